# Optimizing an MI355X kernel written in HIP

```python
import math
import jax, jax.numpy as jnp
from jax import lax
import numpy as np

D_MODEL = 1024
BATCH = 8
SEQ = 2048
DEPTH = 4


CTX_LEN = 256
GRID_W = 64
N_MIXERS = 4
N_MOD = 9
D_FF = 2816
EPS = 1e-6
NEG = -1e30

NA_HEADS = 16
NA_HD = D_MODEL // NA_HEADS
NA_WIN_R = 8
NA_WIN_C = 16
NA_QBLK_C = 16
NA_KBLK_C = NA_QBLK_C + NA_WIN_C

ML_HEADS = 4
ML_HD = D_MODEL // ML_HEADS
ML_CONV = 3
ML_CHUNK = 64

DA_HEADS = 8
DA_HD = D_MODEL // DA_HEADS // 2
DA_QBLK = 128
ROPE_BASE = 10000.0

GLA_HEADS = 4
GLA_DK = D_MODEL // 2 // GLA_HEADS
GLA_DV = D_MODEL // GLA_HEADS
GLA_RANK = 16
GLA_TAU = 16.0
GLA_CHUNK = 64

LAYERS_PER_MIXER = tuple((DEPTH - m + N_MIXERS - 1) // N_MIXERS for m in range(N_MIXERS))

kernel_name = 'hybrid_interleaved_diffusion_block'


def rmsnorm(x, g):
    xf = x.astype(jnp.float32)
    y = xf * lax.rsqrt(jnp.mean(xf * xf, axis=-1, keepdims=True) + EPS)
    return (y * g.astype(jnp.float32)).astype(x.dtype)


def head_rmsnorm(o, g):
    of = o.astype(jnp.float32)
    y = of * lax.rsqrt(jnp.mean(of * of, axis=-1, keepdims=True) + EPS)
    return (y * g.reshape(o.shape[-2:]).astype(jnp.float32)).astype(o.dtype)


def modulate(x, shift, scale):
    return x * (1.0 + scale) + shift


def swiglu(x, w13, w2):
    gate, up = jnp.split(x @ w13, 2, axis=-1)
    return (jax.nn.silu(gate) * up) @ w2


def ffn_branch(h, g, shift, scale, gate, w13, w2):
    return 0.5 * gate * swiglu(modulate(rmsnorm(h, g), shift, scale), w13, w2)


def dwconv_centred(x, w):
    K, C = w.shape
    return lax.conv_general_dilated(x, w[:, None, :].astype(x.dtype), (1,), [(K // 2, K // 2)],
                                    dimension_numbers=('NWC', 'WIO', 'NWC'), feature_group_count=C)


def axial_rope_tables(n, dim):
    t = jnp.arange(n)
    row = (t // GRID_W).astype(jnp.float32)
    col = (t % GRID_W).astype(jnp.float32)
    per_axis = dim // 2
    freqs = ROPE_BASE ** (-jnp.arange(0, per_axis, 2, dtype=jnp.float32) / per_axis)
    ar = row[:, None] * freqs
    ac = col[:, None] * freqs
    ang = jnp.concatenate([ar, ar, ac, ac], axis=-1)
    return jnp.cos(ang), jnp.sin(ang)


def apply_axial_rope(x, cos, sin):
    x1, x2, x3, x4 = jnp.split(x, 4, axis=-1)
    rot = jnp.concatenate([-x2, x1, -x4, x3], axis=-1)
    return (x * cos + rot * sin).astype(x.dtype)


def softmax_attend(q, k, v):
    s = jnp.einsum('bthd,bshd->bhts', q, k).astype(jnp.float32)
    p = jax.nn.softmax(s, axis=-1).astype(v.dtype)
    return jnp.einsum('bhts,bshd->bthd', p, v)


def to_chunks(t, size):
    nc = t.shape[2] // size
    return jnp.moveaxis(t.reshape(t.shape[:2] + (nc, size) + t.shape[3:]), 2, 0)


def from_chunks(t):
    t = jnp.moveaxis(t, 0, 2)
    return t.reshape(t.shape[0], t.shape[1], -1, t.shape[-1])


def mlstm_scan(q, k, v, ig, lf, state):
    tril = np.tril(np.ones((ML_CHUNK, ML_CHUNK), bool))

    def step(carry, inp):
        C, n, m = carry
        qc, kc, vc, ic, fc = inp
        b = jnp.cumsum(fc, axis=-1)
        dmat = jnp.where(tril, b[..., :, None] - b[..., None, :] + ic[..., None, :], NEG)
        inter = b + m[..., None]
        m_t = jnp.maximum(inter, jnp.max(dmat, axis=-1))
        w_inter = jnp.exp(inter - m_t)
        s = jnp.einsum('bhtd,bhsd->bhts', qc, kc) * jnp.exp(dmat - m_t[..., None])
        num = w_inter[..., None] * jnp.einsum('bhtd,bhde->bhte', qc, C) + jnp.einsum('bhts,bhse->bhte', s, vc)
        den = w_inter * jnp.einsum('bhtd,bhd->bht', qc, n) + jnp.sum(s, axis=-1)
        h = num / jnp.maximum(jnp.abs(den), jnp.exp(-m_t))[..., None]
        g = b[..., -1:] - b + ic
        m_new = jnp.maximum(b[..., -1] + m, jnp.max(g, axis=-1))
        w_old = jnp.exp(b[..., -1] + m - m_new)
        w_s = jnp.exp(g - m_new[..., None])
        C_new = w_old[..., None, None] * C + jnp.einsum('bhs,bhsd,bhse->bhde', w_s, kc, vc)
        n_new = w_old[..., None] * n + jnp.einsum('bhs,bhsd->bhd', w_s, kc)
        return (C_new, n_new, m_new), h

    final, h = lax.scan(step, state, (to_chunks(q, ML_CHUNK), to_chunks(k, ML_CHUNK), to_chunks(v, ML_CHUNK),
                                      to_chunks(ig, ML_CHUNK), to_chunks(lf, ML_CHUNK)))
    return from_chunks(h), final


def mlstm_final_state(_q, k, v, ig, lf):
    b = jnp.cumsum(lf, axis=-1)
    g = b[..., -1:] - b + ig
    m = jnp.max(g, axis=-1)
    w = jnp.exp(g - m[..., None])
    return (jnp.einsum('bhs,bhsd,bhse->bhde', w, k, v), jnp.einsum('bhs,bhsd->bhd', w, k), m)


def gla_scan(q, k, v, la, s0):
    tril = np.tril(np.ones((GLA_CHUNK, GLA_CHUNK), bool))[..., None]

    def step(s, inp):
        qc, kc, vc, lc = inp
        bc = jnp.cumsum(lc, axis=2)
        decay = jnp.exp(jnp.where(tril, bc[:, :, :, None, :] - bc[:, :, None, :, :], NEG))
        att = jnp.einsum('bhtd,bhsd,bhtsd->bhts', qc, kc, decay)
        o = jnp.einsum('bhts,bhse->bhte', att, vc) + jnp.einsum('bhtd,bhde->bhte', qc * jnp.exp(bc), s)
        b_end = bc[:, :, -1:, :]
        s_new = jnp.exp(b_end[:, :, 0, :, None]) * s + jnp.einsum('bhsd,bhse->bhde', kc * jnp.exp(b_end - bc), vc)
        return s_new, o

    s_fin, o = lax.scan(step, s0, (to_chunks(q, GLA_CHUNK), to_chunks(k, GLA_CHUNK), to_chunks(v, GLA_CHUNK),
                                   to_chunks(la, GLA_CHUNK)))
    return from_chunks(o), s_fin


def gla_final_state(_q, k, v, la):
    b = jnp.cumsum(la, axis=2)
    return jnp.einsum('bhsd,bhse->bhde', k * jnp.exp(b[:, :, -1:] - b), v)


def prefix_bidir(scan_fn, final_fn, lat_dirs, ctx_dirs, state0, need_ctx):
    h_lat, h_ctx = None, None
    for reverse, lat, ctx in zip((False, True), lat_dirs, ctx_dirs):
        flip = (lambda t: None if t is None else jnp.flip(t, 2)) if reverse else (lambda t: t)
        lat = [flip(t) for t in lat]
        ctx = [flip(t) for t in ctx]
        if need_ctx:
            hc, state = scan_fn(*ctx, state0)
            hc = flip(hc)
            h_ctx = hc if h_ctx is None else h_ctx + hc
        else:
            state = final_fn(*ctx)
        hl, _ = scan_fn(*lat, state)
        hl = flip(hl)
        h_lat = hl if h_lat is None else h_lat + hl
    return h_lat, h_ctx


def na_mixer(a, ac, w_kvq, rpb, w_o, need_ctx):
    B, N, D = a.shape
    L = ac.shape[1]
    H, d = NA_HEADS, NA_HD
    rows = N // GRID_W
    kr = min(NA_WIN_R, rows)
    k, v, q = jnp.split(a @ w_kvq, 3, axis=-1)
    kg = k.reshape(B, rows, GRID_W, H, d)
    vg = v.reshape(B, rows, GRID_W, H, d)
    qg = (q * d ** -0.5).reshape(B, rows, GRID_W, H, d)
    pc = ac @ (w_kvq if need_ctx else w_kvq[:, :2 * D])
    kc = pc[..., :D].reshape(B, L, H, d)
    vc = pc[..., D:2 * D].reshape(B, L, H, d)
    n_cb = GRID_W // NA_QBLK_C
    qcol = np.arange(GRID_W).reshape(n_cb, NA_QBLK_C)
    win0 = np.clip(qcol - NA_WIN_C // 2, 0, GRID_W - NA_WIN_C)
    kcol = np.clip(win0[:, :1], 0, GRID_W - NA_KBLK_C) + np.arange(NA_KBLK_C)
    in_win = (kcol[:, None, :] >= win0[:, :, None]) & (kcol[:, None, :] < win0[:, :, None] + NA_WIN_C)
    col_off = np.clip(kcol[:, None, :] - qcol[:, :, None], 1 - NA_WIN_C, NA_WIN_C - 1) + NA_WIN_C - 1
    rpb_f = rpb.astype(jnp.float32)
    n_loc = kr * NA_KBLK_C

    def one_row(r):
        r0 = jnp.clip(r - kr // 2, 0, rows - kr)
        k_blk = lax.dynamic_slice_in_dim(kg, r0, kr, axis=1)[:, :, kcol]
        v_blk = lax.dynamic_slice_in_dim(vg, r0, kr, axis=1)[:, :, kcol]
        q_row = lax.dynamic_index_in_dim(qg, r, axis=1, keepdims=False).reshape(B, n_cb, NA_QBLK_C, H, d)
        row_off = r0 + jnp.arange(kr) - r + NA_WIN_R - 1
        bias = rpb_f[:, row_off[None, None, :, None], col_off[:, :, None, :]]
        s_loc = jnp.einsum('bjqhd,brjkhd->bhjqrk', q_row, k_blk).astype(jnp.float32) + bias[None]
        s_loc = jnp.where(in_win[None, None, :, :, None, :], s_loc, NEG)
        s_ctx = jnp.einsum('bjqhd,blhd->bhjql', q_row, kc).astype(jnp.float32)
        s = jnp.concatenate([s_loc.reshape(B, H, n_cb, NA_QBLK_C, n_loc), s_ctx], axis=-1)
        p = jax.nn.softmax(s, axis=-1).astype(v.dtype)
        p_loc = p[..., :n_loc].reshape(B, H, n_cb, NA_QBLK_C, kr, NA_KBLK_C)
        o = jnp.einsum('bhjqrk,brjkhd->bjqhd', p_loc, v_blk) + jnp.einsum('bhjql,blhd->bjqhd', p[..., n_loc:], vc)
        return o.reshape(B, GRID_W, D)

    o = lax.map(one_row, jnp.arange(rows))
    y = jnp.transpose(o, (1, 0, 2, 3)).reshape(B, N, D) @ w_o
    yc = None
    if need_ctx:
        qc = (pc[..., 2 * D:] * d ** -0.5).reshape(B, L, H, d)
        yc = softmax_attend(qc, kc, vc).reshape(B, L, D) @ w_o
    return y, yc


def mlstm_mixer(a, ac, w_in, gate_b, conv_w, norm_g, w_o, need_ctx):
    B, N, D = a.shape
    H = ML_HEADS
    n_kvg = 2 * D + 4 * H

    def heads(t):
        return jnp.transpose(t.reshape(t.shape[0], t.shape[1], H, -1), (0, 2, 1, 3)).astype(jnp.float32)

    def prep(p, with_q):
        k = heads(jax.nn.silu(dwconv_centred(p[..., :D], conv_w[:, :D]))) * ML_HD ** -0.5
        v = heads(p[..., D:2 * D])
        g = jnp.transpose((p[..., 2 * D:n_kvg] + gate_b).astype(jnp.float32), (0, 2, 1))
        q = heads(jax.nn.silu(dwconv_centred(p[..., n_kvg:n_kvg + D], conv_w[:, D:]))) if with_q else None
        fwd = (q, k, v, g[:, :H], jax.nn.log_sigmoid(g[:, H:2 * H]))
        bwd = (q, k, v, g[:, 2 * H:3 * H], jax.nn.log_sigmoid(g[:, 3 * H:]))
        return fwd, bwd

    p = a @ w_in
    pc = ac @ (w_in if need_ctx else w_in[:, :n_kvg])
    zero = (jnp.zeros((B, H, ML_HD, ML_HD), jnp.float32), jnp.zeros((B, H, ML_HD), jnp.float32),
            jnp.zeros((B, H), jnp.float32))
    h, hc = prefix_bidir(mlstm_scan, mlstm_final_state, prep(p, True), prep(pc, need_ctx), zero, need_ctx)

    def readout(hh, pp):
        hh = jnp.transpose(hh, (0, 2, 1, 3)).astype(a.dtype)
        T = hh.shape[1]
        return (jax.nn.sigmoid(pp[..., n_kvg + D:]) * head_rmsnorm(hh, norm_g).reshape(B, T, D)) @ w_o

    return readout(h, p), (readout(hc, pc) if need_ctx else None)


def diff_mixer(a, ac, w_kvq, lam_p, norm_g, w_o, layer_idx, need_ctx):
    B, N, D = a.shape
    L = ac.shape[1]
    H, d = DA_HEADS, DA_HD
    lam_init = 0.8 - 0.6 * math.exp(-0.3 * layer_idx)
    lp = lam_p.astype(jnp.float32)
    lam = jnp.exp(jnp.sum(lp[0] * lp[1])) - jnp.exp(jnp.sum(lp[2] * lp[3])) + lam_init

    def attend(q, k, v):
        s = jnp.einsum('bthjd,bshjd->bhjts', q, k).astype(jnp.float32)
        p = jax.nn.softmax(s, axis=-1)
        w = (p[:, :, 0] - lam * p[:, :, 1]).astype(v.dtype)
        return jnp.einsum('bhts,bshe->bthe', w, v)

    def finish(o):
        T = o.shape[1]
        return (head_rmsnorm(o, norm_g) * (1.0 - lam_init)).reshape(B, T, D) @ w_o

    p = a @ w_kvq
    cos, sin = axial_rope_tables(N, d)
    cos, sin = cos[:, None, None, :], sin[:, None, None, :]
    k = apply_axial_rope(p[..., :D].reshape(B, N, H, 2, d), cos, sin)
    v = p[..., D:2 * D].reshape(B, N, H, 2 * d)
    q = apply_axial_rope((p[..., 2 * D:] * d ** -0.5).reshape(B, N, H, 2, d), cos, sin)
    pc = ac @ (w_kvq if need_ctx else w_kvq[:, :2 * D])
    kc = pc[..., :D].reshape(B, L, H, 2, d)
    vc = pc[..., D:2 * D].reshape(B, L, H, 2 * d)
    k_all = jnp.concatenate([k, kc], axis=1)
    v_all = jnp.concatenate([v, vc], axis=1)
    n_blk = N // DA_QBLK
    q_blocks = jnp.moveaxis(q.reshape(B, n_blk, DA_QBLK, H, 2, d), 1, 0)
    o = lax.map(lambda qb: attend(qb, k_all, v_all), q_blocks)
    y = finish(jnp.moveaxis(o, 0, 1).reshape(B, N, H, 2 * d))
    yc = None
    if need_ctx:
        qc = (pc[..., 2 * D:] * d ** -0.5).reshape(B, L, H, 2, d)
        yc = finish(attend(qc, kc, vc))
    return y, yc


def gla_mixer(a, ac, w_in, w_gate_up, b_gate, norm_g, w_o, need_ctx):
    B, N, D = a.shape
    H = GLA_HEADS
    dk_t = H * GLA_DK
    n_kvg = dk_t + D + 2 * GLA_RANK

    def heads(t):
        return jnp.transpose(t.reshape(t.shape[0], t.shape[1], H, -1), (0, 2, 1, 3)).astype(jnp.float32)

    def prep(p, with_q):
        k = heads(p[..., :dk_t])
        v = heads(p[..., dk_t:dk_t + D])
        low = p[..., dk_t + D:n_kvg]
        la = [heads(jax.nn.log_sigmoid((low[..., r * GLA_RANK:(r + 1) * GLA_RANK] @ w_gate_up[r] + b_gate[r])
                                       .astype(jnp.float32))) / GLA_TAU for r in range(2)]
        q = heads(p[..., n_kvg:n_kvg + dk_t]) * GLA_DK ** -0.5 if with_q else None
        return (q, k, v, la[0]), (q, k, v, la[1])

    p = a @ w_in
    pc = ac @ (w_in if need_ctx else w_in[:, :n_kvg])
    zero = jnp.zeros((B, H, GLA_DK, GLA_DV), jnp.float32)
    o, oc = prefix_bidir(gla_scan, gla_final_state, prep(p, True), prep(pc, need_ctx), zero, need_ctx)

    def readout(oo, pp):
        oo = jnp.transpose(oo, (0, 2, 1, 3)).astype(a.dtype)
        T = oo.shape[1]
        return (head_rmsnorm(oo, norm_g).reshape(B, T, D) * jax.nn.silu(pp[..., n_kvg + dk_t:])) @ w_o

    return readout(o, p), (readout(oc, pc) if need_ctx else None)


def setup_inputs(seed: int = 0) -> dict:
    key = jax.random.key(seed)
    ks = jax.random.split(key, 32)
    D = D_MODEL
    n_na, n_ml, n_da, n_gla = LAYERS_PER_MIXER
    dk_t = GLA_HEADS * GLA_DK

    def nrm(i, shape, std):
        return std * jax.random.normal(ks[i], shape, jnp.float32)

    def gain(i, shape):
        return 1.0 + nrm(i, shape, 0.02)

    ig_b = nrm(14, (n_ml, 2, 1, ML_HEADS), 0.1)
    fg_b = jax.random.uniform(ks[15], (n_ml, 2, 1, ML_HEADS), jnp.float32, 3.0, 6.0)
    ml_gate_b = jnp.concatenate([ig_b, fg_b], axis=2).reshape(n_ml, 4 * ML_HEADS)
    return {
        'x': nrm(0, (BATCH, SEQ, D), 1.0),
        'c': nrm(1, (BATCH, D), 1.0),
        'ctx': nrm(2, (BATCH, CTX_LEN, D), 1.0),
        'c_ctx': nrm(3, (D,), 1.0),
        'ada_w': nrm(4, (DEPTH, D, N_MOD * D), 0.5 * D ** -0.5),
        'ada_b': nrm(5, (DEPTH, N_MOD * D), 0.01),
        'norm_g': gain(6, (DEPTH, 3, D)),
        'ffn_w13': nrm(7, (DEPTH, 2, D, 2 * D_FF), D ** -0.5),
        'ffn_w2': nrm(8, (DEPTH, 2, D_FF, D), D_FF ** -0.5),
        'final_g': gain(9, (D,)),
        'na_w_kvq': nrm(10, (n_na, D, 3 * D), D ** -0.5),
        'na_rpb': nrm(11, (n_na, NA_HEADS, 2 * NA_WIN_R - 1, 2 * NA_WIN_C - 1), 0.02),
        'na_w_o': nrm(12, (n_na, D, D), D ** -0.5),
        'ml_w_in': nrm(13, (n_ml, D, 4 * D + 4 * ML_HEADS), D ** -0.5),
        'ml_gate_b': ml_gate_b,
        'ml_conv_w': nrm(16, (n_ml, ML_CONV, 2 * D), ML_CONV ** -0.5),
        'ml_norm_g': gain(17, (n_ml, D)),
        'ml_w_o': nrm(18, (n_ml, D, D), D ** -0.5),
        'da_w_kvq': nrm(19, (n_da, D, 3 * D), D ** -0.5),
        'da_lam': nrm(20, (n_da, 4, DA_HD), 0.1),
        'da_norm_g': gain(21, (n_da, D)),
        'da_w_o': nrm(22, (n_da, D, D), D ** -0.5),
        'gla_w_in': nrm(23, (n_gla, D, 2 * dk_t + 2 * D + 2 * GLA_RANK), D ** -0.5),
        'gla_w_gate_up': nrm(24, (n_gla, 2, GLA_RANK, dk_t), GLA_RANK ** -0.5),
        'gla_b_gate': nrm(25, (n_gla, 2, dk_t), 0.1),
        'gla_norm_g': gain(26, (n_gla, D)),
        'gla_w_o': nrm(27, (n_gla, D, D), D ** -0.5),
    }


def reference(x, c, ctx, c_ctx, ada_w, ada_b, norm_g, ffn_w13, ffn_w2, final_g,
              na_w_kvq, na_rpb, na_w_o,
              ml_w_in, ml_gate_b, ml_conv_w, ml_norm_g, ml_w_o,
              da_w_kvq, da_lam, da_norm_g, da_w_o,
              gla_w_in, gla_w_gate_up, gla_b_gate, gla_norm_g, gla_w_o):
    D = D_MODEL
    s_lat = jax.nn.silu(c)
    s_ctx = jax.nn.silu(c_ctx)
    h, hc = x, ctx
    for i in range(DEPTH):
        kind, j = i % N_MIXERS, i // N_MIXERS
        need_ctx = i < DEPTH - 1
        mod = jnp.split((s_lat @ ada_w[i] + ada_b[i])[:, None, :], N_MOD, axis=-1)
        n_c = N_MOD if need_ctx else 5
        modc = jnp.split((s_ctx @ ada_w[i, :, :n_c * D] + ada_b[i, :n_c * D])[None, None, :], n_c, axis=-1)
        h = h + ffn_branch(h, norm_g[i, 0], mod[0], mod[1], mod[2], ffn_w13[i, 0], ffn_w2[i, 0])
        hc = hc + ffn_branch(hc, norm_g[i, 0], modc[0], modc[1], modc[2], ffn_w13[i, 0], ffn_w2[i, 0])
        a = modulate(rmsnorm(h, norm_g[i, 1]), mod[3], mod[4])
        ac = modulate(rmsnorm(hc, norm_g[i, 1]), modc[3], modc[4])
        if kind == 0:
            y, yc = na_mixer(a, ac, na_w_kvq[j], na_rpb[j], na_w_o[j], need_ctx)
        elif kind == 1:
            y, yc = mlstm_mixer(a, ac, ml_w_in[j], ml_gate_b[j], ml_conv_w[j], ml_norm_g[j], ml_w_o[j], need_ctx)
        elif kind == 2:
            y, yc = diff_mixer(a, ac, da_w_kvq[j], da_lam[j], da_norm_g[j], da_w_o[j], i, need_ctx)
        else:
            y, yc = gla_mixer(a, ac, gla_w_in[j], gla_w_gate_up[j], gla_b_gate[j], gla_norm_g[j], gla_w_o[j], need_ctx)
        h = h + mod[5] * y
        h = h + ffn_branch(h, norm_g[i, 2], mod[6], mod[7], mod[8], ffn_w13[i, 1], ffn_w2[i, 1])
        if need_ctx:
            hc = hc + modc[5] * yc
            hc = hc + ffn_branch(hc, norm_g[i, 2], modc[6], modc[7], modc[8], ffn_w13[i, 1], ffn_w2[i, 1])
    return rmsnorm(h, final_g)
```

```cpp
#include <hip/hip_runtime.h>
#include <hip/hip_cooperative_groups.h>
#include <cstdio>
#include <cstdint>
__device__ __forceinline__ int TID() { int t = threadIdx.x; asm volatile("" : "+v"(t)); return t; }
__device__ __forceinline__ int GDIM() { int t = gridDim.x; asm volatile("" : "+s"(t)); return t; }
__device__ __forceinline__ float shx(float v, int o) { const int lane = TID() & 63; return __builtin_bit_cast(float, __builtin_amdgcn_ds_bpermute((lane ^ o) << 2, __builtin_bit_cast(int, v))); }
__device__ __forceinline__ float rdl(float v, int src) { return __builtin_bit_cast(float, __builtin_amdgcn_readlane(__builtin_bit_cast(int, v), src)); }
__device__ __forceinline__ int BID() { int t = blockIdx.x; asm volatile("" : "+s"(t)); return t; }
namespace pg8 {
#define PG8_LAS __attribute__((address_space(3)))
typedef unsigned short bf16_t;
typedef short bf16x8 __attribute__((ext_vector_type(8)));
typedef float f32x4 __attribute__((ext_vector_type(4)));
typedef unsigned u32x4 __attribute__((ext_vector_type(4)));
constexpr int BM = 256, BK = 64, HALF = 128, HTB = HALF * BK * 2  , STAGE_BYTES = 8 * HTB, NXCD = 8, WGM = 8;

__host__ __device__ __forceinline__ int lds_byte(int r, int c) { const int st = (r >> 4) * 2 + (c >> 5), rr = r & 15, cc = c & 31, ob = rr * 64 + cc * 2; return st * 1024 + (ob ^ (((ob >> 9) & 1) << 5)); }
__host__ __device__ __forceinline__ void stage_rc(int b, int& R, int& C) { const int st = b / 1024, sb = b % 1024, swz = sb ^ (((sb >> 9) & 1) << 5); R = (st >> 1) * 16 + swz / 64; C = (st & 1) * 32 + (swz % 64) / 2; }
__host__ __device__ __forceinline__ int perm32(int rho) { const int n = rho >> 4, i = rho & 15; return 8 * (i >> 2) + 4 * n + (i & 3); }

struct Unit { int pm, pn; };
struct Gemm { const bf16_t* A; const bf16_t* Bt; int M, N, K; };

struct StaticOrder {
    int nM, nN, nwg, G, c;
    __host__ __device__ void init(int M, int N, int G_, int c_) { nM = M / BM; nN = N / BM; nwg = nM * nN; G = G_; c = c_; }
    __host__ __device__ bool next(int i, Unit& u) const {
        const long L = (long)i * G + c; if (L >= nwg) return false;
        int wgid = (int)L; { const int q = nwg / NXCD, r = nwg % NXCD, xcd = wgid % NXCD, off = wgid / NXCD; wgid = (xcd < r ? xcd * (q + 1) : r * (q + 1) + (xcd - r) * q) + off; }
        const int nig = WGM * nN, gid = wgid / nig, fm = gid * WGM, gsz = (nM - fm) < WGM ? (nM - fm) : WGM;
        u.pm = fm + ((wgid % nig) % gsz); u.pn = (wgid % nig) / gsz; return true;
    }
    __device__ __forceinline__ void a_ready(const Unit&) const {}
    __device__ __forceinline__ void done(const Unit&) const {}
};

__device__ __forceinline__ unsigned cvt_pk_bf16(float lo, float hi) { unsigned r; asm volatile("v_cvt_pk_bf16_f32 %0, %1, %2" : "=v"(r) : "v"(lo), "v"(hi)); return r; }
__device__ __forceinline__ float silu_f(float x) { return x / (1.f + __expf(-x)); }
struct EpiSwiglu {
    static constexpr bool PERM = true, AFTER_DRAIN = false;
    bf16_t* O; int ldc;
    __device__ __forceinline__ void operator()(const f32x4 (&acc)[2][2][4][2], const Unit& u, int wr, int wc, int fr, int fq) const {
        const int row0 = u.pm * BM + wr * 64 + fr, col0 = u.pn * HALF + wc * 32 + 8 * fq;
#pragma unroll
        for (int ai = 0; ai < 2; ++ai)
#pragma unroll
            for (int m = 0; m < 4; ++m) {
                bf16_t* rowp = O + (size_t)(row0 + ai * HALF + m * 16) * ldc + col0;
                const f32x4 g0 = acc[ai][0][m][0], g1 = acc[ai][0][m][1], u0 = acc[ai][1][m][0], u1 = acc[ai][1][m][1];
                u32x4 w;
                w.x = cvt_pk_bf16(silu_f(g0[0]) * u0[0], silu_f(g0[1]) * u0[1]);
                w.y = cvt_pk_bf16(silu_f(g0[2]) * u0[2], silu_f(g0[3]) * u0[3]);
                w.z = cvt_pk_bf16(silu_f(g1[0]) * u1[0], silu_f(g1[1]) * u1[1]);
                w.w = cvt_pk_bf16(silu_f(g1[2]) * u1[2], silu_f(g1[3]) * u1[3]);
                *(u32x4*)rowp = w;
            }
    }
};
struct EpiResid {
    static constexpr bool PERM = false, AFTER_DRAIN = false;
    float* H; const float* gate; float scale; int gate_ld;
    __device__ __forceinline__ void operator()(const f32x4 (&acc)[2][2][4][2], const Unit& u, int wr, int wc, int fr, int fq) const {
        const int mrow = u.pm < 64 ? (u.pm >> 3) : 8;
        const float* gp = gate + (size_t)mrow * gate_ld;
        const int row0 = u.pm * BM + wr * 64 + fr, col0 = u.pn * BM + wc * 32 + 4 * fq;
#pragma unroll
        for (int bj = 0; bj < 2; ++bj)
#pragma unroll
            for (int n = 0; n < 2; ++n) {
                const int col = col0 + bj * HALF + n * 16;
                f32x4 g = *(const f32x4*)(gp + col); g = g * scale;
#pragma unroll
                for (int ai = 0; ai < 2; ++ai)
#pragma unroll
                    for (int m = 0; m < 4; ++m) {
                        float* hp = H + (size_t)(row0 + ai * HALF + m * 16) * 1024 + col;
                        f32x4 h = *(const f32x4*)hp; h = h + g * acc[ai][bj][m][n]; *(f32x4*)hp = h;
                    }
            }
    }
};
struct EpiProj {
    static constexpr bool PERM = true, AFTER_DRAIN = false;
    bf16_t* P; int ldc; float* G32; int gcol0, gn;
    __device__ __forceinline__ void operator()(const f32x4 (&acc)[2][2][4][2], const Unit& u, int wr, int wc, int fr, int fq) const {
        const int row0 = u.pm * BM + wr * 64 + fr, col0 = u.pn * BM + wc * 32 + 8 * fq;
#pragma unroll
        for (int bj = 0; bj < 2; ++bj) {
            const int col = col0 + bj * HALF;
            const bool gs = (col >= gcol0) && (col < gcol0 + gn);
#pragma unroll
            for (int ai = 0; ai < 2; ++ai)
#pragma unroll
                for (int m = 0; m < 4; ++m) {
                    const size_t row = (size_t)(row0 + ai * HALF + m * 16);
                    const f32x4 v0 = acc[ai][bj][m][0], v1 = acc[ai][bj][m][1];
                    u32x4 w; w.x = cvt_pk_bf16(v0[0], v0[1]); w.y = cvt_pk_bf16(v0[2], v0[3]); w.z = cvt_pk_bf16(v1[0], v1[1]); w.w = cvt_pk_bf16(v1[2], v1[3]);
                    *(u32x4*)(P + row * ldc + col) = w;
                    if (gs) { float* gp = G32 + row * 32 + (col - gcol0); *(f32x4*)gp = v0; *(f32x4*)(gp + 4) = v1; }
                }
        }
    }
};

template <class Epi, class Sched, bool ALIGN_EPI = false, bool SP2 = false>
__device__ __forceinline__ void gemm_phase(PG8_LAS unsigned char* lds, const Gemm g, const Sched& S, const Epi& E) {
    const int tid = TID(), wid = __builtin_amdgcn_readfirstlane(tid >> 6), lane = tid & 63, wr = wid >> 2, wc = wid & 3, fr = lane & 15, fq = lane >> 4;
    const int K = g.K, nt = K / BK;
    unsigned voffA[2], voffB[2];
#pragma unroll
    for (int i = 0; i < 2; ++i) { int R, C; stage_rc(tid * 16 + i * 8192, R, C); const int Rb = Epi::PERM ? ((R & ~31) + perm32(R & 31)) : R;
        voffA[i] = (unsigned)(R * K + C) * 2u; voffB[i] = (unsigned)(Rb * K + C) * 2u; }
    const size_t kstep = (size_t)(BK * 2);
    const size_t hstep = (size_t)HALF * K * 2;
    const size_t tstep = 2 * hstep;
    const unsigned ldsw = (unsigned)wid * 1024u;
    const int aoff = lds_byte(wr * 64 + fr, fq * 8), boff = lds_byte(wc * 32 + fr, fq * 8);
#define PG8_SA(b, h) (((b) * 2 + (h)) * HTB)
#define PG8_SB(b, h) ((4 + (b) * 2 + (h)) * HTB)
#define PG8_STAGE(bufoff, gbase, voff) do { _Pragma("unroll") for (int _i = 0; _i < 2; ++_i) \
        __builtin_amdgcn_global_load_lds((const unsigned*)((const char*)(gbase) + (voff)[_i]), (PG8_LAS unsigned*)(lds + (bufoff) + ldsw + _i * 8192), 16, 0, 0); } while (0)
#define PG8_LDA(dst, b, h) do { _Pragma("unroll") for (int m = 0; m < 4; ++m) _Pragma("unroll") for (int k = 0; k < 2; ++k) dst[m][k] = *(const PG8_LAS bf16x8*)(lds + PG8_SA(b, h) + aoff + m * 2048 + k * 1024); } while (0)
#define PG8_LDB(dst, b, h) do { _Pragma("unroll") for (int n = 0; n < 2; ++n) _Pragma("unroll") for (int k = 0; k < 2; ++k) dst[n][k] = *(const PG8_LAS bf16x8*)(lds + PG8_SB(b, h) + boff + n * 2048 + k * 1024); } while (0)
#define PG8_MMA(ai, bj, At, Bt) do { __builtin_amdgcn_s_setprio(1); _Pragma("unroll") for (int m = 0; m < 4; ++m) _Pragma("unroll") for (int n = 0; n < 2; ++n) _Pragma("unroll") for (int k = 0; k < 2; ++k) \
        acc[ai][bj][m][n] = __builtin_amdgcn_mfma_f32_16x16x32_bf16(Bt[n][k], At[m][k], acc[ai][bj][m][n], 0, 0, 0); __builtin_amdgcn_s_setprio(0); } while (0)
#define PG8_WAIT_V(n) asm volatile("s_waitcnt vmcnt(" #n ")" ::: "memory")
#define PG8_WAIT_L(n) asm volatile("s_waitcnt lgkmcnt(" #n ")" ::: "memory")
#define PG8_BAR __builtin_amdgcn_s_barrier()
#define PG8_SCHED __builtin_amdgcn_sched_barrier(0)
    Unit cur, nxt; int ui = 0;
    if (!S.next(0, cur)) return;
    f32x4 acc[2][2][4][2];
#pragma unroll
    for (int a = 0; a < 2; ++a)
#pragma unroll
        for (int b = 0; b < 2; ++b)
#pragma unroll
            for (int m = 0; m < 4; ++m)
#pragma unroll
                for (int n = 0; n < 2; ++n) acc[a][b][m][n] = (f32x4){0.f, 0.f, 0.f, 0.f};
    bf16x8 At[4][2], B0[2][2], B1[2][2];
    const char* cA = (const char*)g.A + (size_t)cur.pm * tstep; const char* cB = (const char*)g.Bt + (size_t)cur.pn * tstep;
    S.a_ready(cur);
    if constexpr (SP2) {
        PG8_STAGE(PG8_SB(0, 0), cB, voffB); PG8_STAGE(PG8_SB(0, 1), cB + hstep, voffB); PG8_STAGE(PG8_SA(0, 0), cA, voffA); PG8_STAGE(PG8_SA(0, 1), cA + hstep, voffA);
        if (wr == 1) PG8_BAR;
        PG8_WAIT_V(2); PG8_BAR;
        PG8_STAGE(PG8_SB(1, 0), cB + kstep, voffB); PG8_STAGE(PG8_SA(1, 0), cA + kstep, voffA); PG8_STAGE(PG8_SB(1, 1), cB + hstep + kstep, voffB);
        PG8_WAIT_V(6); PG8_BAR;
    } else {
        PG8_STAGE(PG8_SB(0, 0), cB, voffB); PG8_STAGE(PG8_SA(0, 0), cA, voffA); PG8_STAGE(PG8_SB(0, 1), cB + hstep, voffB); PG8_STAGE(PG8_SA(0, 1), cA + hstep, voffA);
        if (wr == 1) PG8_BAR;
        PG8_WAIT_V(4); PG8_BAR;
        PG8_STAGE(PG8_SB(1, 0), cB + kstep, voffB); PG8_STAGE(PG8_SA(1, 0), cA + kstep, voffA); PG8_STAGE(PG8_SB(1, 1), cB + hstep + kstep, voffB);
        PG8_WAIT_V(6); PG8_BAR;
    }
    for (;;) {
        const bool has_next = S.next(ui + 1, nxt);
        const char* nA = has_next ? (const char*)g.A + (size_t)nxt.pm * tstep : cA; const char* nB = has_next ? (const char*)g.Bt + (size_t)nxt.pn * tstep : cB;
        for (int t = 0; t < nt; t += 2) {
            const bool last = (t == nt - 2);
            const char* a1 = cA + (size_t)(t + 1) * kstep;
            const char* a2 = last ? nA : cA + (size_t)(t + 2) * kstep; const char* b2 = last ? nB : cB + (size_t)(t + 2) * kstep;
            const char* a3 = a2 + kstep; const char* b3 = b2 + kstep;
            if (last && has_next) S.a_ready(nxt);
            if constexpr (SP2) {
            PG8_LDB(B0, 0, 0); PG8_LDB(B1, 0, 1); PG8_SCHED; PG8_LDA(At, 0, 0); PG8_STAGE(PG8_SA(1, 1), a1 + hstep, voffA);
            PG8_WAIT_V(8); PG8_WAIT_L(0); PG8_BAR; PG8_MMA(0, 0, At, B0); PG8_MMA(0, 1, At, B1); PG8_BAR; PG8_SCHED;
            PG8_LDA(At, 0, 1); PG8_STAGE(PG8_SB(0, 0), b2, voffB); PG8_STAGE(PG8_SB(0, 1), b2 + hstep, voffB); PG8_STAGE(PG8_SA(0, 0), a2, voffA);
            PG8_WAIT_V(8); PG8_WAIT_L(0); PG8_BAR; PG8_MMA(1, 0, At, B0); PG8_MMA(1, 1, At, B1); PG8_BAR; PG8_SCHED;
            PG8_LDB(B0, 1, 0); PG8_LDB(B1, 1, 1); PG8_SCHED; PG8_LDA(At, 1, 0); PG8_STAGE(PG8_SA(0, 1), a2 + hstep, voffA);
            PG8_WAIT_V(8); PG8_WAIT_L(0); PG8_BAR; PG8_MMA(0, 0, At, B0); PG8_MMA(0, 1, At, B1); PG8_BAR; PG8_SCHED;
            PG8_LDA(At, 1, 1); PG8_STAGE(PG8_SB(1, 0), b3, voffB); PG8_STAGE(PG8_SB(1, 1), b3 + hstep, voffB); PG8_STAGE(PG8_SA(1, 0), a3, voffA);
            PG8_WAIT_V(8); PG8_WAIT_L(0); PG8_BAR; PG8_MMA(1, 0, At, B0); PG8_MMA(1, 1, At, B1); PG8_BAR; PG8_SCHED;
            } else {
            PG8_LDB(B0, 0, 0); PG8_SCHED; PG8_LDA(At, 0, 0); PG8_STAGE(PG8_SA(1, 1), a1 + hstep, voffA);
            PG8_WAIT_L(8); PG8_BAR; PG8_WAIT_L(0); PG8_MMA(0, 0, At, B0); PG8_BAR; PG8_SCHED;
            PG8_LDB(B1, 0, 1); PG8_STAGE(PG8_SB(0, 0), b2, voffB);
            PG8_BAR; PG8_WAIT_L(0); PG8_MMA(0, 1, At, B1); PG8_BAR;
            PG8_LDA(At, 0, 1); PG8_STAGE(PG8_SA(0, 0), a2, voffA);
            PG8_BAR; PG8_WAIT_L(0); PG8_MMA(1, 0, At, B0); PG8_BAR; PG8_SCHED;
            PG8_STAGE(PG8_SB(0, 1), b2 + hstep, voffB);
            PG8_WAIT_V(6); PG8_BAR; PG8_MMA(1, 1, At, B1); PG8_BAR;
            PG8_LDB(B0, 1, 0); PG8_SCHED; PG8_LDA(At, 1, 0); PG8_STAGE(PG8_SA(0, 1), a2 + hstep, voffA);
            PG8_WAIT_L(8); PG8_BAR; PG8_WAIT_L(0); PG8_MMA(0, 0, At, B0); PG8_BAR; PG8_SCHED;
            PG8_LDB(B1, 1, 1); PG8_STAGE(PG8_SB(1, 0), b3, voffB);
            PG8_BAR; PG8_WAIT_L(0); PG8_MMA(0, 1, At, B1); PG8_BAR;
            PG8_LDA(At, 1, 1); PG8_STAGE(PG8_SA(1, 0), a3, voffA);
            PG8_BAR; PG8_WAIT_L(0); PG8_MMA(1, 0, At, B0); PG8_BAR; PG8_SCHED;
            PG8_STAGE(PG8_SB(1, 1), b3 + hstep, voffB);
            PG8_WAIT_V(6); PG8_BAR; PG8_MMA(1, 1, At, B1); PG8_BAR;
            }
        }
        if constexpr (ALIGN_EPI) { if (wr == 0) PG8_BAR; }
        if constexpr (!Epi::AFTER_DRAIN) { E(acc, cur, wr, wc, fr, fq); S.done(cur); }
        if (!has_next) break;
#pragma unroll
        for (int a = 0; a < 2; ++a)
#pragma unroll
            for (int b = 0; b < 2; ++b)
#pragma unroll
                for (int m = 0; m < 4; ++m)
#pragma unroll
                    for (int n = 0; n < 2; ++n) acc[a][b][m][n] = (f32x4){0.f, 0.f, 0.f, 0.f};
        cur = nxt; cA = nA; cB = nB; ++ui;
        if constexpr (ALIGN_EPI) { if (wr == 1) PG8_BAR; }
    }
    PG8_WAIT_V(0);
    if constexpr (!ALIGN_EPI) { if (wr == 0) PG8_BAR; }
    PG8_BAR;
    if constexpr (Epi::AFTER_DRAIN) { E.fused(acc, cur, wr, wc, fr, fq, lds, wid, lane); S.done(cur); }
#undef PG8_SA
#undef PG8_SB
#undef PG8_STAGE
#undef PG8_LDA
#undef PG8_LDB
#undef PG8_MMA
#undef PG8_WAIT_V
#undef PG8_WAIT_L
#undef PG8_BAR
#undef PG8_SCHED
}
}
namespace cg = cooperative_groups;
typedef unsigned short bf16_t;
typedef float f32x4 __attribute__((ext_vector_type(4)));
typedef unsigned u32x4 __attribute__((ext_vector_type(4)));
typedef unsigned u32x2 __attribute__((ext_vector_type(2)));
#define LAS __attribute__((address_space(3)))

constexpr int D = 1024, NB = 8, SEQ = 2048, CTXL = 256, DFF = 2816;
constexpr int MLAT = NB * SEQ, MCTX = NB * CTXL, MTOT = MLAT + MCTX;
constexpr int MODLD = 9 * D;
enum { I_X = 0, I_C, I_CTX, I_CCTX, I_ADAW, I_ADAB, I_NORMG, I_W13, I_W2, I_FINALG, I_NAW, I_NARPB, I_NAWO, I_MLW, I_MLGB, I_MLCONV, I_MLNG, I_MLWO,
       I_DAW, I_DALAM, I_DANG, I_DAWO, I_GLAW, I_GLAGU, I_GLABG, I_GLANG, I_GLAWO, N_IN };
constexpr int NPAD_IN[4] = {3072, 4352, 3072, 3328};
constexpr int N_IN_REAL[4] = {3072, 4112, 3072, 3104};
constexpr size_t al256(size_t x) { return (x + 255) & ~(size_t)255; }
constexpr size_t WS_MOD = 0;
constexpr size_t WS_ROPE = al256(WS_MOD + (size_t)4 * 9 * MODLD * 4);
constexpr size_t WS_W13T = al256(WS_ROPE + 2 * 64 * 16 * 4);
constexpr size_t W13T_SZ = (size_t)2 * DFF * D * 2;
constexpr size_t WS_W2T = WS_W13T + 8 * W13T_SZ;
constexpr size_t W2T_SZ = (size_t)D * DFF * 2;
constexpr size_t WS_WIN0 = WS_W2T + 8 * W2T_SZ;
constexpr size_t WS_WIN1 = WS_WIN0 + (size_t)3072 * D * 2;
constexpr size_t WS_WIN2 = WS_WIN1 + (size_t)4352 * D * 2;
constexpr size_t WS_WIN3 = WS_WIN2 + (size_t)3072 * D * 2;
constexpr size_t WS_WO = WS_WIN3 + (size_t)3328 * D * 2;
constexpr size_t WS_H = WS_WO + (size_t)4 * D * D * 2;
constexpr size_t WS_U = WS_H + (size_t)MTOT * D * 4;
constexpr size_t WS_P = WS_U + (size_t)MTOT * D * 2;
constexpr size_t WS_G32 = WS_P + (size_t)MTOT * 4352 * 2;
constexpr size_t WS_QC = WS_G32 + (size_t)MTOT * 32 * 4;
constexpr size_t WS_KC = WS_QC + (size_t)MTOT * D * 2;
constexpr size_t WS_HS = WS_KC + (size_t)MTOT * D * 2;
constexpr size_t WS_END = WS_HS + (size_t)2 * MTOT * D * 4;

struct Args { const float* in[N_IN]; float* out; unsigned char* ws; int ph_lo, ph_hi; };

__device__ __forceinline__ unsigned f2bf(float f) { unsigned u = __builtin_bit_cast(unsigned, f); return (u + 0x7fffu + ((u >> 16) & 1u)) >> 16; }
__device__ __forceinline__ unsigned pk2(float lo, float hi) { return f2bf(lo) | (f2bf(hi) << 16); }
__device__ __forceinline__ float bf2f(unsigned short b) { return __builtin_bit_cast(float, (unsigned)b << 16); }
__device__ __forceinline__ float bflo(unsigned w) { return __builtin_bit_cast(float, w << 16); }
__device__ __forceinline__ float bfhi(unsigned w) { return __builtin_bit_cast(float, w & 0xffff0000u); }
__device__ __forceinline__ float wave_sum(float v) {
#pragma unroll
    for (int o = 1; o < 64; o <<= 1) v += shx(v, o);
    return v;
}
__device__ __forceinline__ float wave_max(float v) {
#pragma unroll
    for (int o = 1; o < 64; o <<= 1) v = fmaxf(v, shx(v, o));
    return v;
}
__device__ __forceinline__ float silu(float x) { return x / (1.f + __expf(-x)); }
__device__ __forceinline__ float sigmoidf_(float x) { return 1.f / (1.f + __expf(-x)); }
__device__ __forceinline__ float log_sigmoid(float x) { return fminf(x, 0.f) - log1pf(__expf(-fabsf(x))); }

struct WDesc { const float* src; bf16_t* dst; int K, N, Npad, perm, tiles; };
__device__ __forceinline__ WDesc get_wdesc(const Args& a, unsigned char* ws, int mi) {
    WDesc w;
    if (mi < 8) { w.src = a.in[I_W13] + (size_t)mi * D * 2 * DFF; w.dst = (bf16_t*)(ws + WS_W13T + mi * W13T_SZ); w.K = D; w.N = 2 * DFF; w.Npad = 2 * DFF; w.perm = 1; }
    else if (mi < 16) { const int j = mi - 8; w.src = a.in[I_W2] + (size_t)j * DFF * D; w.dst = (bf16_t*)(ws + WS_W2T + j * W2T_SZ); w.K = DFF; w.N = D; w.Npad = D; w.perm = 0; }
    else if (mi < 20) { const int j = mi - 16;
        w.src = a.in[j == 0 ? I_NAW : j == 1 ? I_MLW : j == 2 ? I_DAW : I_GLAW];
        w.dst = (bf16_t*)(ws + (j == 0 ? WS_WIN0 : j == 1 ? WS_WIN1 : j == 2 ? WS_WIN2 : WS_WIN3));
        w.K = D; w.N = j == 0 ? 3072 : j == 1 ? 4112 : j == 2 ? 3072 : 3104; w.Npad = j == 0 ? 3072 : j == 1 ? 4352 : j == 2 ? 3072 : 3328; w.perm = 0; }
    else { const int j = mi - 20; w.src = a.in[j == 0 ? I_NAWO : j == 1 ? I_MLWO : j == 2 ? I_DAWO : I_GLAWO]; w.dst = (bf16_t*)(ws + WS_WO + (size_t)j * D * D * 2); w.K = D; w.N = D; w.Npad = D; w.perm = 0; }
    w.tiles = (w.K / 64) * (w.Npad / 64);
    return w;
}
constexpr int TILES_W13 = 16 * 88, TILES_W2 = 44 * 16, TILES_WO = 256;
constexpr int TILES_TOTAL = 8 * TILES_W13 + 8 * TILES_W2 + 16 * (48 + 68 + 48 + 52) + 4 * TILES_WO;

__device__ void p0_prologue(const Args& a, LAS unsigned char* lds) {
    const int tid = TID(), lane = tid & 63, wid = tid >> 6;
    unsigned char* ws = a.ws; asm volatile("" : "+s"(ws));
    {
        LAS float* S = (LAS float*)lds;
        LAS float* red = (LAS float*)(lds + 9 * 1024 * 4);
        for (int i = tid; i < 9 * 1024; i += 512) { const float v = i < 8 * 1024 ? a.in[I_C][i] : a.in[I_CCTX][i - 8 * 1024]; S[i] = silu(v); }
        __syncthreads();
        float* MOD = (float*)(ws + WS_MOD);
        for (int item = BID(); item < 4 * 144; item += GDIM()) {
            const int l = item / 144, cgp = item % 144;
            const int cq = tid & 15, kg = tid >> 4;
            const float* W = a.in[I_ADAW] + (size_t)l * D * MODLD + cgp * 64 + cq * 4;
            f32x4 acc[9];
#pragma unroll
            for (int r = 0; r < 9; ++r) acc[r] = (f32x4){0.f, 0.f, 0.f, 0.f};
#pragma unroll 4
            for (int kk = 0; kk < 32; ++kk) {
                const int k = kg * 32 + kk;
                const f32x4 w4 = *(const f32x4*)(W + (size_t)k * MODLD);
#pragma unroll
                for (int r = 0; r < 9; ++r) acc[r] = acc[r] + w4 * S[r * 1024 + k];
            }
#pragma unroll
            for (int r = 0; r < 9; ++r)
#pragma unroll
                for (int e = 0; e < 4; ++e) { float v = acc[r][e]; v += shx(v, 16); v += shx(v, 32); acc[r][e] = v; }
            if (lane < 16) {
#pragma unroll
                for (int r = 0; r < 9; ++r)
#pragma unroll
                    for (int e = 0; e < 4; ++e) red[(wid * 9 + r) * 64 + cq * 4 + e] = acc[r][e];
            }
            __syncthreads();
            for (int o = tid; o < 9 * 64; o += 512) {
                const int r = o >> 6, cc = o & 63; float v = 0.f;
#pragma unroll
                for (int w = 0; w < 8; ++w) v += red[(w * 9 + r) * 64 + cc];
                const int col = cgp * 64 + cc;
                MOD[((size_t)l * 9 + r) * MODLD + col] = v + a.in[I_ADAB][(size_t)l * MODLD + col];
            }
            __syncthreads();
        }
    }
    {
        LAS float* tile = (LAS float*)lds;
        for (int item = BID(); item < TILES_TOTAL; item += GDIM()) {
            int mi, t = item;
            if (t < 8 * TILES_W13) { mi = t / TILES_W13; t -= mi * TILES_W13; }
            else if (t < 8 * TILES_W13 + 8 * TILES_W2) { t -= 8 * TILES_W13; mi = t / TILES_W2; t -= mi * TILES_W2; mi += 8; }
            else { t -= 8 * TILES_W13 + 8 * TILES_W2;
                if (t < 16 * 48) { mi = 16; } else if (t < 16 * (48 + 68)) { mi = 17; t -= 16 * 48; } else if (t < 16 * (48 + 68 + 48)) { mi = 18; t -= 16 * (48 + 68); }
                else if (t < 16 * (48 + 68 + 48 + 52)) { mi = 19; t -= 16 * (48 + 68 + 48); } else { t -= 16 * (48 + 68 + 48 + 52); mi = 20 + t / TILES_WO; t = t % TILES_WO; } }
            const WDesc w = get_wdesc(a, ws, mi);
            const int ntn = w.Npad / 64, kt = t / ntn, nt = t % ntn, k0 = kt * 64, n0 = nt * 64;
            {
                const int nn = tid & 63, n = n0 + nn;
#pragma unroll
                for (int i = 0; i < 8; ++i) { const int kk = (tid >> 6) + 8 * i; tile[kk * 65 + nn] = n < w.N ? w.src[(size_t)(k0 + kk) * w.N + n] : 0.f; }
            }
            __syncthreads();
            {
                const int kp = tid & 31;
#pragma unroll
                for (int i = 0; i < 4; ++i) {
                    const int nn = (tid >> 5) + 16 * i, n = n0 + nn;
                    int drow = n;
                    if (w.perm) { const int half = n >= DFF ? 1 : 0, jj = n - half * DFF; drow = (jj >> 7) * 256 + half * 128 + (jj & 127); }
                    *(unsigned*)(w.dst + (size_t)drow * w.K + k0 + 2 * kp) = pk2(tile[(2 * kp) * 65 + nn], tile[(2 * kp + 1) * 65 + nn]);
                }
            }
            __syncthreads();
        }
    }
    {
        f32x4* H4 = (f32x4*)(ws + WS_H);
        const f32x4* x4 = (const f32x4*)a.in[I_X]; const f32x4* c4 = (const f32x4*)a.in[I_CTX];
        const int n1 = MLAT * D / 4, n2 = MTOT * D / 4;
        for (int i = BID() * 512 + tid; i < n2; i += GDIM() * 512) H4[i] = i < n1 ? x4[i] : c4[i - n1];
    }
    if (BID() == 0) {
        float* R = (float*)(ws + WS_ROPE);
        for (int i = tid; i < 64 * 16; i += 512) { const int pos = i >> 4, fi = i & 15; const float f = powf(10000.f, -(float)fi / 16.f); const float ang = (float)pos * f; R[i] = cosf(ang); R[1024 + i] = sinf(ang); }
    }
}

__device__ void norm_phase(const float* H, const float* g, const float* modl  , int slot_shift, bf16_t* U, int nrows) {
    const int lane = TID() & 63, gw = BID() * 8 + (TID() >> 6), ngw = GDIM() * 8;
    f32x4 gv[4];
#pragma unroll
    for (int j = 0; j < 4; ++j) gv[j] = *(const f32x4*)(g + j * 256 + lane * 4);
    for (int row = gw; row < nrows; row += ngw) {
        const int mrow = row < MLAT ? (row >> 11) : 8;
        const float* sh = modl + (size_t)mrow * MODLD + slot_shift * D; const float* sc = sh + D;
        f32x4 v[4]; float s = 0.f;
#pragma unroll
        for (int j = 0; j < 4; ++j) { v[j] = *(const f32x4*)(H + (size_t)row * D + j * 256 + lane * 4); s += (v[j][0] * v[j][0] + v[j][1] * v[j][1]) + (v[j][2] * v[j][2] + v[j][3] * v[j][3]); }
        const float rstd = rsqrtf(wave_sum(s) * (1.f / D) + 1e-6f);
#pragma unroll
        for (int j = 0; j < 4; ++j) {
            const f32x4 s4 = *(const f32x4*)(sh + j * 256 + lane * 4), c4 = *(const f32x4*)(sc + j * 256 + lane * 4);
            const f32x4 y = (v[j] * rstd) * gv[j] * (c4 + 1.f) + s4;
            u32x2 o; o.x = pk2(y[0], y[1]); o.y = pk2(y[2], y[3]);
            *(u32x2*)(U + (size_t)row * D + j * 256 + lane * 4) = o;
        }
    }
}
__device__ void final_norm_phase(const float* H, const float* g, float* out) {
    const int lane = TID() & 63, gw = BID() * 8 + (TID() >> 6), ngw = GDIM() * 8;
    f32x4 gv[4];
#pragma unroll
    for (int j = 0; j < 4; ++j) gv[j] = *(const f32x4*)(g + j * 256 + lane * 4);
    for (int row = gw; row < MLAT; row += ngw) {
        f32x4 v[4]; float s = 0.f;
#pragma unroll
        for (int j = 0; j < 4; ++j) { v[j] = *(const f32x4*)(H + (size_t)row * D + j * 256 + lane * 4); s += (v[j][0] * v[j][0] + v[j][1] * v[j][1]) + (v[j][2] * v[j][2] + v[j][3] * v[j][3]); }
        const float rstd = rsqrtf(wave_sum(s) * (1.f / D) + 1e-6f);
#pragma unroll
        for (int j = 0; j < 4; ++j) *(f32x4*)(out + (size_t)row * D + j * 256 + lane * 4) = (v[j] * rstd) * gv[j];
    }
}

__device__ __forceinline__ void unpack8(const u32x4 w, float* f) { f[0] = bflo(w.x); f[1] = bfhi(w.x); f[2] = bflo(w.y); f[3] = bfhi(w.y); f[4] = bflo(w.z); f[5] = bfhi(w.z); f[6] = bflo(w.w); f[7] = bfhi(w.w); }
__device__ void na_naive_phase(const bf16_t* P, const float* rpb, bf16_t* U, LAS unsigned char* lds) {
    constexpr int LD = 3072;
    const int lane = TID() & 63, gw = BID() * 8 + (TID() >> 6), ngw = GDIM() * 8;
    for (int item = gw; item < MTOT * 16; item += ngw) {
        const int row = item >> 4, h = item & 15;
        const bool lat = row < MLAT;
        const int b = lat ? (row >> 11) : ((row - MLAT) >> 8);
        const int t = row & 2047, r = t >> 6, c = t & 63;
        const int r0 = min(max(r - 4, 0), 24), win0 = min(max(c - 8, 0), 48);
        const int nk = lat ? 384 : 256;
        LAS float* q = (LAS float*)lds + (TID() >> 6) * 64;
        q[lane] = bf2f(P[(size_t)row * LD + 2048 + h * 64 + lane]);
        __builtin_amdgcn_wave_barrier();
        float s[6];
#pragma unroll
        for (int jj = 0; jj < 6; ++jj) s[jj] = -1e30f;
#pragma unroll 1
        for (int jj = 0; jj < 6; ++jj) {
            const int kk = lane + 64 * jj;
            float val = -1e30f;
            if (kk < nk) {
                int krow; float bias = 0.f;
                if (lat && kk < 128) { const int kr = r0 + (kk >> 4), kc = win0 + (kk & 15); krow = b * 2048 + kr * 64 + kc; bias = rpb[(h * 15 + (kr - r + 7)) * 31 + (kc - c + 15)]; }
                else krow = MLAT + b * 256 + (lat ? kk - 128 : kk);
                const u32x4* kp = (const u32x4*)(P + (size_t)krow * LD + h * 64);
                float d = 0.f;
#pragma unroll
                for (int i = 0; i < 8; ++i) { float kf[8]; unpack8(kp[i], kf); const f32x4 qa = *(const LAS f32x4*)(q + 8 * i), qb = *(const LAS f32x4*)(q + 8 * i + 4);
                    d += kf[0] * qa[0] + kf[1] * qa[1] + kf[2] * qa[2] + kf[3] * qa[3] + kf[4] * qb[0] + kf[5] * qb[1] + kf[6] * qb[2] + kf[7] * qb[3]; }
                val = d * 0.125f + bias;
            }
#pragma unroll
            for (int k2 = 0; k2 < 6; ++k2) s[k2] = (jj == k2) ? val : s[k2];
        }
        float mx = s[0];
#pragma unroll
        for (int jj = 1; jj < 6; ++jj) mx = fmaxf(mx, s[jj]);
        mx = wave_max(mx);
        float sum = 0.f;
#pragma unroll
        for (int jj = 0; jj < 6; ++jj) { s[jj] = (lane + 64 * jj < nk) ? __expf(s[jj] - mx) : 0.f; sum += s[jj]; }
        sum = wave_sum(sum);
        float o = 0.f;
#pragma unroll
        for (int jj = 0; jj < 6; ++jj) {
            if (jj * 64 < nk) {
#pragma unroll 4
                for (int src = 0; src < 64; ++src) {
                    const int kk = jj * 64 + src;
                    const float p = rdl(s[jj], src);
                    int krow;
                    if (lat && kk < 128) krow = b * 2048 + (r0 + (kk >> 4)) * 64 + win0 + (kk & 15); else krow = MLAT + b * 256 + (lat ? kk - 128 : kk);
                    o += p * bf2f(P[(size_t)krow * LD + 1024 + h * 64 + lane]);
                }
            }
        }
        U[(size_t)row * D + h * 64 + lane] = (bf16_t)f2bf(o / sum);
        __builtin_amdgcn_wave_barrier();
    }
}

__device__ void da_rope_phase(bf16_t* P, const float* R) {
    constexpr int LD = 3072;
    const int gt = BID() * 512 + TID(), ngt = GDIM() * 512;
    for (long it = gt; it < (long)MLAT * 1024; it += ngt) {
        const int row = (int)(it >> 10), w = (int)(it & 1023), sec = w >> 9, grp = (w >> 5) & 15, axis = (w >> 4) & 1, i = w & 15;
        const int t = row & 2047, pos = axis ? (t & 63) : (t >> 6);
        const float cs = R[pos * 16 + i], sn = R[1024 + pos * 16 + i];
        bf16_t* p = P + (size_t)row * LD + sec * 2048 + grp * 64 + axis * 32 + i;
        const float x1 = bf2f(p[0]), x2 = bf2f(p[16]);
        p[0] = (bf16_t)f2bf(x1 * cs - x2 * sn); p[16] = (bf16_t)f2bf(x2 * cs + x1 * sn);
    }
}
__device__ void da_naive_phase(const bf16_t* P, const float* lamp, const float* ng, bf16_t* U, LAS unsigned char* lds) {
    constexpr int LD = 3072;
    const int lane = TID() & 63, wid = TID() >> 6, gw = BID() * 8 + wid, ngw = GDIM() * 8;
    LAS float* qs = (LAS float*)lds + wid * 128;
    const float lam_init = 0.8f - 0.6f * expf(-0.3f * 2.f);
    const float l01 = wave_sum(lamp[lane] * lamp[64 + lane]), l23 = wave_sum(lamp[128 + lane] * lamp[192 + lane]);
    const float lam = expf(l01) - expf(l23) + lam_init;
    for (int item = gw; item < MTOT * 8; item += ngw) {
        const int row = item >> 3, h = item & 7;
        const bool lat = row < MLAT;
        const int b = lat ? (row >> 11) : ((row - MLAT) >> 8);
        const int nkl = lat ? 36 : 4;
        { const bf16_t* qp = P + (size_t)row * LD + 2048 + h * 128; qs[lane] = bf2f(qp[lane]) * 0.125f; qs[64 + lane] = bf2f(qp[64 + lane]) * 0.125f; }
        __builtin_amdgcn_wave_barrier();
        float m0 = -1e30f, m1 = -1e30f, l0 = 0.f, l1 = 0.f;
#pragma unroll 1
        for (int jj = 0; jj < nkl; ++jj) {
            const int kk = lane + 64 * jj;
            const int krow = lat ? (kk < 2048 ? b * 2048 + kk : MLAT + b * 256 + kk - 2048) : MLAT + b * 256 + kk;
            const u32x4* kp = (const u32x4*)(P + (size_t)krow * LD + h * 128);
            float d0 = 0.f, d1 = 0.f;
#pragma unroll
            for (int i = 0; i < 8; ++i) { float kf[8]; unpack8(kp[i], kf); const f32x4 qa = *(const LAS f32x4*)(qs + 8 * i), qb = *(const LAS f32x4*)(qs + 8 * i + 4);
                d0 += kf[0] * qa[0] + kf[1] * qa[1] + kf[2] * qa[2] + kf[3] * qa[3] + kf[4] * qb[0] + kf[5] * qb[1] + kf[6] * qb[2] + kf[7] * qb[3]; }
#pragma unroll
            for (int i = 0; i < 8; ++i) { float kf[8]; unpack8(kp[8 + i], kf); const f32x4 qa = *(const LAS f32x4*)(qs + 64 + 8 * i), qb = *(const LAS f32x4*)(qs + 64 + 8 * i + 4);
                d1 += kf[0] * qa[0] + kf[1] * qa[1] + kf[2] * qa[2] + kf[3] * qa[3] + kf[4] * qb[0] + kf[5] * qb[1] + kf[6] * qb[2] + kf[7] * qb[3]; }
            const float n0 = fmaxf(m0, d0), n1 = fmaxf(m1, d1);
            l0 = l0 * __expf(m0 - n0) + __expf(d0 - n0); l1 = l1 * __expf(m1 - n1) + __expf(d1 - n1); m0 = n0; m1 = n1;
        }
        { const float g0 = wave_max(m0), g1 = wave_max(m1); l0 = wave_sum(l0 * __expf(m0 - g0)); l1 = wave_sum(l1 * __expf(m1 - g1)); m0 = g0; m1 = g1; }
        const float i0 = 1.f / l0, i1 = lam / l1;
        float o0 = 0.f, o1 = 0.f;
#pragma unroll 1
        for (int jj = 0; jj < nkl; ++jj) {
            const int kk0 = lane + 64 * jj;
            const int krow0 = lat ? (kk0 < 2048 ? b * 2048 + kk0 : MLAT + b * 256 + kk0 - 2048) : MLAT + b * 256 + kk0;
            const u32x4* kp = (const u32x4*)(P + (size_t)krow0 * LD + h * 128);
            float d0 = 0.f, d1 = 0.f;
#pragma unroll
            for (int i = 0; i < 8; ++i) { float kf[8]; unpack8(kp[i], kf); const f32x4 qa = *(const LAS f32x4*)(qs + 8 * i), qb = *(const LAS f32x4*)(qs + 8 * i + 4);
                d0 += kf[0] * qa[0] + kf[1] * qa[1] + kf[2] * qa[2] + kf[3] * qa[3] + kf[4] * qb[0] + kf[5] * qb[1] + kf[6] * qb[2] + kf[7] * qb[3]; }
#pragma unroll
            for (int i = 0; i < 8; ++i) { float kf[8]; unpack8(kp[8 + i], kf); const f32x4 qa = *(const LAS f32x4*)(qs + 64 + 8 * i), qb = *(const LAS f32x4*)(qs + 64 + 8 * i + 4);
                d1 += kf[0] * qa[0] + kf[1] * qa[1] + kf[2] * qa[2] + kf[3] * qa[3] + kf[4] * qb[0] + kf[5] * qb[1] + kf[6] * qb[2] + kf[7] * qb[3]; }
            const float wv = __expf(d0 - m0) * i0 - __expf(d1 - m1) * i1;
#pragma unroll 4
            for (int src = 0; src < 64; ++src) {
                const int kk = jj * 64 + src;
                const int krow = lat ? (kk < 2048 ? b * 2048 + kk : MLAT + b * 256 + kk - 2048) : MLAT + b * 256 + kk;
                const float p = rdl(wv, src);
                const bf16_t* vp = P + (size_t)krow * LD + 1024 + h * 128;
                o0 += p * bf2f(vp[lane]); o1 += p * bf2f(vp[64 + lane]);
            }
        }
        const float rstd = rsqrtf(wave_sum(o0 * o0 + o1 * o1) * (1.f / 128.f) + 1e-6f) * (1.f - lam_init);
        U[(size_t)row * D + h * 128 + lane] = (bf16_t)f2bf(o0 * rstd * ng[h * 128 + lane]);
        U[(size_t)row * D + h * 128 + 64 + lane] = (bf16_t)f2bf(o1 * rstd * ng[h * 128 + 64 + lane]);
        __builtin_amdgcn_wave_barrier();
    }
}

constexpr int ML_LD = 4352, ML_NKVG = 2064;
__device__ void ml_prep_phase(const bf16_t* P, const float* convw, bf16_t* QC, bf16_t* KC) {
    const int gt = BID() * 512 + TID(), ngt = GDIM() * 512;
    for (long it = gt; it < (long)MTOT * 2048; it += ngt) {
        const int row = (int)(it >> 11), w = (int)(it & 2047), isq = w >> 10, ch = w & 1023;
        const bool lat = row < MLAT;
        const int pos = lat ? (row & 2047) : ((row - MLAT) & 255), len = lat ? 2048 : 256;
        const int col = isq ? (ML_NKVG + ch) : ch;
        const float w0 = convw[0 * 2048 + isq * 1024 + ch], w1 = convw[1 * 2048 + isq * 1024 + ch], w2 = convw[2 * 2048 + isq * 1024 + ch];
        const bf16_t* p = P + (size_t)row * ML_LD + col;
        float v = w1 * bf2f(p[0]);
        if (pos > 0) v += w0 * bf2f(p[-ML_LD]);
        if (pos < len - 1) v += w2 * bf2f(p[ML_LD]);
        v = silu(v);
        if (isq) QC[(size_t)row * D + ch] = (bf16_t)f2bf(v); else KC[(size_t)row * D + ch] = (bf16_t)f2bf(v * 0.0625f);
    }
}
__device__ void ml_scan_naive_phase(const bf16_t* P, const float* G32, const float* gate_b, const bf16_t* QC, const bf16_t* KC, float* HS, LAS unsigned char* lds) {
    const int tid = TID(), dvl = tid & 63, g = tid >> 6;
    LAS float* red = (LAS float*)lds;
    LAS float* redd = red + 2 * 8 * 64;
    for (int item = BID(); item < 256; item += GDIM()) {
        const int dir = item >> 7, b = (item >> 4) & 7, h = (item >> 2) & 3, sl = item & 3;
        const float bi = gate_b[dir * 8 + h], bfg = gate_b[dir * 8 + 4 + h];
        float C[32], n[32];
#pragma unroll
        for (int j = 0; j < 32; ++j) { C[j] = 0.f; n[j] = 0.f; }
        float m = 0.f;
        for (int step = 0; step < CTXL + SEQ; ++step) {
            int row;
            if (step < CTXL) row = MLAT + b * CTXL + (dir ? CTXL - 1 - step : step);
            else { const int s2 = step - CTXL; row = b * SEQ + (dir ? SEQ - 1 - s2 : s2); }
            const float ig = G32[(size_t)row * 32 + dir * 8 + h] + bi, fg = G32[(size_t)row * 32 + dir * 8 + 4 + h] + bfg;
            const float lf = log_sigmoid(fg);
            const float mn = fmaxf(lf + m, ig), fw = __expf(lf + m - mn), iw = __expf(ig - mn);
            m = mn;
            const float v = bf2f(P[(size_t)row * ML_LD + 1024 + h * 256 + sl * 64 + dvl]);
            const u32x4* qp = (const u32x4*)(QC + (size_t)row * D + h * 256 + g * 32);
            const u32x4* kp = (const u32x4*)(KC + (size_t)row * D + h * 256 + g * 32);
            float part = 0.f, dpart = 0.f;
#pragma unroll
            for (int i = 0; i < 4; ++i) {
                float qf[8], kf[8]; unpack8(qp[i], qf); unpack8(kp[i], kf);
#pragma unroll
                for (int e = 0; e < 8; ++e) {
                    const int j = 8 * i + e;
                    C[j] = fw * C[j] + (iw * kf[e]) * v; n[j] = fw * n[j] + iw * kf[e];
                    part += qf[e] * C[j]; dpart += qf[e] * n[j];
                }
            }
            const int pb = step & 1;
            red[(pb * 8 + g) * 64 + dvl] = part;
            if (dvl == 0) redd[pb * 8 + g] = dpart;
            __syncthreads();
            if (tid < 64) {
                float num = 0.f, den = 0.f;
#pragma unroll
                for (int w = 0; w < 8; ++w) { num += red[(pb * 8 + w) * 64 + tid]; den += redd[pb * 8 + w]; }
                HS[((size_t)dir * MTOT + row) * D + h * 256 + sl * 64 + tid] = num / fmaxf(fabsf(den), __expf(-m));
            }
        }
        __syncthreads();
    }
}
__device__ void ml_readout_phase(const bf16_t* P, const float* HS, const float* ng, bf16_t* U) {
    const int lane = TID() & 63, gw = BID() * 8 + (TID() >> 6), ngw = GDIM() * 8;
    for (int row = gw; row < MTOT; row += ngw) {
        const int c0 = lane * 16;
        float v[16]; float ss = 0.f;
#pragma unroll
        for (int i = 0; i < 4; ++i) {
            const f32x4 a0 = *(const f32x4*)(HS + (size_t)row * D + c0 + 4 * i), a1 = *(const f32x4*)(HS + ((size_t)MTOT + row) * D + c0 + 4 * i);
#pragma unroll
            for (int e = 0; e < 4; ++e) { v[4 * i + e] = a0[e] + a1[e]; ss += v[4 * i + e] * v[4 * i + e]; }
        }
        ss += shx(ss, 1); ss += shx(ss, 2); ss += shx(ss, 4); ss += shx(ss, 8);
        const float rstd = rsqrtf(ss * (1.f / 256.f) + 1e-6f);
        const bf16_t* op = P + (size_t)row * ML_LD + ML_NKVG + D + c0;
        unsigned o[8];
#pragma unroll
        for (int i = 0; i < 8; ++i) {
            const float y0 = sigmoidf_(bf2f(op[2 * i])) * v[2 * i] * rstd * ng[c0 + 2 * i], y1 = sigmoidf_(bf2f(op[2 * i + 1])) * v[2 * i + 1] * rstd * ng[c0 + 2 * i + 1];
            o[i] = pk2(y0, y1);
        }
        u32x4* up = (u32x4*)(U + (size_t)row * D + c0);
        up[0] = (u32x4){o[0], o[1], o[2], o[3]}; up[1] = (u32x4){o[4], o[5], o[6], o[7]};
    }
}

constexpr int GL_LD = 3328, GL_NKVG = 1568;
__device__ void gla_prep_phase(const float* G32, const float* wgu, const float* bg, float* LA) {
    const int gt = BID() * 512 + TID(), ngt = GDIM() * 512;
    for (long it = gt; it < (long)2 * MTOT * 512; it += ngt) {
        const int c = (int)(it & 511), row = (int)((it >> 9) % MTOT), dir = (int)(it / ((long)MTOT * 512));
        const float* low = G32 + (size_t)row * 32 + dir * 16;
        float acc = bg[dir * 512 + c];
#pragma unroll
        for (int r = 0; r < 16; ++r) acc += low[r] * wgu[(dir * 16 + r) * 512 + c];
        LA[((size_t)dir * MTOT + row) * 512 + c] = log_sigmoid(acc) * (1.f / 16.f);
    }
}
__device__ void gla_scan_naive_phase(const bf16_t* P, const float* LA, float* HS, LAS unsigned char* lds) {
    const int tid = TID(), dvl = tid & 63, g = tid >> 6;
    LAS float* red = (LAS float*)lds;
    for (int item = BID(); item < 256; item += GDIM()) {
        const int dir = item >> 7, b = (item >> 4) & 7, h = (item >> 2) & 3, sl = item & 3;
        float S[16];
#pragma unroll
        for (int j = 0; j < 16; ++j) S[j] = 0.f;
        for (int step = 0; step < CTXL + SEQ; ++step) {
            int row;
            if (step < CTXL) row = MLAT + b * CTXL + (dir ? CTXL - 1 - step : step);
            else { const int s2 = step - CTXL; row = b * SEQ + (dir ? SEQ - 1 - s2 : s2); }
            const float v = bf2f(P[(size_t)row * GL_LD + 512 + h * 256 + sl * 64 + dvl]);
            const u32x4* kp = (const u32x4*)(P + (size_t)row * GL_LD + h * 128 + g * 16);
            const u32x4* qp = (const u32x4*)(P + (size_t)row * GL_LD + GL_NKVG + h * 128 + g * 16);
            const f32x4* lp = (const f32x4*)(LA + ((size_t)dir * MTOT + row) * 512 + h * 128 + g * 16);
            float part = 0.f;
#pragma unroll
            for (int i = 0; i < 2; ++i) {
                float qf[8], kf[8]; unpack8(qp[i], qf); unpack8(kp[i], kf);
                const f32x4 la0 = lp[2 * i], la1 = lp[2 * i + 1];
#pragma unroll
                for (int e = 0; e < 8; ++e) {
                    const int j = 8 * i + e; const float al = __expf(e < 4 ? la0[e] : la1[e - 4]);
                    S[j] = al * S[j] + kf[e] * v; part += qf[e] * S[j];
                }
            }
            const int pb = step & 1;
            red[(pb * 8 + g) * 64 + dvl] = part;
            __syncthreads();
            if (tid < 64 && step >= CTXL) {
                float num = 0.f;
#pragma unroll
                for (int w = 0; w < 8; ++w) num += red[(pb * 8 + w) * 64 + tid];
                HS[((size_t)dir * MTOT + row) * D + h * 256 + sl * 64 + tid] = num * 0.08838834764831845f;
            }
        }
        __syncthreads();
    }
}
__device__ void gla_readout_phase(const bf16_t* P, const float* HS, const float* ng, bf16_t* U) {
    const int lane = TID() & 63, gw = BID() * 8 + (TID() >> 6), ngw = GDIM() * 8;
    for (int row = gw; row < MLAT; row += ngw) {
        const int c0 = lane * 16;
        float v[16]; float ss = 0.f;
#pragma unroll
        for (int i = 0; i < 4; ++i) {
            const f32x4 a0 = *(const f32x4*)(HS + (size_t)row * D + c0 + 4 * i), a1 = *(const f32x4*)(HS + ((size_t)MTOT + row) * D + c0 + 4 * i);
#pragma unroll
            for (int e = 0; e < 4; ++e) { v[4 * i + e] = a0[e] + a1[e]; ss += v[4 * i + e] * v[4 * i + e]; }
        }
        ss += shx(ss, 1); ss += shx(ss, 2); ss += shx(ss, 4); ss += shx(ss, 8);
        const float rstd = rsqrtf(ss * (1.f / 256.f) + 1e-6f);
        const bf16_t* rp = P + (size_t)row * GL_LD + GL_NKVG + 512 + c0;
        unsigned o[8];
#pragma unroll
        for (int i = 0; i < 8; ++i) {
            const float y0 = silu(bf2f(rp[2 * i])) * v[2 * i] * rstd * ng[c0 + 2 * i], y1 = silu(bf2f(rp[2 * i + 1])) * v[2 * i + 1] * rstd * ng[c0 + 2 * i + 1];
            o[i] = pk2(y0, y1);
        }
        u32x4* up = (u32x4*)(U + (size_t)row * D + c0);
        up[0] = (u32x4){o[0], o[1], o[2], o[3]}; up[1] = (u32x4){o[4], o[5], o[6], o[7]};
    }
}

__device__ __forceinline__ bool phase_exists(int ph) {
    if (ph == 0 || ph == 49) return true;
    const int l = (ph - 1) / 12, k = (ph - 1) % 12;
    if (k == 6 || k == 7) return l != 0 && (k == 6 || (l & 1));
    return true;
}
template <class Epi>
__device__ __forceinline__ void run_gemm(LAS unsigned char* lds, const bf16_t* A, const bf16_t* Bt, int M, int N, int K, const Epi& E) {
    pg8::Gemm g; g.A = A; g.Bt = Bt; g.M = M; g.N = N; g.K = K;
    pg8::StaticOrder S; S.init(M, N, (int)GDIM(), (int)BID());
    pg8::gemm_phase<Epi, pg8::StaticOrder, true, true>(lds, g, S, E);
}
__device__ void run_phase(const Args& a, int ph, LAS unsigned char* lds) {
    unsigned char* ws = a.ws; asm volatile("" : "+s"(ws));
    float* H = (float*)(ws + WS_H); bf16_t* U = (bf16_t*)(ws + WS_U); bf16_t* P = (bf16_t*)(ws + WS_P); float* G32 = (float*)(ws + WS_G32);
    bf16_t* QC = (bf16_t*)(ws + WS_QC); bf16_t* KC = (bf16_t*)(ws + WS_KC); float* HS = (float*)(ws + WS_HS); float* LA = (float*)(ws + WS_QC);
    if (ph == 0) { p0_prologue(a, lds); return; }
    if (ph == 49) { final_norm_phase(H, a.in[I_FINALG], a.out); return; }
    const int l = (ph - 1) / 12, k = (ph - 1) % 12;
    const float* modl = (const float*)(ws + WS_MOD) + (size_t)l * 9 * MODLD;
    const float* ng = a.in[I_NORMG] + (size_t)l * 3 * D;
    switch (k) {
    case 0: norm_phase(H, ng, modl, 0, U, MTOT); break;
    case 1: case 10: { const int f = k == 10 ? 1 : 0; pg8::EpiSwiglu E; E.O = P; E.ldc = DFF; run_gemm(lds, U, (const bf16_t*)(ws + WS_W13T + (size_t)(l * 2 + f) * W13T_SZ), MTOT, 2 * DFF, D, E); } break;
    case 2: case 8: case 11: {
        pg8::EpiResid E; E.H = H; E.gate_ld = MODLD; E.gate = modl + (k == 2 ? 2 : k == 8 ? 5 : 8) * D; E.scale = k == 8 ? 1.0f : 0.5f;
        const bf16_t* A = k == 8 ? U : P; const int K = k == 8 ? D : DFF;
        const bf16_t* Bt = (const bf16_t*)(ws + (k == 8 ? WS_WO + (size_t)l * D * D * 2 : WS_W2T + (size_t)(l * 2 + (k == 11 ? 1 : 0)) * W2T_SZ));
        run_gemm(lds, A, Bt, MTOT, D, K, E);
    } break;
    case 3: norm_phase(H, ng + D, modl, 3, U, MTOT); break;
    case 4: {
        pg8::EpiProj E; E.P = P; E.G32 = G32; E.ldc = NPAD_IN[l]; E.gcol0 = l == 1 ? 2048 : (l == 3 ? 1536 : 1 << 30); E.gn = l == 1 ? 16 : 32;
        const size_t woff = l == 0 ? WS_WIN0 : l == 1 ? WS_WIN1 : l == 2 ? WS_WIN2 : WS_WIN3;
        run_gemm(lds, U, (const bf16_t*)(ws + woff), MTOT, NPAD_IN[l], D, E);
    } break;
    case 5:
        if (l == 0) na_naive_phase(P, a.in[I_NARPB], U, lds);
        else if (l == 1) ml_prep_phase(P, a.in[I_MLCONV], QC, KC);
        else if (l == 2) da_rope_phase(P, (const float*)(ws + WS_ROPE));
        else gla_prep_phase(G32, a.in[I_GLAGU], a.in[I_GLABG], LA);
        break;
    case 6:
        if (l == 1) ml_scan_naive_phase(P, G32, a.in[I_MLGB], QC, KC, HS, lds);
        else if (l == 2) da_naive_phase(P, a.in[I_DALAM], a.in[I_DANG], U, lds);
        else if (l == 3) gla_scan_naive_phase(P, LA, HS, lds);
        break;
    case 7:
        if (l == 1) ml_readout_phase(P, HS, a.in[I_MLNG], U);
        else if (l == 3) gla_readout_phase(P, HS, a.in[I_GLANG], U);
        break;
    case 9: norm_phase(H, ng + 2 * D, modl, 6, U, MTOT); break;
    }
}

constexpr int LDS_BYTES = 135168;
__global__ void __launch_bounds__(512) mega(Args a) {
    extern __shared__ __attribute__((aligned(16))) unsigned char lds_raw[];
    LAS unsigned char* lds = (LAS unsigned char*)lds_raw;
    cg::grid_group grid = cg::this_grid();
    bool first = true;
    for (int ph = a.ph_lo; ph < a.ph_hi; ++ph) {
        if (!phase_exists(ph)) continue;
        if (!first) grid.sync();
        first = false;
        run_phase(a, ph, lds);
        __syncthreads();
    }
}

extern "C" void kernel_launch(void* const* d_in, const int* in_sizes, int n_in, void* d_out, int out_size,
                              void* d_ws, size_t ws_size, hipStream_t stream) {
    static int grid = 0;
    if (grid == 0) {
        int dev = 0, cus = 0, per_cu = 0;
        (void)hipGetDevice(&dev);
        (void)hipDeviceGetAttribute(&cus, hipDeviceAttributeMultiprocessorCount, dev);
        (void)hipFuncSetAttribute((const void*)mega, hipFuncAttributeMaxDynamicSharedMemorySize, LDS_BYTES);
        (void)hipOccupancyMaxActiveBlocksPerMultiprocessor(&per_cu, (const void*)mega, 512, LDS_BYTES);
        grid = cus > 0 ? cus : 256;
        if (n_in != N_IN || ws_size < WS_END) { fprintf(stderr, "kernel_launch: n_in %d ws %zu (need %zu)\n", n_in, ws_size, (size_t)WS_END); }
    }
    Args a{};
    for (int i = 0; i < N_IN; ++i) a.in[i] = (const float*)d_in[i];
    a.out = (float*)d_out; a.ws = (unsigned char*)d_ws; a.ph_lo = 0; a.ph_hi = 50;
    void* args[] = {&a};
    hipError_t e = hipLaunchCooperativeKernel((const void*)mega, dim3(grid), dim3(512), args, LDS_BYTES, stream);
    if (e != hipSuccess) fprintf(stderr, "cooperative launch failed: %s\n", hipGetErrorString(e));
}
```

```cpp
#include <hip/hip_runtime.h>
#include <hip/hip_cooperative_groups.h>
#include <cstdio>
#include <cstdint>
__device__ __forceinline__ int TID() { int t = threadIdx.x; asm volatile("" : "+v"(t)); return t; }
__device__ __forceinline__ int GDIM() { int t = gridDim.x; asm volatile("" : "+s"(t)); return t; }
__device__ __forceinline__ float shx(float v, int o) { const int lane = TID() & 63; return __builtin_bit_cast(float, __builtin_amdgcn_ds_bpermute((lane ^ o) << 2, __builtin_bit_cast(int, v))); }
__device__ __forceinline__ float rdl(float v, int src) { return __builtin_bit_cast(float, __builtin_amdgcn_readlane(__builtin_bit_cast(int, v), src)); }
__device__ __forceinline__ int BID() { int t = blockIdx.x; asm volatile("" : "+s"(t)); return t; }
namespace pg8 {
#define PG8_LAS __attribute__((address_space(3)))
typedef unsigned short bf16_t;
typedef short bf16x8 __attribute__((ext_vector_type(8)));
typedef float f32x4 __attribute__((ext_vector_type(4)));
typedef unsigned u32x4 __attribute__((ext_vector_type(4)));
constexpr int BM = 256, BK = 64, HALF = 128, HTB = HALF * BK * 2  , STAGE_BYTES = 8 * HTB, NXCD = 8, WGM = 8;

__host__ __device__ __forceinline__ int lds_byte(int r, int c) { const int st = (r >> 4) * 2 + (c >> 5), rr = r & 15, cc = c & 31, ob = rr * 64 + cc * 2; return st * 1024 + (ob ^ (((ob >> 9) & 1) << 5)); }
__host__ __device__ __forceinline__ void stage_rc(int b, int& R, int& C) { const int st = b / 1024, sb = b % 1024, swz = sb ^ (((sb >> 9) & 1) << 5); R = (st >> 1) * 16 + swz / 64; C = (st & 1) * 32 + (swz % 64) / 2; }
__host__ __device__ __forceinline__ int perm32(int rho) { const int n = rho >> 4, i = rho & 15; return 8 * (i >> 2) + 4 * n + (i & 3); }

struct Unit { int pm, pn; };
struct Gemm { const bf16_t* A; const bf16_t* Bt; int M, N, K; };

struct StaticOrder {
    int nM, nN, nwg, G, c;
    __host__ __device__ void init(int M, int N, int G_, int c_) { nM = M / BM; nN = N / BM; nwg = nM * nN; G = G_; c = c_; }
    __host__ __device__ bool next(int i, Unit& u) const {
        const long L = (long)i * G + c; if (L >= nwg) return false;
        int wgid = (int)L; { const int q = nwg / NXCD, r = nwg % NXCD, xcd = wgid % NXCD, off = wgid / NXCD; wgid = (xcd < r ? xcd * (q + 1) : r * (q + 1) + (xcd - r) * q) + off; }
        const int nig = WGM * nN, gid = wgid / nig, fm = gid * WGM, gsz = (nM - fm) < WGM ? (nM - fm) : WGM;
        u.pm = fm + ((wgid % nig) % gsz); u.pn = (wgid % nig) / gsz; return true;
    }
    __device__ __forceinline__ void a_ready(const Unit&) const {}
    __device__ __forceinline__ void done(const Unit&) const {}
};

__device__ __forceinline__ unsigned cvt_pk_bf16(float lo, float hi) { unsigned r; asm volatile("v_cvt_pk_bf16_f32 %0, %1, %2" : "=v"(r) : "v"(lo), "v"(hi)); return r; }
typedef unsigned u32x2 __attribute__((ext_vector_type(2)));
__device__ __forceinline__ float silu_f(float x) { return x / (1.f + __expf(-x)); }
struct EpiSwiglu {
    static constexpr bool PERM = true, AFTER_DRAIN = false;
    bf16_t* O; int ldc;
    __device__ __forceinline__ void operator()(const f32x4 (&acc)[2][2][4][2], const Unit& u, int wr, int wc, int fr, int fq) const {
        const int row0 = u.pm * BM + wr * 64 + fr, col0 = u.pn * HALF + wc * 32 + 8 * fq;
#pragma unroll
        for (int ai = 0; ai < 2; ++ai)
#pragma unroll
            for (int m = 0; m < 4; ++m) {
                bf16_t* rowp = O + (size_t)(row0 + ai * HALF + m * 16) * ldc + col0;
                const f32x4 g0 = acc[ai][0][m][0], g1 = acc[ai][0][m][1], u0 = acc[ai][1][m][0], u1 = acc[ai][1][m][1];
                u32x4 w;
                w.x = cvt_pk_bf16(silu_f(g0[0]) * u0[0], silu_f(g0[1]) * u0[1]);
                w.y = cvt_pk_bf16(silu_f(g0[2]) * u0[2], silu_f(g0[3]) * u0[3]);
                w.z = cvt_pk_bf16(silu_f(g1[0]) * u1[0], silu_f(g1[1]) * u1[1]);
                w.w = cvt_pk_bf16(silu_f(g1[2]) * u1[2], silu_f(g1[3]) * u1[3]);
                *(u32x4*)rowp = w;
            }
    }
};
struct EpiResid {
    static constexpr bool PERM = false, AFTER_DRAIN = false;
    float* H; const float* gate; float scale; int gate_ld;
    __device__ __forceinline__ void operator()(const f32x4 (&acc)[2][2][4][2], const Unit& u, int wr, int wc, int fr, int fq) const {
        const int mrow = u.pm < 64 ? (u.pm >> 3) : 8;
        const float* gp = gate + (size_t)mrow * gate_ld;
        const int row0 = u.pm * BM + wr * 64 + fr, col0 = u.pn * BM + wc * 32 + 4 * fq;
#pragma unroll
        for (int bj = 0; bj < 2; ++bj)
#pragma unroll
            for (int n = 0; n < 2; ++n) {
                const int col = col0 + bj * HALF + n * 16;
                f32x4 g = *(const f32x4*)(gp + col); g = g * scale;
#pragma unroll
                for (int ai = 0; ai < 2; ++ai)
#pragma unroll
                    for (int m = 0; m < 4; ++m) {
                        float* hp = H + (size_t)(row0 + ai * HALF + m * 16) * 1024 + col;
                        f32x4 h = *(const f32x4*)hp; h = h + g * acc[ai][bj][m][n]; *(f32x4*)hp = h;
                    }
            }
    }
};
struct EpiProj {
    static constexpr bool PERM = true, AFTER_DRAIN = false;
    bf16_t* P; int ldc; float* G32; int gcol0, gn;
    __device__ __forceinline__ void operator()(const f32x4 (&acc)[2][2][4][2], const Unit& u, int wr, int wc, int fr, int fq) const {
        const int row0 = u.pm * BM + wr * 64 + fr, col0 = u.pn * BM + wc * 32 + 8 * fq;
#pragma unroll
        for (int bj = 0; bj < 2; ++bj) {
            const int col = col0 + bj * HALF;
            const bool gs = (col >= gcol0) && (col < gcol0 + gn);
#pragma unroll
            for (int ai = 0; ai < 2; ++ai)
#pragma unroll
                for (int m = 0; m < 4; ++m) {
                    const size_t row = (size_t)(row0 + ai * HALF + m * 16);
                    const f32x4 v0 = acc[ai][bj][m][0], v1 = acc[ai][bj][m][1];
                    u32x4 w; w.x = cvt_pk_bf16(v0[0], v0[1]); w.y = cvt_pk_bf16(v0[2], v0[3]); w.z = cvt_pk_bf16(v1[0], v1[1]); w.w = cvt_pk_bf16(v1[2], v1[3]);
                    *(u32x4*)(P + row * ldc + col) = w;
                    if (gs) { float* gp = G32 + row * 32 + (col - gcol0); *(f32x4*)gp = v0; *(f32x4*)(gp + 4) = v1; }
                }
        }
    }
};

struct EpiProjAttn {
    static constexpr bool PERM = false, AFTER_DRAIN = false;
    bf16_t* P; bf16_t* VT; const float* R; int rope;
    __device__ __forceinline__ void operator()(const f32x4 (&acc)[2][2][4][2], const Unit& u, int wr, int wc, int fr, int fq) const {
        const int sec = u.pn >> 2;
        const int row0 = u.pm * BM + wr * 64 + fr, col0 = u.pn * BM + wc * 32 + 4 * fq;
        if (sec == 1) {
#pragma unroll
            for (int ai = 0; ai < 2; ++ai)
#pragma unroll
                for (int m = 0; m < 4; ++m) {
                    const int row = row0 + ai * HALF + m * 16;
#pragma unroll
                    for (int bj = 0; bj < 2; ++bj)
#pragma unroll
                        for (int n = 0; n < 2; ++n) {
                            const int col = col0 + bj * HALF + n * 16 - 1024;
                            const f32x4 v = acc[ai][bj][m][n];
#pragma unroll
                            for (int e = 0; e < 4; ++e) VT[(size_t)(col + e) * 18432 + row] = (bf16_t)(cvt_pk_bf16(v[e], 0.f) & 0xffffu);
                        }
                }
            return;
        }
        const float sc = sec == 2 ? 0.125f : 1.f;
        const bool do_rope = rope && u.pm < 64;
        const int axis = wc & 1;
#pragma unroll
        for (int ai = 0; ai < 2; ++ai)
#pragma unroll
            for (int m = 0; m < 4; ++m) {
                const int row = row0 + ai * HALF + m * 16;
                f32x4 cs = (f32x4){1.f, 1.f, 1.f, 1.f}, sn = (f32x4){0.f, 0.f, 0.f, 0.f};
                if (do_rope) { const int t = row & 2047, pos = axis ? (t & 63) : (t >> 6); cs = *(const f32x4*)(R + pos * 16 + 4 * fq); sn = *(const f32x4*)(R + 1024 + pos * 16 + 4 * fq); }
#pragma unroll
                for (int bj = 0; bj < 2; ++bj) {
                    const f32x4 x1 = acc[ai][bj][m][0] * sc, x2 = acc[ai][bj][m][1] * sc;
                    const f32x4 y1 = x1 * cs - x2 * sn, y2 = x2 * cs + x1 * sn;
                    bf16_t* pp = P + (size_t)row * 3072 + col0 + bj * HALF;
                    u32x2 o1, o2; o1.x = cvt_pk_bf16(y1[0], y1[1]); o1.y = cvt_pk_bf16(y1[2], y1[3]); o2.x = cvt_pk_bf16(y2[0], y2[1]); o2.y = cvt_pk_bf16(y2[2], y2[3]);
                    *(u32x2*)pp = o1; *(u32x2*)(pp + 16) = o2;
                }
            }
    }
};

template <class Epi, class Sched, bool ALIGN_EPI = false, bool SP2 = false>
__device__ __forceinline__ void gemm_phase(PG8_LAS unsigned char* lds, const Gemm g, const Sched& S, const Epi& E) {
    const int tid = TID(), wid = __builtin_amdgcn_readfirstlane(tid >> 6), lane = tid & 63, wr = wid >> 2, wc = wid & 3, fr = lane & 15, fq = lane >> 4;
    const int K = g.K, nt = K / BK;
    unsigned voffA[2], voffB[2];
#pragma unroll
    for (int i = 0; i < 2; ++i) { int R, C; stage_rc(tid * 16 + i * 8192, R, C); const int Rb = Epi::PERM ? ((R & ~31) + perm32(R & 31)) : R;
        voffA[i] = (unsigned)(R * K + C) * 2u; voffB[i] = (unsigned)(Rb * K + C) * 2u; }
    const size_t kstep = (size_t)(BK * 2);
    const size_t hstep = (size_t)HALF * K * 2;
    const size_t tstep = 2 * hstep;
    const unsigned ldsw = (unsigned)wid * 1024u;
    const int aoff = lds_byte(wr * 64 + fr, fq * 8), boff = lds_byte(wc * 32 + fr, fq * 8);
#define PG8_SA(b, h) (((b) * 2 + (h)) * HTB)
#define PG8_SB(b, h) ((4 + (b) * 2 + (h)) * HTB)
#define PG8_STAGE(bufoff, gbase, voff) do { _Pragma("unroll") for (int _i = 0; _i < 2; ++_i) \
        __builtin_amdgcn_global_load_lds((const unsigned*)((const char*)(gbase) + (voff)[_i]), (PG8_LAS unsigned*)(lds + (bufoff) + ldsw + _i * 8192), 16, 0, 0); } while (0)
#define PG8_LDA(dst, b, h) do { _Pragma("unroll") for (int m = 0; m < 4; ++m) _Pragma("unroll") for (int k = 0; k < 2; ++k) dst[m][k] = *(const PG8_LAS bf16x8*)(lds + PG8_SA(b, h) + aoff + m * 2048 + k * 1024); } while (0)
#define PG8_LDB(dst, b, h) do { _Pragma("unroll") for (int n = 0; n < 2; ++n) _Pragma("unroll") for (int k = 0; k < 2; ++k) dst[n][k] = *(const PG8_LAS bf16x8*)(lds + PG8_SB(b, h) + boff + n * 2048 + k * 1024); } while (0)
#define PG8_MMA(ai, bj, At, Bt) do { __builtin_amdgcn_s_setprio(1); _Pragma("unroll") for (int m = 0; m < 4; ++m) _Pragma("unroll") for (int n = 0; n < 2; ++n) _Pragma("unroll") for (int k = 0; k < 2; ++k) \
        acc[ai][bj][m][n] = __builtin_amdgcn_mfma_f32_16x16x32_bf16(Bt[n][k], At[m][k], acc[ai][bj][m][n], 0, 0, 0); __builtin_amdgcn_s_setprio(0); } while (0)
#define PG8_WAIT_V(n) asm volatile("s_waitcnt vmcnt(" #n ")" ::: "memory")
#define PG8_WAIT_L(n) asm volatile("s_waitcnt lgkmcnt(" #n ")" ::: "memory")
#define PG8_BAR __builtin_amdgcn_s_barrier()
#define PG8_SCHED __builtin_amdgcn_sched_barrier(0)
    Unit cur, nxt; int ui = 0;
    if (!S.next(0, cur)) return;
    f32x4 acc[2][2][4][2];
#pragma unroll
    for (int a = 0; a < 2; ++a)
#pragma unroll
        for (int b = 0; b < 2; ++b)
#pragma unroll
            for (int m = 0; m < 4; ++m)
#pragma unroll
                for (int n = 0; n < 2; ++n) acc[a][b][m][n] = (f32x4){0.f, 0.f, 0.f, 0.f};
    bf16x8 At[4][2], B0[2][2], B1[2][2];
    const char* cA = (const char*)g.A + (size_t)cur.pm * tstep; const char* cB = (const char*)g.Bt + (size_t)cur.pn * tstep;
    S.a_ready(cur);
    if constexpr (SP2) {
        PG8_STAGE(PG8_SB(0, 0), cB, voffB); PG8_STAGE(PG8_SB(0, 1), cB + hstep, voffB); PG8_STAGE(PG8_SA(0, 0), cA, voffA); PG8_STAGE(PG8_SA(0, 1), cA + hstep, voffA);
        if (wr == 1) PG8_BAR;
        PG8_WAIT_V(2); PG8_BAR;
        PG8_STAGE(PG8_SB(1, 0), cB + kstep, voffB); PG8_STAGE(PG8_SA(1, 0), cA + kstep, voffA); PG8_STAGE(PG8_SB(1, 1), cB + hstep + kstep, voffB);
        PG8_WAIT_V(6); PG8_BAR;
    } else {
        PG8_STAGE(PG8_SB(0, 0), cB, voffB); PG8_STAGE(PG8_SA(0, 0), cA, voffA); PG8_STAGE(PG8_SB(0, 1), cB + hstep, voffB); PG8_STAGE(PG8_SA(0, 1), cA + hstep, voffA);
        if (wr == 1) PG8_BAR;
        PG8_WAIT_V(4); PG8_BAR;
        PG8_STAGE(PG8_SB(1, 0), cB + kstep, voffB); PG8_STAGE(PG8_SA(1, 0), cA + kstep, voffA); PG8_STAGE(PG8_SB(1, 1), cB + hstep + kstep, voffB);
        PG8_WAIT_V(6); PG8_BAR;
    }
    for (;;) {
        const bool has_next = S.next(ui + 1, nxt);
        const char* nA = has_next ? (const char*)g.A + (size_t)nxt.pm * tstep : cA; const char* nB = has_next ? (const char*)g.Bt + (size_t)nxt.pn * tstep : cB;
        for (int t = 0; t < nt; t += 2) {
            const bool last = (t == nt - 2);
            const char* a1 = cA + (size_t)(t + 1) * kstep;
            const char* a2 = last ? nA : cA + (size_t)(t + 2) * kstep; const char* b2 = last ? nB : cB + (size_t)(t + 2) * kstep;
            const char* a3 = a2 + kstep; const char* b3 = b2 + kstep;
            if (last && has_next) S.a_ready(nxt);
            if constexpr (SP2) {
            PG8_LDB(B0, 0, 0); PG8_LDB(B1, 0, 1); PG8_SCHED; PG8_LDA(At, 0, 0); PG8_STAGE(PG8_SA(1, 1), a1 + hstep, voffA);
            PG8_WAIT_V(8); PG8_WAIT_L(0); PG8_BAR; PG8_MMA(0, 0, At, B0); PG8_MMA(0, 1, At, B1); PG8_BAR; PG8_SCHED;
            PG8_LDA(At, 0, 1); PG8_STAGE(PG8_SB(0, 0), b2, voffB); PG8_STAGE(PG8_SB(0, 1), b2 + hstep, voffB); PG8_STAGE(PG8_SA(0, 0), a2, voffA);
            PG8_WAIT_V(8); PG8_WAIT_L(0); PG8_BAR; PG8_MMA(1, 0, At, B0); PG8_MMA(1, 1, At, B1); PG8_BAR; PG8_SCHED;
            PG8_LDB(B0, 1, 0); PG8_LDB(B1, 1, 1); PG8_SCHED; PG8_LDA(At, 1, 0); PG8_STAGE(PG8_SA(0, 1), a2 + hstep, voffA);
            PG8_WAIT_V(8); PG8_WAIT_L(0); PG8_BAR; PG8_MMA(0, 0, At, B0); PG8_MMA(0, 1, At, B1); PG8_BAR; PG8_SCHED;
            PG8_LDA(At, 1, 1); PG8_STAGE(PG8_SB(1, 0), b3, voffB); PG8_STAGE(PG8_SB(1, 1), b3 + hstep, voffB); PG8_STAGE(PG8_SA(1, 0), a3, voffA);
            PG8_WAIT_V(8); PG8_WAIT_L(0); PG8_BAR; PG8_MMA(1, 0, At, B0); PG8_MMA(1, 1, At, B1); PG8_BAR; PG8_SCHED;
            } else {
            PG8_LDB(B0, 0, 0); PG8_SCHED; PG8_LDA(At, 0, 0); PG8_STAGE(PG8_SA(1, 1), a1 + hstep, voffA);
            PG8_WAIT_L(8); PG8_BAR; PG8_WAIT_L(0); PG8_MMA(0, 0, At, B0); PG8_BAR; PG8_SCHED;
            PG8_LDB(B1, 0, 1); PG8_STAGE(PG8_SB(0, 0), b2, voffB);
            PG8_BAR; PG8_WAIT_L(0); PG8_MMA(0, 1, At, B1); PG8_BAR;
            PG8_LDA(At, 0, 1); PG8_STAGE(PG8_SA(0, 0), a2, voffA);
            PG8_BAR; PG8_WAIT_L(0); PG8_MMA(1, 0, At, B0); PG8_BAR; PG8_SCHED;
            PG8_STAGE(PG8_SB(0, 1), b2 + hstep, voffB);
            PG8_WAIT_V(6); PG8_BAR; PG8_MMA(1, 1, At, B1); PG8_BAR;
            PG8_LDB(B0, 1, 0); PG8_SCHED; PG8_LDA(At, 1, 0); PG8_STAGE(PG8_SA(0, 1), a2 + hstep, voffA);
            PG8_WAIT_L(8); PG8_BAR; PG8_WAIT_L(0); PG8_MMA(0, 0, At, B0); PG8_BAR; PG8_SCHED;
            PG8_LDB(B1, 1, 1); PG8_STAGE(PG8_SB(1, 0), b3, voffB);
            PG8_BAR; PG8_WAIT_L(0); PG8_MMA(0, 1, At, B1); PG8_BAR;
            PG8_LDA(At, 1, 1); PG8_STAGE(PG8_SA(1, 0), a3, voffA);
            PG8_BAR; PG8_WAIT_L(0); PG8_MMA(1, 0, At, B0); PG8_BAR; PG8_SCHED;
            PG8_STAGE(PG8_SB(1, 1), b3 + hstep, voffB);
            PG8_WAIT_V(6); PG8_BAR; PG8_MMA(1, 1, At, B1); PG8_BAR;
            }
        }
        if constexpr (ALIGN_EPI) { if (wr == 0) PG8_BAR; }
        if constexpr (!Epi::AFTER_DRAIN) { E(acc, cur, wr, wc, fr, fq); S.done(cur); }
        if (!has_next) break;
#pragma unroll
        for (int a = 0; a < 2; ++a)
#pragma unroll
            for (int b = 0; b < 2; ++b)
#pragma unroll
                for (int m = 0; m < 4; ++m)
#pragma unroll
                    for (int n = 0; n < 2; ++n) acc[a][b][m][n] = (f32x4){0.f, 0.f, 0.f, 0.f};
        cur = nxt; cA = nA; cB = nB; ++ui;
        if constexpr (ALIGN_EPI) { if (wr == 1) PG8_BAR; }
    }
    PG8_WAIT_V(0);
    if constexpr (!ALIGN_EPI) { if (wr == 0) PG8_BAR; }
    PG8_BAR;
    if constexpr (Epi::AFTER_DRAIN) { E.fused(acc, cur, wr, wc, fr, fq, lds, wid, lane); S.done(cur); }
#undef PG8_SA
#undef PG8_SB
#undef PG8_STAGE
#undef PG8_LDA
#undef PG8_LDB
#undef PG8_MMA
#undef PG8_WAIT_V
#undef PG8_WAIT_L
#undef PG8_BAR
#undef PG8_SCHED
}
}
namespace cg = cooperative_groups;
typedef unsigned short bf16_t;
typedef float f32x4 __attribute__((ext_vector_type(4)));
typedef unsigned u32x4 __attribute__((ext_vector_type(4)));
typedef unsigned u32x2 __attribute__((ext_vector_type(2)));
#define LAS __attribute__((address_space(3)))

constexpr int D = 1024, NB = 8, SEQ = 2048, CTXL = 256, DFF = 2816;
constexpr int MLAT = NB * SEQ, MCTX = NB * CTXL, MTOT = MLAT + MCTX;
constexpr int MODLD = 9 * D;
enum { I_X = 0, I_C, I_CTX, I_CCTX, I_ADAW, I_ADAB, I_NORMG, I_W13, I_W2, I_FINALG, I_NAW, I_NARPB, I_NAWO, I_MLW, I_MLGB, I_MLCONV, I_MLNG, I_MLWO,
       I_DAW, I_DALAM, I_DANG, I_DAWO, I_GLAW, I_GLAGU, I_GLABG, I_GLANG, I_GLAWO, N_IN };
constexpr int NPAD_IN[4] = {3072, 4352, 3072, 3328};
constexpr int N_IN_REAL[4] = {3072, 4112, 3072, 3104};
constexpr size_t al256(size_t x) { return (x + 255) & ~(size_t)255; }
constexpr size_t WS_MOD = 0;
constexpr size_t WS_ROPE = al256(WS_MOD + (size_t)4 * 9 * MODLD * 4);
constexpr size_t WS_W13T = al256(WS_ROPE + 2 * 64 * 16 * 4);
constexpr size_t W13T_SZ = (size_t)2 * DFF * D * 2;
constexpr size_t WS_W2T = WS_W13T + 8 * W13T_SZ;
constexpr size_t W2T_SZ = (size_t)D * DFF * 2;
constexpr size_t WS_WIN0 = WS_W2T + 8 * W2T_SZ;
constexpr size_t WS_WIN1 = WS_WIN0 + (size_t)3072 * D * 2;
constexpr size_t WS_WIN2 = WS_WIN1 + (size_t)4352 * D * 2;
constexpr size_t WS_WIN3 = WS_WIN2 + (size_t)3072 * D * 2;
constexpr size_t WS_WO = WS_WIN3 + (size_t)3328 * D * 2;
constexpr size_t WS_H = WS_WO + (size_t)4 * D * D * 2;
constexpr size_t WS_U = WS_H + (size_t)MTOT * D * 4;
constexpr size_t WS_P = WS_U + (size_t)MTOT * D * 2;
constexpr size_t WS_G32 = WS_P + (size_t)MTOT * 4352 * 2;
constexpr size_t WS_QC = WS_G32 + (size_t)MTOT * 32 * 4;
constexpr size_t WS_KC = WS_QC + (size_t)MTOT * D * 2;
constexpr size_t WS_HS = WS_KC + (size_t)MTOT * D * 2;
constexpr size_t WS_VT = WS_HS + (size_t)2 * MTOT * D * 4;
constexpr size_t WS_END = WS_VT + (size_t)D * MTOT * 2;

struct Args { const float* in[N_IN]; float* out; unsigned char* ws; int ph_lo, ph_hi; };

__device__ __forceinline__ unsigned f2bf(float f) { unsigned u = __builtin_bit_cast(unsigned, f); return (u + 0x7fffu + ((u >> 16) & 1u)) >> 16; }
__device__ __forceinline__ unsigned pk2(float lo, float hi) { return f2bf(lo) | (f2bf(hi) << 16); }
__device__ __forceinline__ float bf2f(unsigned short b) { return __builtin_bit_cast(float, (unsigned)b << 16); }
__device__ __forceinline__ float bflo(unsigned w) { return __builtin_bit_cast(float, w << 16); }
__device__ __forceinline__ float bfhi(unsigned w) { return __builtin_bit_cast(float, w & 0xffff0000u); }
__device__ __forceinline__ float wave_sum(float v) {
#pragma unroll
    for (int o = 1; o < 64; o <<= 1) v += shx(v, o);
    return v;
}
__device__ __forceinline__ float wave_max(float v) {
#pragma unroll
    for (int o = 1; o < 64; o <<= 1) v = fmaxf(v, shx(v, o));
    return v;
}
__device__ __forceinline__ float silu(float x) { return x / (1.f + __expf(-x)); }
__device__ __forceinline__ float sigmoidf_(float x) { return 1.f / (1.f + __expf(-x)); }
__device__ __forceinline__ float log_sigmoid(float x) { return fminf(x, 0.f) - log1pf(__expf(-fabsf(x))); }

struct WDesc { const float* src; bf16_t* dst; int K, N, Npad, perm, tiles; };
__device__ __forceinline__ WDesc get_wdesc(const Args& a, unsigned char* ws, int mi) {
    WDesc w;
    if (mi < 8) { w.src = a.in[I_W13] + (size_t)mi * D * 2 * DFF; w.dst = (bf16_t*)(ws + WS_W13T + mi * W13T_SZ); w.K = D; w.N = 2 * DFF; w.Npad = 2 * DFF; w.perm = 1; }
    else if (mi < 16) { const int j = mi - 8; w.src = a.in[I_W2] + (size_t)j * DFF * D; w.dst = (bf16_t*)(ws + WS_W2T + j * W2T_SZ); w.K = DFF; w.N = D; w.Npad = D; w.perm = 0; }
    else if (mi < 20) { const int j = mi - 16;
        w.src = a.in[j == 0 ? I_NAW : j == 1 ? I_MLW : j == 2 ? I_DAW : I_GLAW];
        w.dst = (bf16_t*)(ws + (j == 0 ? WS_WIN0 : j == 1 ? WS_WIN1 : j == 2 ? WS_WIN2 : WS_WIN3));
        w.K = D; w.N = j == 0 ? 3072 : j == 1 ? 4112 : j == 2 ? 3072 : 3104; w.Npad = j == 0 ? 3072 : j == 1 ? 4352 : j == 2 ? 3072 : 3328; w.perm = 0; }
    else { const int j = mi - 20; w.src = a.in[j == 0 ? I_NAWO : j == 1 ? I_MLWO : j == 2 ? I_DAWO : I_GLAWO]; w.dst = (bf16_t*)(ws + WS_WO + (size_t)j * D * D * 2); w.K = D; w.N = D; w.Npad = D; w.perm = 0; }
    w.tiles = (w.K / 64) * (w.Npad / 64);
    return w;
}
constexpr int TILES_W13 = 16 * 88, TILES_W2 = 44 * 16, TILES_WO = 256;
constexpr int TILES_TOTAL = 8 * TILES_W13 + 8 * TILES_W2 + 16 * (48 + 68 + 48 + 52) + 4 * TILES_WO;

__device__ void p0_prologue(const Args& a, LAS unsigned char* lds) {
    const int tid = TID(), lane = tid & 63, wid = tid >> 6;
    unsigned char* ws = a.ws; asm volatile("" : "+s"(ws));
    {
        LAS float* S = (LAS float*)lds;
        LAS float* red = (LAS float*)(lds + 9 * 1024 * 4);
        for (int i = tid; i < 9 * 1024; i += 512) { const float v = i < 8 * 1024 ? a.in[I_C][i] : a.in[I_CCTX][i - 8 * 1024]; S[i] = silu(v); }
        __syncthreads();
        float* MOD = (float*)(ws + WS_MOD);
        for (int item = BID(); item < 4 * 144; item += GDIM()) {
            const int l = item / 144, cgp = item % 144;
            const int cq = tid & 15, kg = tid >> 4;
            const float* W = a.in[I_ADAW] + (size_t)l * D * MODLD + cgp * 64 + cq * 4;
            f32x4 acc[9];
#pragma unroll
            for (int r = 0; r < 9; ++r) acc[r] = (f32x4){0.f, 0.f, 0.f, 0.f};
#pragma unroll 4
            for (int kk = 0; kk < 32; ++kk) {
                const int k = kg * 32 + kk;
                const f32x4 w4 = *(const f32x4*)(W + (size_t)k * MODLD);
#pragma unroll
                for (int r = 0; r < 9; ++r) acc[r] = acc[r] + w4 * S[r * 1024 + k];
            }
#pragma unroll
            for (int r = 0; r < 9; ++r)
#pragma unroll
                for (int e = 0; e < 4; ++e) { float v = acc[r][e]; v += shx(v, 16); v += shx(v, 32); acc[r][e] = v; }
            if (lane < 16) {
#pragma unroll
                for (int r = 0; r < 9; ++r)
#pragma unroll
                    for (int e = 0; e < 4; ++e) red[(wid * 9 + r) * 64 + cq * 4 + e] = acc[r][e];
            }
            __syncthreads();
            for (int o = tid; o < 9 * 64; o += 512) {
                const int r = o >> 6, cc = o & 63; float v = 0.f;
#pragma unroll
                for (int w = 0; w < 8; ++w) v += red[(w * 9 + r) * 64 + cc];
                const int col = cgp * 64 + cc;
                MOD[((size_t)l * 9 + r) * MODLD + col] = v + a.in[I_ADAB][(size_t)l * MODLD + col];
            }
            __syncthreads();
        }
    }
    {
        LAS float* tile = (LAS float*)lds;
        for (int item = BID(); item < TILES_TOTAL; item += GDIM()) {
            int mi, t = item;
            if (t < 8 * TILES_W13) { mi = t / TILES_W13; t -= mi * TILES_W13; }
            else if (t < 8 * TILES_W13 + 8 * TILES_W2) { t -= 8 * TILES_W13; mi = t / TILES_W2; t -= mi * TILES_W2; mi += 8; }
            else { t -= 8 * TILES_W13 + 8 * TILES_W2;
                if (t < 16 * 48) { mi = 16; } else if (t < 16 * (48 + 68)) { mi = 17; t -= 16 * 48; } else if (t < 16 * (48 + 68 + 48)) { mi = 18; t -= 16 * (48 + 68); }
                else if (t < 16 * (48 + 68 + 48 + 52)) { mi = 19; t -= 16 * (48 + 68 + 48); } else { t -= 16 * (48 + 68 + 48 + 52); mi = 20 + t / TILES_WO; t = t % TILES_WO; } }
            const WDesc w = get_wdesc(a, ws, mi);
            const int ntn = w.Npad / 64, kt = t / ntn, nt = t % ntn, k0 = kt * 64, n0 = nt * 64;
            {
                const int nn = tid & 63, n = n0 + nn;
#pragma unroll
                for (int i = 0; i < 8; ++i) { const int kk = (tid >> 6) + 8 * i; tile[kk * 65 + nn] = n < w.N ? w.src[(size_t)(k0 + kk) * w.N + n] : 0.f; }
            }
            __syncthreads();
            {
                const int kp = tid & 31;
#pragma unroll
                for (int i = 0; i < 4; ++i) {
                    const int nn = (tid >> 5) + 16 * i, n = n0 + nn;
                    int drow = n;
                    if (w.perm) { const int half = n >= DFF ? 1 : 0, jj = n - half * DFF; drow = (jj >> 7) * 256 + half * 128 + (jj & 127); }
                    *(unsigned*)(w.dst + (size_t)drow * w.K + k0 + 2 * kp) = pk2(tile[(2 * kp) * 65 + nn], tile[(2 * kp + 1) * 65 + nn]);
                }
            }
            __syncthreads();
        }
    }
    {
        f32x4* H4 = (f32x4*)(ws + WS_H);
        const f32x4* x4 = (const f32x4*)a.in[I_X]; const f32x4* c4 = (const f32x4*)a.in[I_CTX];
        const int n1 = MLAT * D / 4, n2 = MTOT * D / 4;
        for (int i = BID() * 512 + tid; i < n2; i += GDIM() * 512) H4[i] = i < n1 ? x4[i] : c4[i - n1];
    }
    if (BID() == 0) {
        float* R = (float*)(ws + WS_ROPE);
        for (int i = tid; i < 64 * 16; i += 512) { const int pos = i >> 4, fi = i & 15; const float f = powf(10000.f, -(float)fi / 16.f); const float ang = (float)pos * f; R[i] = cosf(ang); R[1024 + i] = sinf(ang); }
    }
}

__device__ void norm_phase(const float* H, const float* g, const float* modl  , int slot_shift, bf16_t* U, int nrows) {
    const int lane = TID() & 63, gw = BID() * 8 + (TID() >> 6), ngw = GDIM() * 8;
    f32x4 gv[4];
#pragma unroll
    for (int j = 0; j < 4; ++j) gv[j] = *(const f32x4*)(g + j * 256 + lane * 4);
    for (int row = gw; row < nrows; row += ngw) {
        const int mrow = row < MLAT ? (row >> 11) : 8;
        const float* sh = modl + (size_t)mrow * MODLD + slot_shift * D; const float* sc = sh + D;
        f32x4 v[4]; float s = 0.f;
#pragma unroll
        for (int j = 0; j < 4; ++j) { v[j] = *(const f32x4*)(H + (size_t)row * D + j * 256 + lane * 4); s += (v[j][0] * v[j][0] + v[j][1] * v[j][1]) + (v[j][2] * v[j][2] + v[j][3] * v[j][3]); }
        const float rstd = rsqrtf(wave_sum(s) * (1.f / D) + 1e-6f);
#pragma unroll
        for (int j = 0; j < 4; ++j) {
            const f32x4 s4 = *(const f32x4*)(sh + j * 256 + lane * 4), c4 = *(const f32x4*)(sc + j * 256 + lane * 4);
            const f32x4 y = (v[j] * rstd) * gv[j] * (c4 + 1.f) + s4;
            u32x2 o; o.x = pk2(y[0], y[1]); o.y = pk2(y[2], y[3]);
            *(u32x2*)(U + (size_t)row * D + j * 256 + lane * 4) = o;
        }
    }
}
__device__ void final_norm_phase(const float* H, const float* g, float* out) {
    const int lane = TID() & 63, gw = BID() * 8 + (TID() >> 6), ngw = GDIM() * 8;
    f32x4 gv[4];
#pragma unroll
    for (int j = 0; j < 4; ++j) gv[j] = *(const f32x4*)(g + j * 256 + lane * 4);
    for (int row = gw; row < MLAT; row += ngw) {
        f32x4 v[4]; float s = 0.f;
#pragma unroll
        for (int j = 0; j < 4; ++j) { v[j] = *(const f32x4*)(H + (size_t)row * D + j * 256 + lane * 4); s += (v[j][0] * v[j][0] + v[j][1] * v[j][1]) + (v[j][2] * v[j][2] + v[j][3] * v[j][3]); }
        const float rstd = rsqrtf(wave_sum(s) * (1.f / D) + 1e-6f);
#pragma unroll
        for (int j = 0; j < 4; ++j) *(f32x4*)(out + (size_t)row * D + j * 256 + lane * 4) = (v[j] * rstd) * gv[j];
    }
}

__device__ __forceinline__ void unpack8(const u32x4 w, float* f) { f[0] = bflo(w.x); f[1] = bfhi(w.x); f[2] = bflo(w.y); f[3] = bfhi(w.y); f[4] = bflo(w.z); f[5] = bfhi(w.z); f[6] = bflo(w.w); f[7] = bfhi(w.w); }
__device__ void na_naive_phase(const bf16_t* P, const float* rpb, bf16_t* U, LAS unsigned char* lds) {
    constexpr int LD = 3072;
    const int lane = TID() & 63, gw = BID() * 8 + (TID() >> 6), ngw = GDIM() * 8;
    for (int item = gw; item < MTOT * 16; item += ngw) {
        const int row = item >> 4, h = item & 15;
        const bool lat = row < MLAT;
        const int b = lat ? (row >> 11) : ((row - MLAT) >> 8);
        const int t = row & 2047, r = t >> 6, c = t & 63;
        const int r0 = min(max(r - 4, 0), 24), win0 = min(max(c - 8, 0), 48);
        const int nk = lat ? 384 : 256;
        LAS float* q = (LAS float*)lds + (TID() >> 6) * 64;
        q[lane] = bf2f(P[(size_t)row * LD + 2048 + h * 64 + lane]);
        __builtin_amdgcn_wave_barrier();
        float s[6];
#pragma unroll
        for (int jj = 0; jj < 6; ++jj) s[jj] = -1e30f;
#pragma unroll 1
        for (int jj = 0; jj < 6; ++jj) {
            const int kk = lane + 64 * jj;
            float val = -1e30f;
            if (kk < nk) {
                int krow; float bias = 0.f;
                if (lat && kk < 128) { const int kr = r0 + (kk >> 4), kc = win0 + (kk & 15); krow = b * 2048 + kr * 64 + kc; bias = rpb[(h * 15 + (kr - r + 7)) * 31 + (kc - c + 15)]; }
                else krow = MLAT + b * 256 + (lat ? kk - 128 : kk);
                const u32x4* kp = (const u32x4*)(P + (size_t)krow * LD + h * 64);
                float d = 0.f;
#pragma unroll
                for (int i = 0; i < 8; ++i) { float kf[8]; unpack8(kp[i], kf); const f32x4 qa = *(const LAS f32x4*)(q + 8 * i), qb = *(const LAS f32x4*)(q + 8 * i + 4);
                    d += kf[0] * qa[0] + kf[1] * qa[1] + kf[2] * qa[2] + kf[3] * qa[3] + kf[4] * qb[0] + kf[5] * qb[1] + kf[6] * qb[2] + kf[7] * qb[3]; }
                val = d * 0.125f + bias;
            }
#pragma unroll
            for (int k2 = 0; k2 < 6; ++k2) s[k2] = (jj == k2) ? val : s[k2];
        }
        float mx = s[0];
#pragma unroll
        for (int jj = 1; jj < 6; ++jj) mx = fmaxf(mx, s[jj]);
        mx = wave_max(mx);
        float sum = 0.f;
#pragma unroll
        for (int jj = 0; jj < 6; ++jj) { s[jj] = (lane + 64 * jj < nk) ? __expf(s[jj] - mx) : 0.f; sum += s[jj]; }
        sum = wave_sum(sum);
        float o = 0.f;
#pragma unroll
        for (int jj = 0; jj < 6; ++jj) {
            if (jj * 64 < nk) {
#pragma unroll 4
                for (int src = 0; src < 64; ++src) {
                    const int kk = jj * 64 + src;
                    const float p = rdl(s[jj], src);
                    int krow;
                    if (lat && kk < 128) krow = b * 2048 + (r0 + (kk >> 4)) * 64 + win0 + (kk & 15); else krow = MLAT + b * 256 + (lat ? kk - 128 : kk);
                    o += p * bf2f(P[(size_t)krow * LD + 1024 + h * 64 + lane]);
                }
            }
        }
        U[(size_t)row * D + h * 64 + lane] = (bf16_t)f2bf(o / sum);
        __builtin_amdgcn_wave_barrier();
    }
}

__device__ void da_rope_phase(bf16_t* P, const float* R) {
    constexpr int LD = 3072;
    const int gt = BID() * 512 + TID(), ngt = GDIM() * 512;
    for (long it = gt; it < (long)MLAT * 1024; it += ngt) {
        const int row = (int)(it >> 10), w = (int)(it & 1023), sec = w >> 9, grp = (w >> 5) & 15, axis = (w >> 4) & 1, i = w & 15;
        const int t = row & 2047, pos = axis ? (t & 63) : (t >> 6);
        const float cs = R[pos * 16 + i], sn = R[1024 + pos * 16 + i];
        bf16_t* p = P + (size_t)row * LD + sec * 2048 + grp * 64 + axis * 32 + i;
        const float x1 = bf2f(p[0]), x2 = bf2f(p[16]);
        p[0] = (bf16_t)f2bf(x1 * cs - x2 * sn); p[16] = (bf16_t)f2bf(x2 * cs + x1 * sn);
    }
}
__device__ void da_naive_phase(const bf16_t* P, const float* lamp, const float* ng, bf16_t* U, LAS unsigned char* lds) {
    constexpr int LD = 3072;
    const int lane = TID() & 63, wid = TID() >> 6, gw = BID() * 8 + wid, ngw = GDIM() * 8;
    LAS float* qs = (LAS float*)lds + wid * 128;
    const float lam_init = 0.8f - 0.6f * expf(-0.3f * 2.f);
    const float l01 = wave_sum(lamp[lane] * lamp[64 + lane]), l23 = wave_sum(lamp[128 + lane] * lamp[192 + lane]);
    const float lam = expf(l01) - expf(l23) + lam_init;
    for (int item = gw; item < MTOT * 8; item += ngw) {
        const int row = item >> 3, h = item & 7;
        const bool lat = row < MLAT;
        const int b = lat ? (row >> 11) : ((row - MLAT) >> 8);
        const int nkl = lat ? 36 : 4;
        { const bf16_t* qp = P + (size_t)row * LD + 2048 + h * 128; qs[lane] = bf2f(qp[lane]) * 0.125f; qs[64 + lane] = bf2f(qp[64 + lane]) * 0.125f; }
        __builtin_amdgcn_wave_barrier();
        float m0 = -1e30f, m1 = -1e30f, l0 = 0.f, l1 = 0.f;
#pragma unroll 1
        for (int jj = 0; jj < nkl; ++jj) {
            const int kk = lane + 64 * jj;
            const int krow = lat ? (kk < 2048 ? b * 2048 + kk : MLAT + b * 256 + kk - 2048) : MLAT + b * 256 + kk;
            const u32x4* kp = (const u32x4*)(P + (size_t)krow * LD + h * 128);
            float d0 = 0.f, d1 = 0.f;
#pragma unroll
            for (int i = 0; i < 8; ++i) { float kf[8]; unpack8(kp[i], kf); const f32x4 qa = *(const LAS f32x4*)(qs + 8 * i), qb = *(const LAS f32x4*)(qs + 8 * i + 4);
                d0 += kf[0] * qa[0] + kf[1] * qa[1] + kf[2] * qa[2] + kf[3] * qa[3] + kf[4] * qb[0] + kf[5] * qb[1] + kf[6] * qb[2] + kf[7] * qb[3]; }
#pragma unroll
            for (int i = 0; i < 8; ++i) { float kf[8]; unpack8(kp[8 + i], kf); const f32x4 qa = *(const LAS f32x4*)(qs + 64 + 8 * i), qb = *(const LAS f32x4*)(qs + 64 + 8 * i + 4);
                d1 += kf[0] * qa[0] + kf[1] * qa[1] + kf[2] * qa[2] + kf[3] * qa[3] + kf[4] * qb[0] + kf[5] * qb[1] + kf[6] * qb[2] + kf[7] * qb[3]; }
            const float n0 = fmaxf(m0, d0), n1 = fmaxf(m1, d1);
            l0 = l0 * __expf(m0 - n0) + __expf(d0 - n0); l1 = l1 * __expf(m1 - n1) + __expf(d1 - n1); m0 = n0; m1 = n1;
        }
        { const float g0 = wave_max(m0), g1 = wave_max(m1); l0 = wave_sum(l0 * __expf(m0 - g0)); l1 = wave_sum(l1 * __expf(m1 - g1)); m0 = g0; m1 = g1; }
        const float i0 = 1.f / l0, i1 = lam / l1;
        float o0 = 0.f, o1 = 0.f;
#pragma unroll 1
        for (int jj = 0; jj < nkl; ++jj) {
            const int kk0 = lane + 64 * jj;
            const int krow0 = lat ? (kk0 < 2048 ? b * 2048 + kk0 : MLAT + b * 256 + kk0 - 2048) : MLAT + b * 256 + kk0;
            const u32x4* kp = (const u32x4*)(P + (size_t)krow0 * LD + h * 128);
            float d0 = 0.f, d1 = 0.f;
#pragma unroll
            for (int i = 0; i < 8; ++i) { float kf[8]; unpack8(kp[i], kf); const f32x4 qa = *(const LAS f32x4*)(qs + 8 * i), qb = *(const LAS f32x4*)(qs + 8 * i + 4);
                d0 += kf[0] * qa[0] + kf[1] * qa[1] + kf[2] * qa[2] + kf[3] * qa[3] + kf[4] * qb[0] + kf[5] * qb[1] + kf[6] * qb[2] + kf[7] * qb[3]; }
#pragma unroll
            for (int i = 0; i < 8; ++i) { float kf[8]; unpack8(kp[8 + i], kf); const f32x4 qa = *(const LAS f32x4*)(qs + 64 + 8 * i), qb = *(const LAS f32x4*)(qs + 64 + 8 * i + 4);
                d1 += kf[0] * qa[0] + kf[1] * qa[1] + kf[2] * qa[2] + kf[3] * qa[3] + kf[4] * qb[0] + kf[5] * qb[1] + kf[6] * qb[2] + kf[7] * qb[3]; }
            const float wv = __expf(d0 - m0) * i0 - __expf(d1 - m1) * i1;
#pragma unroll 4
            for (int src = 0; src < 64; ++src) {
                const int kk = jj * 64 + src;
                const int krow = lat ? (kk < 2048 ? b * 2048 + kk : MLAT + b * 256 + kk - 2048) : MLAT + b * 256 + kk;
                const float p = rdl(wv, src);
                const bf16_t* vp = P + (size_t)krow * LD + 1024 + h * 128;
                o0 += p * bf2f(vp[lane]); o1 += p * bf2f(vp[64 + lane]);
            }
        }
        const float rstd = rsqrtf(wave_sum(o0 * o0 + o1 * o1) * (1.f / 128.f) + 1e-6f) * (1.f - lam_init);
        U[(size_t)row * D + h * 128 + lane] = (bf16_t)f2bf(o0 * rstd * ng[h * 128 + lane]);
        U[(size_t)row * D + h * 128 + 64 + lane] = (bf16_t)f2bf(o1 * rstd * ng[h * 128 + 64 + lane]);
        __builtin_amdgcn_wave_barrier();
    }
}


typedef short bf16x8 __attribute__((ext_vector_type(8)));
__device__ __forceinline__ bf16x8 pack8(const f32x4 a, const f32x4 b) { u32x4 w; w.x = pk2(a[0], a[1]); w.y = pk2(a[2], a[3]); w.z = pk2(b[0], b[1]); w.w = pk2(b[2], b[3]); return __builtin_bit_cast(bf16x8, w); }
__device__ void da_flash_phase(const bf16_t* P, const bf16_t* VT, const float* lamp, const float* ng, bf16_t* U, LAS unsigned char* lds) {
    constexpr int LD = 3072, KS = 272, VS = 144, KBUF = 64 * KS, VBUF = 128 * VS, BUF = KBUF + VBUF;
    const int tid = TID(), lane = tid & 63, wid = tid >> 6, m16 = lane & 15, quad = lane >> 4;
    const float lam_init = 0.8f - 0.6f * expf(-0.3f * 2.f);
    const float l01 = wave_sum(lamp[lane] * lamp[64 + lane]), l23 = wave_sum(lamp[128 + lane] * lamp[192 + lane]);
    const float lam = expf(l01) - expf(l23) + lam_init;
    const int kkey = tid >> 3, kch = tid & 7, vdv = tid >> 2, vch = tid & 3;
    const int krho = ((kkey >> 5) * 2 + ((kkey >> 2) & 1)) * 16 + ((kkey >> 3) & 3) * 4 + (kkey & 3);
    for (int item = BID(); item < 1024 + 128; item += GDIM()) {
        const bool lat = item < 1024;
        int b, h, qb;
        if (lat) { b = item >> 7; h = (item >> 4) & 7; qb = item & 15; } else { const int i2 = item - 1024; b = i2 >> 4; h = (i2 >> 1) & 7; qb = i2 & 1; }
        const int qrow = (lat ? b * 2048 : MLAT + b * 256) + qb * 128 + wid * 16 + m16;
        const int nblk = lat ? 36 : 4;
        bf16x8 qf[2][2];
        { const bf16_t* qp = P + (size_t)qrow * LD + 2048 + h * 128 + quad * 8;
#pragma unroll
          for (int j = 0; j < 2; ++j)
#pragma unroll
            for (int ks = 0; ks < 2; ++ks) qf[j][ks] = *(const bf16x8*)(qp + j * 64 + ks * 32); }
        f32x4 O[2][8];
#pragma unroll
        for (int j = 0; j < 2; ++j)
#pragma unroll
            for (int dt = 0; dt < 8; ++dt) O[j][dt] = (f32x4){0.f, 0.f, 0.f, 0.f};
        float mrun[2] = {-1e30f, -1e30f}, lrun[2] = {0.f, 0.f};
        u32x4 rk0, rk1, rv0, rv1;
        {
            const int kr0 = lat ? b * 2048 : MLAT + b * 256;
            const bf16_t* kp = P + (size_t)(kr0 + kkey) * LD + h * 128 + kch * 8;
            rk0 = *(const u32x4*)kp; rk1 = *(const u32x4*)(kp + 64);
            const bf16_t* vp = VT + (size_t)(h * 128 + vdv) * MTOT + kr0 + vch * 8;
            rv0 = *(const u32x4*)vp; rv1 = *(const u32x4*)(vp + 32);
            LAS unsigned char* Kb = lds; LAS unsigned char* Vb = lds + KBUF;
            *(LAS u32x4*)(Kb + krho * KS + kch * 16) = rk0; *(LAS u32x4*)(Kb + krho * KS + (kch + 8) * 16) = rk1;
            *(LAS u32x4*)(Vb + vdv * VS + vch * 16) = rv0; *(LAS u32x4*)(Vb + vdv * VS + (vch + 4) * 16) = rv1;
        }
        __syncthreads();
#pragma unroll 1
        for (int kb = 0; kb < nblk; ++kb) {
            const bool more = kb + 1 < nblk;
            if (more) {
                const int k1 = kb + 1;
                const int kr0 = lat ? (k1 < 32 ? b * 2048 + k1 * 64 : MLAT + b * 256 + (k1 - 32) * 64) : MLAT + b * 256 + k1 * 64;
                const bf16_t* kp = P + (size_t)(kr0 + kkey) * LD + h * 128 + kch * 8;
                rk0 = *(const u32x4*)kp; rk1 = *(const u32x4*)(kp + 64);
                const bf16_t* vp = VT + (size_t)(h * 128 + vdv) * MTOT + kr0 + vch * 8;
                rv0 = *(const u32x4*)vp; rv1 = *(const u32x4*)(vp + 32);
            }
            LAS const unsigned char* Kb = lds + (kb & 1) * BUF; LAS const unsigned char* Vb = Kb + KBUF;
            f32x4 st[2][2][2];
#pragma unroll
            for (int sb = 0; sb < 2; ++sb)
#pragma unroll
                for (int j = 0; j < 2; ++j)
#pragma unroll
                    for (int T = 0; T < 2; ++T) {
                        f32x4 acc = (f32x4){0.f, 0.f, 0.f, 0.f};
#pragma unroll
                        for (int ks = 0; ks < 2; ++ks) {
                            const bf16x8 A = *(LAS const bf16x8*)(Kb + ((sb * 2 + T) * 16 + m16) * KS + (j * 64 + ks * 32 + quad * 8) * 2);
                            acc = __builtin_amdgcn_mfma_f32_16x16x32_bf16(A, qf[j][ks], acc, 0, 0, 0);
                        }
                        st[sb][j][T] = acc;
                    }
#pragma unroll
            for (int j = 0; j < 2; ++j) {
                float mx = -1e30f;
#pragma unroll
                for (int sb = 0; sb < 2; ++sb)
#pragma unroll
                    for (int T = 0; T < 2; ++T)
#pragma unroll
                        for (int e = 0; e < 4; ++e) mx = fmaxf(mx, st[sb][j][T][e]);
                mx = fmaxf(mx, shx(mx, 16)); mx = fmaxf(mx, shx(mx, 32));
                const float mnew = fmaxf(mrun[j], mx), alpha = __expf(mrun[j] - mnew);
                mrun[j] = mnew;
                float ps = 0.f;
#pragma unroll
                for (int sb = 0; sb < 2; ++sb)
#pragma unroll
                    for (int T = 0; T < 2; ++T)
#pragma unroll
                        for (int e = 0; e < 4; ++e) { const float pv = __expf(st[sb][j][T][e] - mnew); st[sb][j][T][e] = pv; ps += pv; }
                lrun[j] = lrun[j] * alpha + ps;
#pragma unroll
                for (int dt = 0; dt < 8; ++dt) O[j][dt] = O[j][dt] * alpha;
            }
#pragma unroll
            for (int sb = 0; sb < 2; ++sb) {
                const bf16x8 p0 = pack8(st[sb][0][0], st[sb][0][1]), p1 = pack8(st[sb][1][0], st[sb][1][1]);
#pragma unroll
                for (int dt = 0; dt < 8; ++dt) {
                    const bf16x8 A = *(LAS const bf16x8*)(Vb + (dt * 16 + m16) * VS + (sb * 32 + quad * 8) * 2);
                    O[0][dt] = __builtin_amdgcn_mfma_f32_16x16x32_bf16(A, p0, O[0][dt], 0, 0, 0);
                    O[1][dt] = __builtin_amdgcn_mfma_f32_16x16x32_bf16(A, p1, O[1][dt], 0, 0, 0);
                }
            }
            if (more) {
                LAS unsigned char* Kn = lds + ((kb + 1) & 1) * BUF; LAS unsigned char* Vn = Kn + KBUF;
                *(LAS u32x4*)(Kn + krho * KS + kch * 16) = rk0; *(LAS u32x4*)(Kn + krho * KS + (kch + 8) * 16) = rk1;
                *(LAS u32x4*)(Vn + vdv * VS + vch * 16) = rv0; *(LAS u32x4*)(Vn + vdv * VS + (vch + 4) * 16) = rv1;
            }
            __syncthreads();
        }
        float l0 = lrun[0], l1 = lrun[1];
        l0 += shx(l0, 16); l0 += shx(l0, 32); l1 += shx(l1, 16); l1 += shx(l1, 32);
        const float i0 = 1.f / l0, i1 = lam / l1;
        float ss = 0.f;
#pragma unroll
        for (int dt = 0; dt < 8; ++dt) { O[0][dt] = O[0][dt] * i0 - O[1][dt] * i1;
#pragma unroll
            for (int e = 0; e < 4; ++e) ss += O[0][dt][e] * O[0][dt][e]; }
        ss += shx(ss, 16); ss += shx(ss, 32);
        const float rstd = rsqrtf(ss * (1.f / 128.f) + 1e-6f) * (1.f - lam_init);
#pragma unroll
        for (int dt = 0; dt < 8; ++dt) {
            const int c = h * 128 + dt * 16 + quad * 4;
            const f32x4 g4 = *(const f32x4*)(ng + c);
            const f32x4 y = O[0][dt] * rstd * g4;
            u32x2 o; o.x = pk2(y[0], y[1]); o.y = pk2(y[2], y[3]);
            *(u32x2*)(U + (size_t)qrow * D + c) = o;
        }
    }
}

constexpr int ML_LD = 4352, ML_NKVG = 2064;
__device__ void ml_prep_phase(const bf16_t* P, const float* convw, bf16_t* QC, bf16_t* KC) {
    const int gt = BID() * 512 + TID(), ngt = GDIM() * 512;
    for (long it = gt; it < (long)MTOT * 2048; it += ngt) {
        const int row = (int)(it >> 11), w = (int)(it & 2047), isq = w >> 10, ch = w & 1023;
        const bool lat = row < MLAT;
        const int pos = lat ? (row & 2047) : ((row - MLAT) & 255), len = lat ? 2048 : 256;
        const int col = isq ? (ML_NKVG + ch) : ch;
        const float w0 = convw[0 * 2048 + isq * 1024 + ch], w1 = convw[1 * 2048 + isq * 1024 + ch], w2 = convw[2 * 2048 + isq * 1024 + ch];
        const bf16_t* p = P + (size_t)row * ML_LD + col;
        float v = w1 * bf2f(p[0]);
        if (pos > 0) v += w0 * bf2f(p[-ML_LD]);
        if (pos < len - 1) v += w2 * bf2f(p[ML_LD]);
        v = silu(v);
        if (isq) QC[(size_t)row * D + ch] = (bf16_t)f2bf(v); else KC[(size_t)row * D + ch] = (bf16_t)f2bf(v * 0.0625f);
    }
}
__device__ void ml_scan_naive_phase(const bf16_t* P, const float* G32, const float* gate_b, const bf16_t* QC, const bf16_t* KC, float* HS, LAS unsigned char* lds) {
    const int tid = TID(), dvl = tid & 63, g = tid >> 6;
    LAS float* red = (LAS float*)lds;
    LAS float* redd = red + 2 * 8 * 64;
    for (int item = BID(); item < 256; item += GDIM()) {
        const int dir = item >> 7, b = (item >> 4) & 7, h = (item >> 2) & 3, sl = item & 3;
        const float bi = gate_b[dir * 8 + h], bfg = gate_b[dir * 8 + 4 + h];
        float C[32], n[32];
#pragma unroll
        for (int j = 0; j < 32; ++j) { C[j] = 0.f; n[j] = 0.f; }
        float m = 0.f;
        for (int step = 0; step < CTXL + SEQ; ++step) {
            int row;
            if (step < CTXL) row = MLAT + b * CTXL + (dir ? CTXL - 1 - step : step);
            else { const int s2 = step - CTXL; row = b * SEQ + (dir ? SEQ - 1 - s2 : s2); }
            const float ig = G32[(size_t)row * 32 + dir * 8 + h] + bi, fg = G32[(size_t)row * 32 + dir * 8 + 4 + h] + bfg;
            const float lf = log_sigmoid(fg);
            const float mn = fmaxf(lf + m, ig), fw = __expf(lf + m - mn), iw = __expf(ig - mn);
            m = mn;
            const float v = bf2f(P[(size_t)row * ML_LD + 1024 + h * 256 + sl * 64 + dvl]);
            const u32x4* qp = (const u32x4*)(QC + (size_t)row * D + h * 256 + g * 32);
            const u32x4* kp = (const u32x4*)(KC + (size_t)row * D + h * 256 + g * 32);
            float part = 0.f, dpart = 0.f;
#pragma unroll
            for (int i = 0; i < 4; ++i) {
                float qf[8], kf[8]; unpack8(qp[i], qf); unpack8(kp[i], kf);
#pragma unroll
                for (int e = 0; e < 8; ++e) {
                    const int j = 8 * i + e;
                    C[j] = fw * C[j] + (iw * kf[e]) * v; n[j] = fw * n[j] + iw * kf[e];
                    part += qf[e] * C[j]; dpart += qf[e] * n[j];
                }
            }
            const int pb = step & 1;
            red[(pb * 8 + g) * 64 + dvl] = part;
            if (dvl == 0) redd[pb * 8 + g] = dpart;
            __syncthreads();
            if (tid < 64) {
                float num = 0.f, den = 0.f;
#pragma unroll
                for (int w = 0; w < 8; ++w) { num += red[(pb * 8 + w) * 64 + tid]; den += redd[pb * 8 + w]; }
                HS[((size_t)dir * MTOT + row) * D + h * 256 + sl * 64 + tid] = num / fmaxf(fabsf(den), __expf(-m));
            }
        }
        __syncthreads();
    }
}
__device__ void ml_readout_phase(const bf16_t* P, const float* HS, const float* ng, bf16_t* U) {
    const int lane = TID() & 63, gw = BID() * 8 + (TID() >> 6), ngw = GDIM() * 8;
    for (int row = gw; row < MTOT; row += ngw) {
        const int c0 = lane * 16;
        float v[16]; float ss = 0.f;
#pragma unroll
        for (int i = 0; i < 4; ++i) {
            const f32x4 a0 = *(const f32x4*)(HS + (size_t)row * D + c0 + 4 * i), a1 = *(const f32x4*)(HS + ((size_t)MTOT + row) * D + c0 + 4 * i);
#pragma unroll
            for (int e = 0; e < 4; ++e) { v[4 * i + e] = a0[e] + a1[e]; ss += v[4 * i + e] * v[4 * i + e]; }
        }
        ss += shx(ss, 1); ss += shx(ss, 2); ss += shx(ss, 4); ss += shx(ss, 8);
        const float rstd = rsqrtf(ss * (1.f / 256.f) + 1e-6f);
        const bf16_t* op = P + (size_t)row * ML_LD + ML_NKVG + D + c0;
        unsigned o[8];
#pragma unroll
        for (int i = 0; i < 8; ++i) {
            const float y0 = sigmoidf_(bf2f(op[2 * i])) * v[2 * i] * rstd * ng[c0 + 2 * i], y1 = sigmoidf_(bf2f(op[2 * i + 1])) * v[2 * i + 1] * rstd * ng[c0 + 2 * i + 1];
            o[i] = pk2(y0, y1);
        }
        u32x4* up = (u32x4*)(U + (size_t)row * D + c0);
        up[0] = (u32x4){o[0], o[1], o[2], o[3]}; up[1] = (u32x4){o[4], o[5], o[6], o[7]};
    }
}

constexpr int GL_LD = 3328, GL_NKVG = 1568;
__device__ void gla_prep_phase(const float* G32, const float* wgu, const float* bg, float* LA) {
    const int gt = BID() * 512 + TID(), ngt = GDIM() * 512;
    for (long it = gt; it < (long)2 * MTOT * 512; it += ngt) {
        const int c = (int)(it & 511), row = (int)((it >> 9) % MTOT), dir = (int)(it / ((long)MTOT * 512));
        const float* low = G32 + (size_t)row * 32 + dir * 16;
        float acc = bg[dir * 512 + c];
#pragma unroll
        for (int r = 0; r < 16; ++r) acc += low[r] * wgu[(dir * 16 + r) * 512 + c];
        LA[((size_t)dir * MTOT + row) * 512 + c] = log_sigmoid(acc) * (1.f / 16.f);
    }
}
__device__ void gla_scan_naive_phase(const bf16_t* P, const float* LA, float* HS, LAS unsigned char* lds) {
    const int tid = TID(), dvl = tid & 63, g = tid >> 6;
    LAS float* red = (LAS float*)lds;
    for (int item = BID(); item < 256; item += GDIM()) {
        const int dir = item >> 7, b = (item >> 4) & 7, h = (item >> 2) & 3, sl = item & 3;
        float S[16];
#pragma unroll
        for (int j = 0; j < 16; ++j) S[j] = 0.f;
        for (int step = 0; step < CTXL + SEQ; ++step) {
            int row;
            if (step < CTXL) row = MLAT + b * CTXL + (dir ? CTXL - 1 - step : step);
            else { const int s2 = step - CTXL; row = b * SEQ + (dir ? SEQ - 1 - s2 : s2); }
            const float v = bf2f(P[(size_t)row * GL_LD + 512 + h * 256 + sl * 64 + dvl]);
            const u32x4* kp = (const u32x4*)(P + (size_t)row * GL_LD + h * 128 + g * 16);
            const u32x4* qp = (const u32x4*)(P + (size_t)row * GL_LD + GL_NKVG + h * 128 + g * 16);
            const f32x4* lp = (const f32x4*)(LA + ((size_t)dir * MTOT + row) * 512 + h * 128 + g * 16);
            float part = 0.f;
#pragma unroll
            for (int i = 0; i < 2; ++i) {
                float qf[8], kf[8]; unpack8(qp[i], qf); unpack8(kp[i], kf);
                const f32x4 la0 = lp[2 * i], la1 = lp[2 * i + 1];
#pragma unroll
                for (int e = 0; e < 8; ++e) {
                    const int j = 8 * i + e; const float al = __expf(e < 4 ? la0[e] : la1[e - 4]);
                    S[j] = al * S[j] + kf[e] * v; part += qf[e] * S[j];
                }
            }
            const int pb = step & 1;
            red[(pb * 8 + g) * 64 + dvl] = part;
            __syncthreads();
            if (tid < 64 && step >= CTXL) {
                float num = 0.f;
#pragma unroll
                for (int w = 0; w < 8; ++w) num += red[(pb * 8 + w) * 64 + tid];
                HS[((size_t)dir * MTOT + row) * D + h * 256 + sl * 64 + tid] = num * 0.08838834764831845f;
            }
        }
        __syncthreads();
    }
}
__device__ void gla_readout_phase(const bf16_t* P, const float* HS, const float* ng, bf16_t* U) {
    const int lane = TID() & 63, gw = BID() * 8 + (TID() >> 6), ngw = GDIM() * 8;
    for (int row = gw; row < MLAT; row += ngw) {
        const int c0 = lane * 16;
        float v[16]; float ss = 0.f;
#pragma unroll
        for (int i = 0; i < 4; ++i) {
            const f32x4 a0 = *(const f32x4*)(HS + (size_t)row * D + c0 + 4 * i), a1 = *(const f32x4*)(HS + ((size_t)MTOT + row) * D + c0 + 4 * i);
#pragma unroll
            for (int e = 0; e < 4; ++e) { v[4 * i + e] = a0[e] + a1[e]; ss += v[4 * i + e] * v[4 * i + e]; }
        }
        ss += shx(ss, 1); ss += shx(ss, 2); ss += shx(ss, 4); ss += shx(ss, 8);
        const float rstd = rsqrtf(ss * (1.f / 256.f) + 1e-6f);
        const bf16_t* rp = P + (size_t)row * GL_LD + GL_NKVG + 512 + c0;
        unsigned o[8];
#pragma unroll
        for (int i = 0; i < 8; ++i) {
            const float y0 = silu(bf2f(rp[2 * i])) * v[2 * i] * rstd * ng[c0 + 2 * i], y1 = silu(bf2f(rp[2 * i + 1])) * v[2 * i + 1] * rstd * ng[c0 + 2 * i + 1];
            o[i] = pk2(y0, y1);
        }
        u32x4* up = (u32x4*)(U + (size_t)row * D + c0);
        up[0] = (u32x4){o[0], o[1], o[2], o[3]}; up[1] = (u32x4){o[4], o[5], o[6], o[7]};
    }
}

__device__ __forceinline__ bool phase_exists(int ph) {
    if (ph == 0 || ph == 49) return true;
    const int l = (ph - 1) / 12, k = (ph - 1) % 12;
    if (k == 6 || k == 7) return (l & 1) != 0;
    return true;
}
template <class Epi>
__device__ __forceinline__ void run_gemm(LAS unsigned char* lds, const bf16_t* A, const bf16_t* Bt, int M, int N, int K, const Epi& E) {
    pg8::Gemm g; g.A = A; g.Bt = Bt; g.M = M; g.N = N; g.K = K;
    pg8::StaticOrder S; S.init(M, N, (int)GDIM(), (int)BID());
    pg8::gemm_phase<Epi, pg8::StaticOrder, true, true>(lds, g, S, E);
}
__device__ void run_phase(const Args& a, int ph, LAS unsigned char* lds) {
    unsigned char* ws = a.ws; asm volatile("" : "+s"(ws));
    float* H = (float*)(ws + WS_H); bf16_t* U = (bf16_t*)(ws + WS_U); bf16_t* P = (bf16_t*)(ws + WS_P); float* G32 = (float*)(ws + WS_G32);
    bf16_t* QC = (bf16_t*)(ws + WS_QC); bf16_t* KC = (bf16_t*)(ws + WS_KC); float* HS = (float*)(ws + WS_HS); float* LA = (float*)(ws + WS_QC);
    if (ph == 0) { p0_prologue(a, lds); return; }
    if (ph == 49) { final_norm_phase(H, a.in[I_FINALG], a.out); return; }
    const int l = (ph - 1) / 12, k = (ph - 1) % 12;
    const float* modl = (const float*)(ws + WS_MOD) + (size_t)l * 9 * MODLD;
    const float* ng = a.in[I_NORMG] + (size_t)l * 3 * D;
    switch (k) {
    case 0: norm_phase(H, ng, modl, 0, U, MTOT); break;
    case 1: case 10: { const int f = k == 10 ? 1 : 0; pg8::EpiSwiglu E; E.O = P; E.ldc = DFF; run_gemm(lds, U, (const bf16_t*)(ws + WS_W13T + (size_t)(l * 2 + f) * W13T_SZ), MTOT, 2 * DFF, D, E); } break;
    case 2: case 8: case 11: {
        pg8::EpiResid E; E.H = H; E.gate_ld = MODLD; E.gate = modl + (k == 2 ? 2 : k == 8 ? 5 : 8) * D; E.scale = k == 8 ? 1.0f : 0.5f;
        const bf16_t* A = k == 8 ? U : P; const int K = k == 8 ? D : DFF;
        const bf16_t* Bt = (const bf16_t*)(ws + (k == 8 ? WS_WO + (size_t)l * D * D * 2 : WS_W2T + (size_t)(l * 2 + (k == 11 ? 1 : 0)) * W2T_SZ));
        run_gemm(lds, A, Bt, MTOT, D, K, E);
    } break;
    case 3: norm_phase(H, ng + D, modl, 3, U, MTOT); break;
    case 4: {
        const size_t woff = l == 0 ? WS_WIN0 : l == 1 ? WS_WIN1 : l == 2 ? WS_WIN2 : WS_WIN3;
        if (l == 2) { pg8::EpiProjAttn E; E.P = P; E.VT = (bf16_t*)(ws + WS_VT); E.R = (const float*)(ws + WS_ROPE); E.rope = 1; run_gemm(lds, U, (const bf16_t*)(ws + woff), MTOT, 3072, D, E); }
        else { pg8::EpiProj E; E.P = P; E.G32 = G32; E.ldc = NPAD_IN[l]; E.gcol0 = l == 1 ? 2048 : (l == 3 ? 1536 : 1 << 30); E.gn = l == 1 ? 16 : 32;
            run_gemm(lds, U, (const bf16_t*)(ws + woff), MTOT, NPAD_IN[l], D, E); }
    } break;
    case 5:
        if (l == 0) na_naive_phase(P, a.in[I_NARPB], U, lds);
        else if (l == 1) ml_prep_phase(P, a.in[I_MLCONV], QC, KC);
        else if (l == 2) da_flash_phase(P, (const bf16_t*)(ws + WS_VT), a.in[I_DALAM], a.in[I_DANG], U, lds);
        else gla_prep_phase(G32, a.in[I_GLAGU], a.in[I_GLABG], LA);
        break;
    case 6:
        if (l == 1) ml_scan_naive_phase(P, G32, a.in[I_MLGB], QC, KC, HS, lds);
        else if (l == 3) gla_scan_naive_phase(P, LA, HS, lds);
        break;
    case 7:
        if (l == 1) ml_readout_phase(P, HS, a.in[I_MLNG], U);
        else if (l == 3) gla_readout_phase(P, HS, a.in[I_GLANG], U);
        break;
    case 9: norm_phase(H, ng + 2 * D, modl, 6, U, MTOT); break;
    }
}

constexpr int LDS_BYTES = 135168;
__global__ void __launch_bounds__(512) mega(Args a) {
    extern __shared__ __attribute__((aligned(16))) unsigned char lds_raw[];
    LAS unsigned char* lds = (LAS unsigned char*)lds_raw;
    cg::grid_group grid = cg::this_grid();
    bool first = true;
    for (int ph = a.ph_lo; ph < a.ph_hi; ++ph) {
        if (!phase_exists(ph)) continue;
        if (!first) grid.sync();
        first = false;
        run_phase(a, ph, lds);
        __syncthreads();
    }
}

extern "C" void kernel_launch(void* const* d_in, const int* in_sizes, int n_in, void* d_out, int out_size,
                              void* d_ws, size_t ws_size, hipStream_t stream) {
    static int grid = 0;
    if (grid == 0) {
        int dev = 0, cus = 0, per_cu = 0;
        (void)hipGetDevice(&dev);
        (void)hipDeviceGetAttribute(&cus, hipDeviceAttributeMultiprocessorCount, dev);
        (void)hipFuncSetAttribute((const void*)mega, hipFuncAttributeMaxDynamicSharedMemorySize, LDS_BYTES);
        (void)hipOccupancyMaxActiveBlocksPerMultiprocessor(&per_cu, (const void*)mega, 512, LDS_BYTES);
        grid = cus > 0 ? cus : 256;
        if (n_in != N_IN || ws_size < WS_END) { fprintf(stderr, "kernel_launch: n_in %d ws %zu (need %zu)\n", n_in, ws_size, (size_t)WS_END); }
    }
    Args a{};
    for (int i = 0; i < N_IN; ++i) a.in[i] = (const float*)d_in[i];
    a.out = (float*)d_out; a.ws = (unsigned char*)d_ws; a.ph_lo = 0; a.ph_hi = 50;
    void* args[] = {&a};
    hipError_t e = hipLaunchCooperativeKernel((const void*)mega, dim3(grid), dim3(512), args, LDS_BYTES, stream);
    if (e != hipSuccess) fprintf(stderr, "cooperative launch failed: %s\n", hipGetErrorString(e));
}
```

```cpp
#include <hip/hip_runtime.h>
#include <hip/hip_cooperative_groups.h>
#include <cstdio>
#include <cstdint>
__device__ __forceinline__ int TID() { int t = threadIdx.x; asm volatile("" : "+v"(t)); return t; }
__device__ __forceinline__ int GDIM() { int t = gridDim.x; asm volatile("" : "+s"(t)); return t; }
__device__ __forceinline__ float shx(float v, int o) { const int lane = TID() & 63; return __builtin_bit_cast(float, __builtin_amdgcn_ds_bpermute((lane ^ o) << 2, __builtin_bit_cast(int, v))); }
__device__ __forceinline__ float rdl(float v, int src) { return __builtin_bit_cast(float, __builtin_amdgcn_readlane(__builtin_bit_cast(int, v), src)); }
__device__ __forceinline__ int BID() { int t = blockIdx.x; asm volatile("" : "+s"(t)); return t; }
namespace pg8 {
#define PG8_LAS __attribute__((address_space(3)))
typedef unsigned short bf16_t;
typedef short bf16x8 __attribute__((ext_vector_type(8)));
typedef float f32x4 __attribute__((ext_vector_type(4)));
typedef unsigned u32x4 __attribute__((ext_vector_type(4)));
constexpr int BM = 256, BK = 64, HALF = 128, HTB = HALF * BK * 2  , STAGE_BYTES = 8 * HTB, NXCD = 8, WGM = 8;

__host__ __device__ __forceinline__ int lds_byte(int r, int c) { const int st = (r >> 4) * 2 + (c >> 5), rr = r & 15, cc = c & 31, ob = rr * 64 + cc * 2; return st * 1024 + (ob ^ (((ob >> 9) & 1) << 5)); }
__host__ __device__ __forceinline__ void stage_rc(int b, int& R, int& C) { const int st = b / 1024, sb = b % 1024, swz = sb ^ (((sb >> 9) & 1) << 5); R = (st >> 1) * 16 + swz / 64; C = (st & 1) * 32 + (swz % 64) / 2; }
__host__ __device__ __forceinline__ int perm32(int rho) { const int n = rho >> 4, i = rho & 15; return 8 * (i >> 2) + 4 * n + (i & 3); }

struct Unit { int pm, pn; };
struct Gemm { const bf16_t* A; const bf16_t* Bt; int M, N, K; };

struct StaticOrder {
    int nM, nN, nwg, G, c;
    __host__ __device__ void init(int M, int N, int G_, int c_) { nM = M / BM; nN = N / BM; nwg = nM * nN; G = G_; c = c_; }
    __host__ __device__ bool next(int i, Unit& u) const {
        const long L = (long)i * G + c; if (L >= nwg) return false;
        int wgid = (int)L; { const int q = nwg / NXCD, r = nwg % NXCD, xcd = wgid % NXCD, off = wgid / NXCD; wgid = (xcd < r ? xcd * (q + 1) : r * (q + 1) + (xcd - r) * q) + off; }
        const int nig = WGM * nN, gid = wgid / nig, fm = gid * WGM, gsz = (nM - fm) < WGM ? (nM - fm) : WGM;
        u.pm = fm + ((wgid % nig) % gsz); u.pn = (wgid % nig) / gsz; return true;
    }
    __device__ __forceinline__ void a_ready(const Unit&) const {}
    __device__ __forceinline__ void done(const Unit&) const {}
};

__device__ __forceinline__ unsigned cvt_pk_bf16(float lo, float hi) { unsigned r; asm volatile("v_cvt_pk_bf16_f32 %0, %1, %2" : "=v"(r) : "v"(lo), "v"(hi)); return r; }
typedef unsigned u32x2 __attribute__((ext_vector_type(2)));
__device__ __forceinline__ float silu_f(float x) { return x / (1.f + __expf(-x)); }
struct EpiSwiglu {
    static constexpr bool PERM = true, AFTER_DRAIN = false;
    bf16_t* O; int ldc;
    __device__ __forceinline__ void operator()(const f32x4 (&acc)[2][2][4][2], const Unit& u, int wr, int wc, int fr, int fq) const {
        const int row0 = u.pm * BM + wr * 64 + fr, col0 = u.pn * HALF + wc * 32 + 8 * fq;
#pragma unroll
        for (int ai = 0; ai < 2; ++ai)
#pragma unroll
            for (int m = 0; m < 4; ++m) {
                bf16_t* rowp = O + (size_t)(row0 + ai * HALF + m * 16) * ldc + col0;
                const f32x4 g0 = acc[ai][0][m][0], g1 = acc[ai][0][m][1], u0 = acc[ai][1][m][0], u1 = acc[ai][1][m][1];
                u32x4 w;
                w.x = cvt_pk_bf16(silu_f(g0[0]) * u0[0], silu_f(g0[1]) * u0[1]);
                w.y = cvt_pk_bf16(silu_f(g0[2]) * u0[2], silu_f(g0[3]) * u0[3]);
                w.z = cvt_pk_bf16(silu_f(g1[0]) * u1[0], silu_f(g1[1]) * u1[1]);
                w.w = cvt_pk_bf16(silu_f(g1[2]) * u1[2], silu_f(g1[3]) * u1[3]);
                *(u32x4*)rowp = w;
            }
    }
};
struct EpiResid {
    static constexpr bool PERM = false, AFTER_DRAIN = false;
    float* H; const float* gate; float scale; int gate_ld;
    __device__ __forceinline__ void operator()(const f32x4 (&acc)[2][2][4][2], const Unit& u, int wr, int wc, int fr, int fq) const {
        const int mrow = u.pm < 64 ? (u.pm >> 3) : 8;
        const float* gp = gate + (size_t)mrow * gate_ld;
        const int row0 = u.pm * BM + wr * 64 + fr, col0 = u.pn * BM + wc * 32 + 4 * fq;
#pragma unroll
        for (int bj = 0; bj < 2; ++bj)
#pragma unroll
            for (int n = 0; n < 2; ++n) {
                const int col = col0 + bj * HALF + n * 16;
                f32x4 g = *(const f32x4*)(gp + col); g = g * scale;
#pragma unroll
                for (int ai = 0; ai < 2; ++ai)
#pragma unroll
                    for (int m = 0; m < 4; ++m) {
                        float* hp = H + (size_t)(row0 + ai * HALF + m * 16) * 1024 + col;
                        f32x4 h = *(const f32x4*)hp; h = h + g * acc[ai][bj][m][n]; *(f32x4*)hp = h;
                    }
            }
    }
};
struct EpiProj {
    static constexpr bool PERM = true, AFTER_DRAIN = false;
    bf16_t* P; int ldc; float* G32; int gcol0, gn; bf16_t* VT; int vcol0;
    __device__ __forceinline__ void operator()(const f32x4 (&acc)[2][2][4][2], const Unit& u, int wr, int wc, int fr, int fq) const {
        const int row0 = u.pm * BM + wr * 64 + fr, col0 = u.pn * BM + wc * 32 + 8 * fq;
#pragma unroll
        for (int bj = 0; bj < 2; ++bj) {
            const int col = col0 + bj * HALF;
            const bool gs = (col >= gcol0) && (col < gcol0 + gn);
            const bool vs = (col >= vcol0) && (col < vcol0 + 1024);
#pragma unroll
            for (int ai = 0; ai < 2; ++ai)
#pragma unroll
                for (int m = 0; m < 4; ++m) {
                    const size_t row = (size_t)(row0 + ai * HALF + m * 16);
                    const f32x4 v0 = acc[ai][bj][m][0], v1 = acc[ai][bj][m][1];
                    u32x4 w; w.x = cvt_pk_bf16(v0[0], v0[1]); w.y = cvt_pk_bf16(v0[2], v0[3]); w.z = cvt_pk_bf16(v1[0], v1[1]); w.w = cvt_pk_bf16(v1[2], v1[3]);
                    *(u32x4*)(P + row * ldc + col) = w;
                    if (gs) { float* gp = G32 + row * 32 + (col - gcol0); *(f32x4*)gp = v0; *(f32x4*)(gp + 4) = v1; }
                    if (vs) { bf16_t* vp = VT + (size_t)(col - vcol0) * 18432 + row;
                        vp[0] = (bf16_t)(w.x & 0xffffu); vp[18432] = (bf16_t)(w.x >> 16); vp[2 * 18432] = (bf16_t)(w.y & 0xffffu); vp[3 * 18432] = (bf16_t)(w.y >> 16);
                        vp[4 * 18432] = (bf16_t)(w.z & 0xffffu); vp[5 * 18432] = (bf16_t)(w.z >> 16); vp[6 * 18432] = (bf16_t)(w.w & 0xffffu); vp[7 * 18432] = (bf16_t)(w.w >> 16); }
                }
        }
    }
};

struct EpiProjAttn {
    static constexpr bool PERM = false, AFTER_DRAIN = false;
    bf16_t* P; bf16_t* VT; const float* R; int rope;
    __device__ __forceinline__ void operator()(const f32x4 (&acc)[2][2][4][2], const Unit& u, int wr, int wc, int fr, int fq) const {
        const int sec = u.pn >> 2;
        const int row0 = u.pm * BM + wr * 64 + fr, col0 = u.pn * BM + wc * 32 + 4 * fq;
        if (sec == 1) {
#pragma unroll
            for (int ai = 0; ai < 2; ++ai)
#pragma unroll
                for (int m = 0; m < 4; ++m) {
                    const int row = row0 + ai * HALF + m * 16;
#pragma unroll
                    for (int bj = 0; bj < 2; ++bj)
#pragma unroll
                        for (int n = 0; n < 2; ++n) {
                            const int col = col0 + bj * HALF + n * 16 - 1024;
                            const f32x4 v = acc[ai][bj][m][n];
#pragma unroll
                            for (int e = 0; e < 4; ++e) VT[(size_t)(col + e) * 18432 + row] = (bf16_t)(cvt_pk_bf16(v[e], 0.f) & 0xffffu);
                        }
                }
            return;
        }
        const float sc = sec == 2 ? 0.125f : 1.f;
        const bool do_rope = rope && u.pm < 64;
        const int axis = wc & 1;
#pragma unroll
        for (int ai = 0; ai < 2; ++ai)
#pragma unroll
            for (int m = 0; m < 4; ++m) {
                const int row = row0 + ai * HALF + m * 16;
                f32x4 cs = (f32x4){1.f, 1.f, 1.f, 1.f}, sn = (f32x4){0.f, 0.f, 0.f, 0.f};
                if (do_rope) { const int t = row & 2047, pos = axis ? (t & 63) : (t >> 6); cs = *(const f32x4*)(R + pos * 16 + 4 * fq); sn = *(const f32x4*)(R + 1024 + pos * 16 + 4 * fq); }
#pragma unroll
                for (int bj = 0; bj < 2; ++bj) {
                    const f32x4 x1 = acc[ai][bj][m][0] * sc, x2 = acc[ai][bj][m][1] * sc;
                    const f32x4 y1 = x1 * cs - x2 * sn, y2 = x2 * cs + x1 * sn;
                    bf16_t* pp = P + (size_t)row * 3072 + col0 + bj * HALF;
                    u32x2 o1, o2; o1.x = cvt_pk_bf16(y1[0], y1[1]); o1.y = cvt_pk_bf16(y1[2], y1[3]); o2.x = cvt_pk_bf16(y2[0], y2[1]); o2.y = cvt_pk_bf16(y2[2], y2[3]);
                    *(u32x2*)pp = o1; *(u32x2*)(pp + 16) = o2;
                }
            }
    }
};

template <class Epi, class Sched, bool ALIGN_EPI = false, bool SP2 = false>
__device__ __forceinline__ void gemm_phase(PG8_LAS unsigned char* lds, const Gemm g, const Sched& S, const Epi& E) {
    const int tid = TID(), wid = __builtin_amdgcn_readfirstlane(tid >> 6), lane = tid & 63, wr = wid >> 2, wc = wid & 3, fr = lane & 15, fq = lane >> 4;
    const int K = g.K, nt = K / BK;
    unsigned voffA[2], voffB[2];
#pragma unroll
    for (int i = 0; i < 2; ++i) { int R, C; stage_rc(tid * 16 + i * 8192, R, C); const int Rb = Epi::PERM ? ((R & ~31) + perm32(R & 31)) : R;
        voffA[i] = (unsigned)(R * K + C) * 2u; voffB[i] = (unsigned)(Rb * K + C) * 2u; }
    const size_t kstep = (size_t)(BK * 2);
    const size_t hstep = (size_t)HALF * K * 2;
    const size_t tstep = 2 * hstep;
    const unsigned ldsw = (unsigned)wid * 1024u;
    const int aoff = lds_byte(wr * 64 + fr, fq * 8), boff = lds_byte(wc * 32 + fr, fq * 8);
#define PG8_SA(b, h) (((b) * 2 + (h)) * HTB)
#define PG8_SB(b, h) ((4 + (b) * 2 + (h)) * HTB)
#define PG8_STAGE(bufoff, gbase, voff) do { _Pragma("unroll") for (int _i = 0; _i < 2; ++_i) \
        __builtin_amdgcn_global_load_lds((const unsigned*)((const char*)(gbase) + (voff)[_i]), (PG8_LAS unsigned*)(lds + (bufoff) + ldsw + _i * 8192), 16, 0, 0); } while (0)
#define PG8_LDA(dst, b, h) do { _Pragma("unroll") for (int m = 0; m < 4; ++m) _Pragma("unroll") for (int k = 0; k < 2; ++k) dst[m][k] = *(const PG8_LAS bf16x8*)(lds + PG8_SA(b, h) + aoff + m * 2048 + k * 1024); } while (0)
#define PG8_LDB(dst, b, h) do { _Pragma("unroll") for (int n = 0; n < 2; ++n) _Pragma("unroll") for (int k = 0; k < 2; ++k) dst[n][k] = *(const PG8_LAS bf16x8*)(lds + PG8_SB(b, h) + boff + n * 2048 + k * 1024); } while (0)
#define PG8_MMA(ai, bj, At, Bt) do { __builtin_amdgcn_s_setprio(1); _Pragma("unroll") for (int m = 0; m < 4; ++m) _Pragma("unroll") for (int n = 0; n < 2; ++n) _Pragma("unroll") for (int k = 0; k < 2; ++k) \
        acc[ai][bj][m][n] = __builtin_amdgcn_mfma_f32_16x16x32_bf16(Bt[n][k], At[m][k], acc[ai][bj][m][n], 0, 0, 0); __builtin_amdgcn_s_setprio(0); } while (0)
#define PG8_WAIT_V(n) asm volatile("s_waitcnt vmcnt(" #n ")" ::: "memory")
#define PG8_WAIT_L(n) asm volatile("s_waitcnt lgkmcnt(" #n ")" ::: "memory")
#define PG8_BAR __builtin_amdgcn_s_barrier()
#define PG8_SCHED __builtin_amdgcn_sched_barrier(0)
    Unit cur, nxt; int ui = 0;
    if (!S.next(0, cur)) return;
    f32x4 acc[2][2][4][2];
#pragma unroll
    for (int a = 0; a < 2; ++a)
#pragma unroll
        for (int b = 0; b < 2; ++b)
#pragma unroll
            for (int m = 0; m < 4; ++m)
#pragma unroll
                for (int n = 0; n < 2; ++n) acc[a][b][m][n] = (f32x4){0.f, 0.f, 0.f, 0.f};
    bf16x8 At[4][2], B0[2][2], B1[2][2];
    const char* cA = (const char*)g.A + (size_t)cur.pm * tstep; const char* cB = (const char*)g.Bt + (size_t)cur.pn * tstep;
    S.a_ready(cur);
    if constexpr (SP2) {
        PG8_STAGE(PG8_SB(0, 0), cB, voffB); PG8_STAGE(PG8_SB(0, 1), cB + hstep, voffB); PG8_STAGE(PG8_SA(0, 0), cA, voffA); PG8_STAGE(PG8_SA(0, 1), cA + hstep, voffA);
        if (wr == 1) PG8_BAR;
        PG8_WAIT_V(2); PG8_BAR;
        PG8_STAGE(PG8_SB(1, 0), cB + kstep, voffB); PG8_STAGE(PG8_SA(1, 0), cA + kstep, voffA); PG8_STAGE(PG8_SB(1, 1), cB + hstep + kstep, voffB);
        PG8_WAIT_V(6); PG8_BAR;
    } else {
        PG8_STAGE(PG8_SB(0, 0), cB, voffB); PG8_STAGE(PG8_SA(0, 0), cA, voffA); PG8_STAGE(PG8_SB(0, 1), cB + hstep, voffB); PG8_STAGE(PG8_SA(0, 1), cA + hstep, voffA);
        if (wr == 1) PG8_BAR;
        PG8_WAIT_V(4); PG8_BAR;
        PG8_STAGE(PG8_SB(1, 0), cB + kstep, voffB); PG8_STAGE(PG8_SA(1, 0), cA + kstep, voffA); PG8_STAGE(PG8_SB(1, 1), cB + hstep + kstep, voffB);
        PG8_WAIT_V(6); PG8_BAR;
    }
    for (;;) {
        const bool has_next = S.next(ui + 1, nxt);
        const char* nA = has_next ? (const char*)g.A + (size_t)nxt.pm * tstep : cA; const char* nB = has_next ? (const char*)g.Bt + (size_t)nxt.pn * tstep : cB;
        for (int t = 0; t < nt; t += 2) {
            const bool last = (t == nt - 2);
            const char* a1 = cA + (size_t)(t + 1) * kstep;
            const char* a2 = last ? nA : cA + (size_t)(t + 2) * kstep; const char* b2 = last ? nB : cB + (size_t)(t + 2) * kstep;
            const char* a3 = a2 + kstep; const char* b3 = b2 + kstep;
            if (last && has_next) S.a_ready(nxt);
            if constexpr (SP2) {
            PG8_LDB(B0, 0, 0); PG8_LDB(B1, 0, 1); PG8_SCHED; PG8_LDA(At, 0, 0); PG8_STAGE(PG8_SA(1, 1), a1 + hstep, voffA);
            PG8_WAIT_V(8); PG8_WAIT_L(0); PG8_BAR; PG8_MMA(0, 0, At, B0); PG8_MMA(0, 1, At, B1); PG8_BAR; PG8_SCHED;
            PG8_LDA(At, 0, 1); PG8_STAGE(PG8_SB(0, 0), b2, voffB); PG8_STAGE(PG8_SB(0, 1), b2 + hstep, voffB); PG8_STAGE(PG8_SA(0, 0), a2, voffA);
            PG8_WAIT_V(8); PG8_WAIT_L(0); PG8_BAR; PG8_MMA(1, 0, At, B0); PG8_MMA(1, 1, At, B1); PG8_BAR; PG8_SCHED;
            PG8_LDB(B0, 1, 0); PG8_LDB(B1, 1, 1); PG8_SCHED; PG8_LDA(At, 1, 0); PG8_STAGE(PG8_SA(0, 1), a2 + hstep, voffA);
            PG8_WAIT_V(8); PG8_WAIT_L(0); PG8_BAR; PG8_MMA(0, 0, At, B0); PG8_MMA(0, 1, At, B1); PG8_BAR; PG8_SCHED;
            PG8_LDA(At, 1, 1); PG8_STAGE(PG8_SB(1, 0), b3, voffB); PG8_STAGE(PG8_SB(1, 1), b3 + hstep, voffB); PG8_STAGE(PG8_SA(1, 0), a3, voffA);
            PG8_WAIT_V(8); PG8_WAIT_L(0); PG8_BAR; PG8_MMA(1, 0, At, B0); PG8_MMA(1, 1, At, B1); PG8_BAR; PG8_SCHED;
            } else {
            PG8_LDB(B0, 0, 0); PG8_SCHED; PG8_LDA(At, 0, 0); PG8_STAGE(PG8_SA(1, 1), a1 + hstep, voffA);
            PG8_WAIT_L(8); PG8_BAR; PG8_WAIT_L(0); PG8_MMA(0, 0, At, B0); PG8_BAR; PG8_SCHED;
            PG8_LDB(B1, 0, 1); PG8_STAGE(PG8_SB(0, 0), b2, voffB);
            PG8_BAR; PG8_WAIT_L(0); PG8_MMA(0, 1, At, B1); PG8_BAR;
            PG8_LDA(At, 0, 1); PG8_STAGE(PG8_SA(0, 0), a2, voffA);
            PG8_BAR; PG8_WAIT_L(0); PG8_MMA(1, 0, At, B0); PG8_BAR; PG8_SCHED;
            PG8_STAGE(PG8_SB(0, 1), b2 + hstep, voffB);
            PG8_WAIT_V(6); PG8_BAR; PG8_MMA(1, 1, At, B1); PG8_BAR;
            PG8_LDB(B0, 1, 0); PG8_SCHED; PG8_LDA(At, 1, 0); PG8_STAGE(PG8_SA(0, 1), a2 + hstep, voffA);
            PG8_WAIT_L(8); PG8_BAR; PG8_WAIT_L(0); PG8_MMA(0, 0, At, B0); PG8_BAR; PG8_SCHED;
            PG8_LDB(B1, 1, 1); PG8_STAGE(PG8_SB(1, 0), b3, voffB);
            PG8_BAR; PG8_WAIT_L(0); PG8_MMA(0, 1, At, B1); PG8_BAR;
            PG8_LDA(At, 1, 1); PG8_STAGE(PG8_SA(1, 0), a3, voffA);
            PG8_BAR; PG8_WAIT_L(0); PG8_MMA(1, 0, At, B0); PG8_BAR; PG8_SCHED;
            PG8_STAGE(PG8_SB(1, 1), b3 + hstep, voffB);
            PG8_WAIT_V(6); PG8_BAR; PG8_MMA(1, 1, At, B1); PG8_BAR;
            }
        }
        if constexpr (ALIGN_EPI) { if (wr == 0) PG8_BAR; }
        if constexpr (!Epi::AFTER_DRAIN) { E(acc, cur, wr, wc, fr, fq); S.done(cur); }
        if (!has_next) break;
#pragma unroll
        for (int a = 0; a < 2; ++a)
#pragma unroll
            for (int b = 0; b < 2; ++b)
#pragma unroll
                for (int m = 0; m < 4; ++m)
#pragma unroll
                    for (int n = 0; n < 2; ++n) acc[a][b][m][n] = (f32x4){0.f, 0.f, 0.f, 0.f};
        cur = nxt; cA = nA; cB = nB; ++ui;
        if constexpr (ALIGN_EPI) { if (wr == 1) PG8_BAR; }
    }
    PG8_WAIT_V(0);
    if constexpr (!ALIGN_EPI) { if (wr == 0) PG8_BAR; }
    PG8_BAR;
    if constexpr (Epi::AFTER_DRAIN) { E.fused(acc, cur, wr, wc, fr, fq, lds, wid, lane); S.done(cur); }
#undef PG8_SA
#undef PG8_SB
#undef PG8_STAGE
#undef PG8_LDA
#undef PG8_LDB
#undef PG8_MMA
#undef PG8_WAIT_V
#undef PG8_WAIT_L
#undef PG8_BAR
#undef PG8_SCHED
}
}
namespace cg = cooperative_groups;
typedef unsigned short bf16_t;
typedef float f32x4 __attribute__((ext_vector_type(4)));
typedef unsigned u32x4 __attribute__((ext_vector_type(4)));
typedef unsigned u32x2 __attribute__((ext_vector_type(2)));
#define LAS __attribute__((address_space(3)))

constexpr int D = 1024, NB = 8, SEQ = 2048, CTXL = 256, DFF = 2816;
constexpr int MLAT = NB * SEQ, MCTX = NB * CTXL, MTOT = MLAT + MCTX;
constexpr int MODLD = 9 * D;
enum { I_X = 0, I_C, I_CTX, I_CCTX, I_ADAW, I_ADAB, I_NORMG, I_W13, I_W2, I_FINALG, I_NAW, I_NARPB, I_NAWO, I_MLW, I_MLGB, I_MLCONV, I_MLNG, I_MLWO,
       I_DAW, I_DALAM, I_DANG, I_DAWO, I_GLAW, I_GLAGU, I_GLABG, I_GLANG, I_GLAWO, N_IN };
constexpr int NPAD_IN[4] = {3072, 4352, 3072, 3328};
constexpr int N_IN_REAL[4] = {3072, 4112, 3072, 3104};
constexpr size_t al256(size_t x) { return (x + 255) & ~(size_t)255; }
constexpr size_t WS_MOD = 0;
constexpr size_t WS_ROPE = al256(WS_MOD + (size_t)4 * 9 * MODLD * 4);
constexpr size_t WS_W13T = al256(WS_ROPE + 2 * 64 * 16 * 4);
constexpr size_t W13T_SZ = (size_t)2 * DFF * D * 2;
constexpr size_t WS_W2T = WS_W13T + 8 * W13T_SZ;
constexpr size_t W2T_SZ = (size_t)D * DFF * 2;
constexpr size_t WS_WIN0 = WS_W2T + 8 * W2T_SZ;
constexpr size_t WS_WIN1 = WS_WIN0 + (size_t)3072 * D * 2;
constexpr size_t WS_WIN2 = WS_WIN1 + (size_t)4352 * D * 2;
constexpr size_t WS_WIN3 = WS_WIN2 + (size_t)3072 * D * 2;
constexpr size_t WS_WO = WS_WIN3 + (size_t)3328 * D * 2;
constexpr size_t WS_H = WS_WO + (size_t)4 * D * D * 2;
constexpr size_t WS_U = WS_H + (size_t)MTOT * D * 4;
constexpr size_t WS_P = WS_U + (size_t)MTOT * D * 2;
constexpr size_t WS_G32 = WS_P + (size_t)MTOT * 4352 * 2;
constexpr size_t WS_QC = WS_G32 + (size_t)MTOT * 32 * 4;
constexpr size_t WS_KC = WS_QC + (size_t)MTOT * D * 2;
constexpr size_t WS_HS = WS_KC + (size_t)MTOT * D * 2;
constexpr size_t WS_VT = WS_HS + (size_t)2 * MTOT * D * 2;
constexpr size_t WS_KBT = WS_VT + (size_t)D * MTOT * 2;
constexpr size_t WS_SC = WS_KBT + (size_t)2 * D * MTOT * 2;
constexpr size_t SC_SA = 0, SC_SMX = (size_t)8 * MTOT * 4, SC_SB = (size_t)16 * MTOT * 4, SC_CE = (size_t)24 * MTOT * 4, SC_DEC = SC_CE + 65536;
constexpr size_t WS_END = WS_SC + SC_DEC + (size_t)2 * 288 * 512 * 4;

struct Args { const float* in[N_IN]; float* out; unsigned char* ws; int ph_lo, ph_hi; };

__device__ __forceinline__ unsigned f2bf(float f) { unsigned u = __builtin_bit_cast(unsigned, f); return (u + 0x7fffu + ((u >> 16) & 1u)) >> 16; }
__device__ __forceinline__ unsigned pk2(float lo, float hi) { return f2bf(lo) | (f2bf(hi) << 16); }
__device__ __forceinline__ float bf2f(unsigned short b) { return __builtin_bit_cast(float, (unsigned)b << 16); }
__device__ __forceinline__ float bflo(unsigned w) { return __builtin_bit_cast(float, w << 16); }
__device__ __forceinline__ float bfhi(unsigned w) { return __builtin_bit_cast(float, w & 0xffff0000u); }
__device__ __forceinline__ float wave_sum(float v) {
#pragma unroll
    for (int o = 1; o < 64; o <<= 1) v += shx(v, o);
    return v;
}
__device__ __forceinline__ float wave_max(float v) {
#pragma unroll
    for (int o = 1; o < 64; o <<= 1) v = fmaxf(v, shx(v, o));
    return v;
}
__device__ __forceinline__ float silu(float x) { return x / (1.f + __expf(-x)); }
__device__ __forceinline__ float sigmoidf_(float x) { return 1.f / (1.f + __expf(-x)); }
__device__ __forceinline__ float log_sigmoid(float x) { return fminf(x, 0.f) - log1pf(__expf(-fabsf(x))); }

struct WDesc { const float* src; bf16_t* dst; int K, N, Npad, perm, tiles; };
__device__ __forceinline__ WDesc get_wdesc(const Args& a, unsigned char* ws, int mi) {
    WDesc w;
    if (mi < 8) { w.src = a.in[I_W13] + (size_t)mi * D * 2 * DFF; w.dst = (bf16_t*)(ws + WS_W13T + mi * W13T_SZ); w.K = D; w.N = 2 * DFF; w.Npad = 2 * DFF; w.perm = 1; }
    else if (mi < 16) { const int j = mi - 8; w.src = a.in[I_W2] + (size_t)j * DFF * D; w.dst = (bf16_t*)(ws + WS_W2T + j * W2T_SZ); w.K = DFF; w.N = D; w.Npad = D; w.perm = 0; }
    else if (mi < 20) { const int j = mi - 16;
        w.src = a.in[j == 0 ? I_NAW : j == 1 ? I_MLW : j == 2 ? I_DAW : I_GLAW];
        w.dst = (bf16_t*)(ws + (j == 0 ? WS_WIN0 : j == 1 ? WS_WIN1 : j == 2 ? WS_WIN2 : WS_WIN3));
        w.K = D; w.N = j == 0 ? 3072 : j == 1 ? 4112 : j == 2 ? 3072 : 3104; w.Npad = j == 0 ? 3072 : j == 1 ? 4352 : j == 2 ? 3072 : 3328; w.perm = 0; }
    else { const int j = mi - 20; w.src = a.in[j == 0 ? I_NAWO : j == 1 ? I_MLWO : j == 2 ? I_DAWO : I_GLAWO]; w.dst = (bf16_t*)(ws + WS_WO + (size_t)j * D * D * 2); w.K = D; w.N = D; w.Npad = D; w.perm = 0; }
    w.tiles = (w.K / 64) * (w.Npad / 64);
    return w;
}
constexpr int TILES_W13 = 16 * 88, TILES_W2 = 44 * 16, TILES_WO = 256;
constexpr int TILES_TOTAL = 8 * TILES_W13 + 8 * TILES_W2 + 16 * (48 + 68 + 48 + 52) + 4 * TILES_WO;

__device__ void p0_prologue(const Args& a, LAS unsigned char* lds) {
    const int tid = TID(), lane = tid & 63, wid = tid >> 6;
    unsigned char* ws = a.ws; asm volatile("" : "+s"(ws));
    {
        LAS float* S = (LAS float*)lds;
        LAS float* red = (LAS float*)(lds + 9 * 1024 * 4);
        for (int i = tid; i < 9 * 1024; i += 512) { const float v = i < 8 * 1024 ? a.in[I_C][i] : a.in[I_CCTX][i - 8 * 1024]; S[i] = silu(v); }
        __syncthreads();
        float* MOD = (float*)(ws + WS_MOD);
        for (int item = BID(); item < 4 * 144; item += GDIM()) {
            const int l = item / 144, cgp = item % 144;
            const int cq = tid & 15, kg = tid >> 4;
            const float* W = a.in[I_ADAW] + (size_t)l * D * MODLD + cgp * 64 + cq * 4;
            f32x4 acc[9];
#pragma unroll
            for (int r = 0; r < 9; ++r) acc[r] = (f32x4){0.f, 0.f, 0.f, 0.f};
#pragma unroll 4
            for (int kk = 0; kk < 32; ++kk) {
                const int k = kg * 32 + kk;
                const f32x4 w4 = *(const f32x4*)(W + (size_t)k * MODLD);
#pragma unroll
                for (int r = 0; r < 9; ++r) acc[r] = acc[r] + w4 * S[r * 1024 + k];
            }
#pragma unroll
            for (int r = 0; r < 9; ++r)
#pragma unroll
                for (int e = 0; e < 4; ++e) { float v = acc[r][e]; v += shx(v, 16); v += shx(v, 32); acc[r][e] = v; }
            if (lane < 16) {
#pragma unroll
                for (int r = 0; r < 9; ++r)
#pragma unroll
                    for (int e = 0; e < 4; ++e) red[(wid * 9 + r) * 64 + cq * 4 + e] = acc[r][e];
            }
            __syncthreads();
            for (int o = tid; o < 9 * 64; o += 512) {
                const int r = o >> 6, cc = o & 63; float v = 0.f;
#pragma unroll
                for (int w = 0; w < 8; ++w) v += red[(w * 9 + r) * 64 + cc];
                const int col = cgp * 64 + cc;
                MOD[((size_t)l * 9 + r) * MODLD + col] = v + a.in[I_ADAB][(size_t)l * MODLD + col];
            }
            __syncthreads();
        }
    }
    {
        LAS float* tile = (LAS float*)lds;
        for (int item = BID(); item < TILES_TOTAL; item += GDIM()) {
            int mi, t = item;
            if (t < 8 * TILES_W13) { mi = t / TILES_W13; t -= mi * TILES_W13; }
            else if (t < 8 * TILES_W13 + 8 * TILES_W2) { t -= 8 * TILES_W13; mi = t / TILES_W2; t -= mi * TILES_W2; mi += 8; }
            else { t -= 8 * TILES_W13 + 8 * TILES_W2;
                if (t < 16 * 48) { mi = 16; } else if (t < 16 * (48 + 68)) { mi = 17; t -= 16 * 48; } else if (t < 16 * (48 + 68 + 48)) { mi = 18; t -= 16 * (48 + 68); }
                else if (t < 16 * (48 + 68 + 48 + 52)) { mi = 19; t -= 16 * (48 + 68 + 48); } else { t -= 16 * (48 + 68 + 48 + 52); mi = 20 + t / TILES_WO; t = t % TILES_WO; } }
            const WDesc w = get_wdesc(a, ws, mi);
            const int ntn = w.Npad / 64, kt = t / ntn, nt = t % ntn, k0 = kt * 64, n0 = nt * 64;
            {
                const int nn = tid & 63, n = n0 + nn;
#pragma unroll
                for (int i = 0; i < 8; ++i) { const int kk = (tid >> 6) + 8 * i; tile[kk * 65 + nn] = n < w.N ? w.src[(size_t)(k0 + kk) * w.N + n] : 0.f; }
            }
            __syncthreads();
            {
                const int kp = tid & 31;
#pragma unroll
                for (int i = 0; i < 4; ++i) {
                    const int nn = (tid >> 5) + 16 * i, n = n0 + nn;
                    int drow = n;
                    if (w.perm) { const int half = n >= DFF ? 1 : 0, jj = n - half * DFF; drow = (jj >> 7) * 256 + half * 128 + (jj & 127); }
                    *(unsigned*)(w.dst + (size_t)drow * w.K + k0 + 2 * kp) = pk2(tile[(2 * kp) * 65 + nn], tile[(2 * kp + 1) * 65 + nn]);
                }
            }
            __syncthreads();
        }
    }
    {
        f32x4* H4 = (f32x4*)(ws + WS_H);
        const f32x4* x4 = (const f32x4*)a.in[I_X]; const f32x4* c4 = (const f32x4*)a.in[I_CTX];
        const int n1 = MLAT * D / 4, n2 = MTOT * D / 4;
        for (int i = BID() * 512 + tid; i < n2; i += GDIM() * 512) H4[i] = i < n1 ? x4[i] : c4[i - n1];
    }
    if (BID() == 0) {
        float* R = (float*)(ws + WS_ROPE);
        for (int i = tid; i < 64 * 16; i += 512) { const int pos = i >> 4, fi = i & 15; const float f = powf(10000.f, -(float)fi / 16.f); const float ang = (float)pos * f; R[i] = cosf(ang); R[1024 + i] = sinf(ang); }
    }
}

__device__ void norm_phase(const float* H, const float* g, const float* modl  , int slot_shift, bf16_t* U, int nrows) {
    const int lane = TID() & 63, gw = BID() * 8 + (TID() >> 6), ngw = GDIM() * 8;
    f32x4 gv[4];
#pragma unroll
    for (int j = 0; j < 4; ++j) gv[j] = *(const f32x4*)(g + j * 256 + lane * 4);
    for (int row = gw; row < nrows; row += ngw) {
        const int mrow = row < MLAT ? (row >> 11) : 8;
        const float* sh = modl + (size_t)mrow * MODLD + slot_shift * D; const float* sc = sh + D;
        f32x4 v[4]; float s = 0.f;
#pragma unroll
        for (int j = 0; j < 4; ++j) { v[j] = *(const f32x4*)(H + (size_t)row * D + j * 256 + lane * 4); s += (v[j][0] * v[j][0] + v[j][1] * v[j][1]) + (v[j][2] * v[j][2] + v[j][3] * v[j][3]); }
        const float rstd = rsqrtf(wave_sum(s) * (1.f / D) + 1e-6f);
#pragma unroll
        for (int j = 0; j < 4; ++j) {
            const f32x4 s4 = *(const f32x4*)(sh + j * 256 + lane * 4), c4 = *(const f32x4*)(sc + j * 256 + lane * 4);
            const f32x4 y = (v[j] * rstd) * gv[j] * (c4 + 1.f) + s4;
            u32x2 o; o.x = pk2(y[0], y[1]); o.y = pk2(y[2], y[3]);
            *(u32x2*)(U + (size_t)row * D + j * 256 + lane * 4) = o;
        }
    }
}
__device__ void final_norm_phase(const float* H, const float* g, float* out) {
    const int lane = TID() & 63, gw = BID() * 8 + (TID() >> 6), ngw = GDIM() * 8;
    f32x4 gv[4];
#pragma unroll
    for (int j = 0; j < 4; ++j) gv[j] = *(const f32x4*)(g + j * 256 + lane * 4);
    for (int row = gw; row < MLAT; row += ngw) {
        f32x4 v[4]; float s = 0.f;
#pragma unroll
        for (int j = 0; j < 4; ++j) { v[j] = *(const f32x4*)(H + (size_t)row * D + j * 256 + lane * 4); s += (v[j][0] * v[j][0] + v[j][1] * v[j][1]) + (v[j][2] * v[j][2] + v[j][3] * v[j][3]); }
        const float rstd = rsqrtf(wave_sum(s) * (1.f / D) + 1e-6f);
#pragma unroll
        for (int j = 0; j < 4; ++j) *(f32x4*)(out + (size_t)row * D + j * 256 + lane * 4) = (v[j] * rstd) * gv[j];
    }
}

__device__ __forceinline__ void unpack8(const u32x4 w, float* f) { f[0] = bflo(w.x); f[1] = bfhi(w.x); f[2] = bflo(w.y); f[3] = bfhi(w.y); f[4] = bflo(w.z); f[5] = bfhi(w.z); f[6] = bflo(w.w); f[7] = bfhi(w.w); }
__device__ void na_naive_phase(const bf16_t* P, const float* rpb, bf16_t* U, LAS unsigned char* lds) {
    constexpr int LD = 3072;
    const int lane = TID() & 63, gw = BID() * 8 + (TID() >> 6), ngw = GDIM() * 8;
    for (int item = gw; item < MTOT * 16; item += ngw) {
        const int row = item >> 4, h = item & 15;
        const bool lat = row < MLAT;
        const int b = lat ? (row >> 11) : ((row - MLAT) >> 8);
        const int t = row & 2047, r = t >> 6, c = t & 63;
        const int r0 = min(max(r - 4, 0), 24), win0 = min(max(c - 8, 0), 48);
        const int nk = lat ? 384 : 256;
        LAS float* q = (LAS float*)lds + (TID() >> 6) * 64;
        q[lane] = bf2f(P[(size_t)row * LD + 2048 + h * 64 + lane]);
        __builtin_amdgcn_wave_barrier();
        float s[6];
#pragma unroll
        for (int jj = 0; jj < 6; ++jj) s[jj] = -1e30f;
#pragma unroll 1
        for (int jj = 0; jj < 6; ++jj) {
            const int kk = lane + 64 * jj;
            float val = -1e30f;
            if (kk < nk) {
                int krow; float bias = 0.f;
                if (lat && kk < 128) { const int kr = r0 + (kk >> 4), kc = win0 + (kk & 15); krow = b * 2048 + kr * 64 + kc; bias = rpb[(h * 15 + (kr - r + 7)) * 31 + (kc - c + 15)]; }
                else krow = MLAT + b * 256 + (lat ? kk - 128 : kk);
                const u32x4* kp = (const u32x4*)(P + (size_t)krow * LD + h * 64);
                float d = 0.f;
#pragma unroll
                for (int i = 0; i < 8; ++i) { float kf[8]; unpack8(kp[i], kf); const f32x4 qa = *(const LAS f32x4*)(q + 8 * i), qb = *(const LAS f32x4*)(q + 8 * i + 4);
                    d += kf[0] * qa[0] + kf[1] * qa[1] + kf[2] * qa[2] + kf[3] * qa[3] + kf[4] * qb[0] + kf[5] * qb[1] + kf[6] * qb[2] + kf[7] * qb[3]; }
                val = d * 0.125f + bias;
            }
#pragma unroll
            for (int k2 = 0; k2 < 6; ++k2) s[k2] = (jj == k2) ? val : s[k2];
        }
        float mx = s[0];
#pragma unroll
        for (int jj = 1; jj < 6; ++jj) mx = fmaxf(mx, s[jj]);
        mx = wave_max(mx);
        float sum = 0.f;
#pragma unroll
        for (int jj = 0; jj < 6; ++jj) { s[jj] = (lane + 64 * jj < nk) ? __expf(s[jj] - mx) : 0.f; sum += s[jj]; }
        sum = wave_sum(sum);
        float o = 0.f;
#pragma unroll
        for (int jj = 0; jj < 6; ++jj) {
            if (jj * 64 < nk) {
#pragma unroll 4
                for (int src = 0; src < 64; ++src) {
                    const int kk = jj * 64 + src;
                    const float p = rdl(s[jj], src);
                    int krow;
                    if (lat && kk < 128) krow = b * 2048 + (r0 + (kk >> 4)) * 64 + win0 + (kk & 15); else krow = MLAT + b * 256 + (lat ? kk - 128 : kk);
                    o += p * bf2f(P[(size_t)krow * LD + 1024 + h * 64 + lane]);
                }
            }
        }
        U[(size_t)row * D + h * 64 + lane] = (bf16_t)f2bf(o / sum);
        __builtin_amdgcn_wave_barrier();
    }
}

__device__ void da_rope_phase(bf16_t* P, const float* R) {
    constexpr int LD = 3072;
    const int gt = BID() * 512 + TID(), ngt = GDIM() * 512;
    for (long it = gt; it < (long)MLAT * 1024; it += ngt) {
        const int row = (int)(it >> 10), w = (int)(it & 1023), sec = w >> 9, grp = (w >> 5) & 15, axis = (w >> 4) & 1, i = w & 15;
        const int t = row & 2047, pos = axis ? (t & 63) : (t >> 6);
        const float cs = R[pos * 16 + i], sn = R[1024 + pos * 16 + i];
        bf16_t* p = P + (size_t)row * LD + sec * 2048 + grp * 64 + axis * 32 + i;
        const float x1 = bf2f(p[0]), x2 = bf2f(p[16]);
        p[0] = (bf16_t)f2bf(x1 * cs - x2 * sn); p[16] = (bf16_t)f2bf(x2 * cs + x1 * sn);
    }
}
__device__ void da_naive_phase(const bf16_t* P, const float* lamp, const float* ng, bf16_t* U, LAS unsigned char* lds) {
    constexpr int LD = 3072;
    const int lane = TID() & 63, wid = TID() >> 6, gw = BID() * 8 + wid, ngw = GDIM() * 8;
    LAS float* qs = (LAS float*)lds + wid * 128;
    const float lam_init = 0.8f - 0.6f * expf(-0.3f * 2.f);
    const float l01 = wave_sum(lamp[lane] * lamp[64 + lane]), l23 = wave_sum(lamp[128 + lane] * lamp[192 + lane]);
    const float lam = expf(l01) - expf(l23) + lam_init;
    for (int item = gw; item < MTOT * 8; item += ngw) {
        const int row = item >> 3, h = item & 7;
        const bool lat = row < MLAT;
        const int b = lat ? (row >> 11) : ((row - MLAT) >> 8);
        const int nkl = lat ? 36 : 4;
        { const bf16_t* qp = P + (size_t)row * LD + 2048 + h * 128; qs[lane] = bf2f(qp[lane]) * 0.125f; qs[64 + lane] = bf2f(qp[64 + lane]) * 0.125f; }
        __builtin_amdgcn_wave_barrier();
        float m0 = -1e30f, m1 = -1e30f, l0 = 0.f, l1 = 0.f;
#pragma unroll 1
        for (int jj = 0; jj < nkl; ++jj) {
            const int kk = lane + 64 * jj;
            const int krow = lat ? (kk < 2048 ? b * 2048 + kk : MLAT + b * 256 + kk - 2048) : MLAT + b * 256 + kk;
            const u32x4* kp = (const u32x4*)(P + (size_t)krow * LD + h * 128);
            float d0 = 0.f, d1 = 0.f;
#pragma unroll
            for (int i = 0; i < 8; ++i) { float kf[8]; unpack8(kp[i], kf); const f32x4 qa = *(const LAS f32x4*)(qs + 8 * i), qb = *(const LAS f32x4*)(qs + 8 * i + 4);
                d0 += kf[0] * qa[0] + kf[1] * qa[1] + kf[2] * qa[2] + kf[3] * qa[3] + kf[4] * qb[0] + kf[5] * qb[1] + kf[6] * qb[2] + kf[7] * qb[3]; }
#pragma unroll
            for (int i = 0; i < 8; ++i) { float kf[8]; unpack8(kp[8 + i], kf); const f32x4 qa = *(const LAS f32x4*)(qs + 64 + 8 * i), qb = *(const LAS f32x4*)(qs + 64 + 8 * i + 4);
                d1 += kf[0] * qa[0] + kf[1] * qa[1] + kf[2] * qa[2] + kf[3] * qa[3] + kf[4] * qb[0] + kf[5] * qb[1] + kf[6] * qb[2] + kf[7] * qb[3]; }
            const float n0 = fmaxf(m0, d0), n1 = fmaxf(m1, d1);
            l0 = l0 * __expf(m0 - n0) + __expf(d0 - n0); l1 = l1 * __expf(m1 - n1) + __expf(d1 - n1); m0 = n0; m1 = n1;
        }
        { const float g0 = wave_max(m0), g1 = wave_max(m1); l0 = wave_sum(l0 * __expf(m0 - g0)); l1 = wave_sum(l1 * __expf(m1 - g1)); m0 = g0; m1 = g1; }
        const float i0 = 1.f / l0, i1 = lam / l1;
        float o0 = 0.f, o1 = 0.f;
#pragma unroll 1
        for (int jj = 0; jj < nkl; ++jj) {
            const int kk0 = lane + 64 * jj;
            const int krow0 = lat ? (kk0 < 2048 ? b * 2048 + kk0 : MLAT + b * 256 + kk0 - 2048) : MLAT + b * 256 + kk0;
            const u32x4* kp = (const u32x4*)(P + (size_t)krow0 * LD + h * 128);
            float d0 = 0.f, d1 = 0.f;
#pragma unroll
            for (int i = 0; i < 8; ++i) { float kf[8]; unpack8(kp[i], kf); const f32x4 qa = *(const LAS f32x4*)(qs + 8 * i), qb = *(const LAS f32x4*)(qs + 8 * i + 4);
                d0 += kf[0] * qa[0] + kf[1] * qa[1] + kf[2] * qa[2] + kf[3] * qa[3] + kf[4] * qb[0] + kf[5] * qb[1] + kf[6] * qb[2] + kf[7] * qb[3]; }
#pragma unroll
            for (int i = 0; i < 8; ++i) { float kf[8]; unpack8(kp[8 + i], kf); const f32x4 qa = *(const LAS f32x4*)(qs + 64 + 8 * i), qb = *(const LAS f32x4*)(qs + 64 + 8 * i + 4);
                d1 += kf[0] * qa[0] + kf[1] * qa[1] + kf[2] * qa[2] + kf[3] * qa[3] + kf[4] * qb[0] + kf[5] * qb[1] + kf[6] * qb[2] + kf[7] * qb[3]; }
            const float wv = __expf(d0 - m0) * i0 - __expf(d1 - m1) * i1;
#pragma unroll 4
            for (int src = 0; src < 64; ++src) {
                const int kk = jj * 64 + src;
                const int krow = lat ? (kk < 2048 ? b * 2048 + kk : MLAT + b * 256 + kk - 2048) : MLAT + b * 256 + kk;
                const float p = rdl(wv, src);
                const bf16_t* vp = P + (size_t)krow * LD + 1024 + h * 128;
                o0 += p * bf2f(vp[lane]); o1 += p * bf2f(vp[64 + lane]);
            }
        }
        const float rstd = rsqrtf(wave_sum(o0 * o0 + o1 * o1) * (1.f / 128.f) + 1e-6f) * (1.f - lam_init);
        U[(size_t)row * D + h * 128 + lane] = (bf16_t)f2bf(o0 * rstd * ng[h * 128 + lane]);
        U[(size_t)row * D + h * 128 + 64 + lane] = (bf16_t)f2bf(o1 * rstd * ng[h * 128 + 64 + lane]);
        __builtin_amdgcn_wave_barrier();
    }
}


typedef short bf16x8 __attribute__((ext_vector_type(8)));
__device__ __forceinline__ bf16x8 pack8(const f32x4 a, const f32x4 b) { u32x4 w; w.x = pk2(a[0], a[1]); w.y = pk2(a[2], a[3]); w.z = pk2(b[0], b[1]); w.w = pk2(b[2], b[3]); return __builtin_bit_cast(bf16x8, w); }
__device__ void da_flash_phase(const bf16_t* P, const bf16_t* VT, const float* lamp, const float* ng, bf16_t* U, LAS unsigned char* lds) {
    constexpr int LD = 3072, KS = 272, VS = 144, KBUF = 64 * KS, VBUF = 128 * VS, BUF = KBUF + VBUF;
    const int tid = TID(), lane = tid & 63, wid = tid >> 6, m16 = lane & 15, quad = lane >> 4;
    const float lam_init = 0.8f - 0.6f * expf(-0.3f * 2.f);
    const float l01 = wave_sum(lamp[lane] * lamp[64 + lane]), l23 = wave_sum(lamp[128 + lane] * lamp[192 + lane]);
    const float lam = expf(l01) - expf(l23) + lam_init;
    const int kkey = tid >> 3, kch = tid & 7, vdv = tid >> 2, vch = tid & 3;
    const int krho = ((kkey >> 5) * 2 + ((kkey >> 2) & 1)) * 16 + ((kkey >> 3) & 3) * 4 + (kkey & 3);
    for (int item = BID(); item < 1024 + 128; item += GDIM()) {
        const bool lat = item < 1024;
        int b, h, qb;
        if (lat) { b = item >> 7; h = (item >> 4) & 7; qb = item & 15; } else { const int i2 = item - 1024; b = i2 >> 4; h = (i2 >> 1) & 7; qb = i2 & 1; }
        const int qrow = (lat ? b * 2048 : MLAT + b * 256) + qb * 128 + wid * 16 + m16;
        const int nblk = lat ? 36 : 4;
        bf16x8 qf[2][2];
        { const bf16_t* qp = P + (size_t)qrow * LD + 2048 + h * 128 + quad * 8;
#pragma unroll
          for (int j = 0; j < 2; ++j)
#pragma unroll
            for (int ks = 0; ks < 2; ++ks) qf[j][ks] = *(const bf16x8*)(qp + j * 64 + ks * 32); }
        f32x4 O[2][8];
#pragma unroll
        for (int j = 0; j < 2; ++j)
#pragma unroll
            for (int dt = 0; dt < 8; ++dt) O[j][dt] = (f32x4){0.f, 0.f, 0.f, 0.f};
        float mrun[2] = {-1e30f, -1e30f}, lrun[2] = {0.f, 0.f};
        u32x4 rk0, rk1, rv0, rv1;
        {
            const int kr0 = lat ? b * 2048 : MLAT + b * 256;
            const bf16_t* kp = P + (size_t)(kr0 + kkey) * LD + h * 128 + kch * 8;
            rk0 = *(const u32x4*)kp; rk1 = *(const u32x4*)(kp + 64);
            const bf16_t* vp = VT + (size_t)(h * 128 + vdv) * MTOT + kr0 + vch * 8;
            rv0 = *(const u32x4*)vp; rv1 = *(const u32x4*)(vp + 32);
            LAS unsigned char* Kb = lds; LAS unsigned char* Vb = lds + KBUF;
            *(LAS u32x4*)(Kb + krho * KS + kch * 16) = rk0; *(LAS u32x4*)(Kb + krho * KS + (kch + 8) * 16) = rk1;
            *(LAS u32x4*)(Vb + vdv * VS + vch * 16) = rv0; *(LAS u32x4*)(Vb + vdv * VS + (vch + 4) * 16) = rv1;
        }
        __syncthreads();
#pragma unroll 1
        for (int kb = 0; kb < nblk; ++kb) {
            const bool more = kb + 1 < nblk;
            if (more) {
                const int k1 = kb + 1;
                const int kr0 = lat ? (k1 < 32 ? b * 2048 + k1 * 64 : MLAT + b * 256 + (k1 - 32) * 64) : MLAT + b * 256 + k1 * 64;
                const bf16_t* kp = P + (size_t)(kr0 + kkey) * LD + h * 128 + kch * 8;
                rk0 = *(const u32x4*)kp; rk1 = *(const u32x4*)(kp + 64);
                const bf16_t* vp = VT + (size_t)(h * 128 + vdv) * MTOT + kr0 + vch * 8;
                rv0 = *(const u32x4*)vp; rv1 = *(const u32x4*)(vp + 32);
            }
            LAS const unsigned char* Kb = lds + (kb & 1) * BUF; LAS const unsigned char* Vb = Kb + KBUF;
            f32x4 st[2][2][2];
#pragma unroll
            for (int sb = 0; sb < 2; ++sb)
#pragma unroll
                for (int j = 0; j < 2; ++j)
#pragma unroll
                    for (int T = 0; T < 2; ++T) {
                        f32x4 acc = (f32x4){0.f, 0.f, 0.f, 0.f};
#pragma unroll
                        for (int ks = 0; ks < 2; ++ks) {
                            const bf16x8 A = *(LAS const bf16x8*)(Kb + ((sb * 2 + T) * 16 + m16) * KS + (j * 64 + ks * 32 + quad * 8) * 2);
                            acc = __builtin_amdgcn_mfma_f32_16x16x32_bf16(A, qf[j][ks], acc, 0, 0, 0);
                        }
                        st[sb][j][T] = acc;
                    }
#pragma unroll
            for (int j = 0; j < 2; ++j) {
                float mx = -1e30f;
#pragma unroll
                for (int sb = 0; sb < 2; ++sb)
#pragma unroll
                    for (int T = 0; T < 2; ++T)
#pragma unroll
                        for (int e = 0; e < 4; ++e) mx = fmaxf(mx, st[sb][j][T][e]);
                mx = fmaxf(mx, shx(mx, 16)); mx = fmaxf(mx, shx(mx, 32));
                const float mnew = fmaxf(mrun[j], mx), alpha = __expf(mrun[j] - mnew);
                mrun[j] = mnew;
                float ps = 0.f;
#pragma unroll
                for (int sb = 0; sb < 2; ++sb)
#pragma unroll
                    for (int T = 0; T < 2; ++T)
#pragma unroll
                        for (int e = 0; e < 4; ++e) { const float pv = __expf(st[sb][j][T][e] - mnew); st[sb][j][T][e] = pv; ps += pv; }
                lrun[j] = lrun[j] * alpha + ps;
#pragma unroll
                for (int dt = 0; dt < 8; ++dt) O[j][dt] = O[j][dt] * alpha;
            }
#pragma unroll
            for (int sb = 0; sb < 2; ++sb) {
                const bf16x8 p0 = pack8(st[sb][0][0], st[sb][0][1]), p1 = pack8(st[sb][1][0], st[sb][1][1]);
#pragma unroll
                for (int dt = 0; dt < 8; ++dt) {
                    const bf16x8 A = *(LAS const bf16x8*)(Vb + (dt * 16 + m16) * VS + (sb * 32 + quad * 8) * 2);
                    O[0][dt] = __builtin_amdgcn_mfma_f32_16x16x32_bf16(A, p0, O[0][dt], 0, 0, 0);
                    O[1][dt] = __builtin_amdgcn_mfma_f32_16x16x32_bf16(A, p1, O[1][dt], 0, 0, 0);
                }
            }
            if (more) {
                LAS unsigned char* Kn = lds + ((kb + 1) & 1) * BUF; LAS unsigned char* Vn = Kn + KBUF;
                *(LAS u32x4*)(Kn + krho * KS + kch * 16) = rk0; *(LAS u32x4*)(Kn + krho * KS + (kch + 8) * 16) = rk1;
                *(LAS u32x4*)(Vn + vdv * VS + vch * 16) = rv0; *(LAS u32x4*)(Vn + vdv * VS + (vch + 4) * 16) = rv1;
            }
            __syncthreads();
        }
        float l0 = lrun[0], l1 = lrun[1];
        l0 += shx(l0, 16); l0 += shx(l0, 32); l1 += shx(l1, 16); l1 += shx(l1, 32);
        const float i0 = 1.f / l0, i1 = lam / l1;
        float ss = 0.f;
#pragma unroll
        for (int dt = 0; dt < 8; ++dt) { O[0][dt] = O[0][dt] * i0 - O[1][dt] * i1;
#pragma unroll
            for (int e = 0; e < 4; ++e) ss += O[0][dt][e] * O[0][dt][e]; }
        ss += shx(ss, 16); ss += shx(ss, 32);
        const float rstd = rsqrtf(ss * (1.f / 128.f) + 1e-6f) * (1.f - lam_init);
#pragma unroll
        for (int dt = 0; dt < 8; ++dt) {
            const int c = h * 128 + dt * 16 + quad * 4;
            const f32x4 g4 = *(const f32x4*)(ng + c);
            const f32x4 y = O[0][dt] * rstd * g4;
            u32x2 o; o.x = pk2(y[0], y[1]); o.y = pk2(y[2], y[3]);
            *(u32x2*)(U + (size_t)qrow * D + c) = o;
        }
    }
}


__device__ void na_mfma_phase(const bf16_t* P, const bf16_t* VT, const float* rpb, bf16_t* U) {
    constexpr int LD = 3072;
    const int lane = TID() & 63, gw = BID() * 8 + (TID() >> 6), ngw = GDIM() * 8, m16 = lane & 15, quad = lane >> 4;
    const int krow_in = (m16 >> 2) * 8 + (m16 & 3);
    for (int item = gw; item < 16384 + 2048; item += ngw) {
        const bool lat = item < 16384;
        int b, h, r = 0, j = 0, qrow;
        if (lat) { b = item >> 11; h = (item >> 7) & 15; r = (item >> 2) & 31; j = item & 3; qrow = b * 2048 + r * 64 + j * 16 + m16; }
        else { const int i2 = item - 16384; b = i2 >> 8; h = (i2 >> 4) & 15; qrow = MLAT + b * 256 + (i2 & 15) * 16 + m16; }
        const int r0 = min(max(r - 4, 0), 24), kc0 = min(max(16 * j - 8, 0), 32);
        const int c = j * 16 + m16, win0 = min(max(c - 8, 0), 48);
        bf16x8 qf[2];
        { const bf16_t* qp = P + (size_t)qrow * LD + 2048 + h * 64 + quad * 8; qf[0] = *(const bf16x8*)qp; qf[1] = *(const bf16x8*)(qp + 32); }
        f32x4 st[16][2];
        float mx = -1e30f;
#pragma unroll
        for (int sp = 0; sp < 16; ++sp) {
            if (sp < 8 && !lat) { st[sp][0] = (f32x4){-1e30f, -1e30f, -1e30f, -1e30f}; st[sp][1] = st[sp][0]; continue; }
            const int tok0 = sp < 8 ? b * 2048 + (r0 + sp) * 64 + kc0 : MLAT + b * 256 + (sp - 8) * 32;
#pragma unroll
            for (int T = 0; T < 2; ++T) {
                const bf16_t* kp = P + (size_t)(tok0 + krow_in + 4 * T) * LD + h * 64 + quad * 8;
                f32x4 acc = (f32x4){0.f, 0.f, 0.f, 0.f};
                acc = __builtin_amdgcn_mfma_f32_16x16x32_bf16(*(const bf16x8*)kp, qf[0], acc, 0, 0, 0);
                acc = __builtin_amdgcn_mfma_f32_16x16x32_bf16(*(const bf16x8*)(kp + 32), qf[1], acc, 0, 0, 0);
                if (sp < 8) {
                    const int ro = (r0 + sp - r + 7) * 31;
#pragma unroll
                    for (int e = 0; e < 4; ++e) {
                        const int kc = kc0 + quad * 8 + T * 4 + e;
                        const bool inw = (kc >= win0) && (kc < win0 + 16);
                        const float bias = rpb[h * 465 + (inw ? ro + (kc - c + 15) : 0)];
                        acc[e] = inw ? acc[e] + bias : -1e30f;
                    }
                }
                st[sp][T] = acc;
#pragma unroll
                for (int e = 0; e < 4; ++e) mx = fmaxf(mx, acc[e]);
            }
        }
        mx = fmaxf(mx, shx(mx, 16)); mx = fmaxf(mx, shx(mx, 32));
        float sum = 0.f;
        f32x4 O[4];
#pragma unroll
        for (int dt = 0; dt < 4; ++dt) O[dt] = (f32x4){0.f, 0.f, 0.f, 0.f};
#pragma unroll
        for (int sp = 0; sp < 16; ++sp) {
            if (sp < 8 && !lat) continue;
#pragma unroll
            for (int T = 0; T < 2; ++T)
#pragma unroll
                for (int e = 0; e < 4; ++e) { const float pv = __expf(st[sp][T][e] - mx); st[sp][T][e] = pv; sum += pv; }
            const bf16x8 pf = pack8(st[sp][0], st[sp][1]);
            const int tok0 = sp < 8 ? b * 2048 + (r0 + sp) * 64 + kc0 : MLAT + b * 256 + (sp - 8) * 32;
#pragma unroll
            for (int dt = 0; dt < 4; ++dt) {
                const bf16x8 Av = *(const bf16x8*)(VT + (size_t)(h * 64 + dt * 16 + m16) * MTOT + tok0 + quad * 8);
                O[dt] = __builtin_amdgcn_mfma_f32_16x16x32_bf16(Av, pf, O[dt], 0, 0, 0);
            }
        }
        sum += shx(sum, 16); sum += shx(sum, 32);
        const float inv = 1.f / sum;
#pragma unroll
        for (int dt = 0; dt < 4; ++dt) {
            const f32x4 y = O[dt] * inv;
            u32x2 o; o.x = pk2(y[0], y[1]); o.y = pk2(y[2], y[3]);
            *(u32x2*)(U + (size_t)qrow * D + h * 64 + dt * 16 + quad * 4) = o;
        }
    }
}

constexpr int ML_LD = 4352, ML_NKVG = 2064;
__device__ void ml_prep_phase(const bf16_t* P, const float* convw, bf16_t* QC, bf16_t* KC) {
    const int gt = BID() * 512 + TID(), ngt = GDIM() * 512;
    for (long it = gt; it < (long)MTOT * 2048; it += ngt) {
        const int row = (int)(it >> 11), w = (int)(it & 2047), isq = w >> 10, ch = w & 1023;
        const bool lat = row < MLAT;
        const int pos = lat ? (row & 2047) : ((row - MLAT) & 255), len = lat ? 2048 : 256;
        const int col = isq ? (ML_NKVG + ch) : ch;
        const float w0 = convw[0 * 2048 + isq * 1024 + ch], w1 = convw[1 * 2048 + isq * 1024 + ch], w2 = convw[2 * 2048 + isq * 1024 + ch];
        const bf16_t* p = P + (size_t)row * ML_LD + col;
        float v = w1 * bf2f(p[0]);
        if (pos > 0) v += w0 * bf2f(p[-ML_LD]);
        if (pos < len - 1) v += w2 * bf2f(p[ML_LD]);
        v = silu(v);
        if (isq) QC[(size_t)row * D + ch] = (bf16_t)f2bf(v); else KC[(size_t)row * D + ch] = (bf16_t)f2bf(v * 0.0625f);
    }
}
__device__ void ml_scan_naive_phase(const bf16_t* P, const float* G32, const float* gate_b, const bf16_t* QC, const bf16_t* KC, float* HS, LAS unsigned char* lds) {
    const int tid = TID(), dvl = tid & 63, g = tid >> 6;
    LAS float* red = (LAS float*)lds;
    LAS float* redd = red + 2 * 8 * 64;
    for (int item = BID(); item < 256; item += GDIM()) {
        const int dir = item >> 7, b = (item >> 4) & 7, h = (item >> 2) & 3, sl = item & 3;
        const float bi = gate_b[dir * 8 + h], bfg = gate_b[dir * 8 + 4 + h];
        float C[32], n[32];
#pragma unroll
        for (int j = 0; j < 32; ++j) { C[j] = 0.f; n[j] = 0.f; }
        float m = 0.f;
        for (int step = 0; step < CTXL + SEQ; ++step) {
            int row;
            if (step < CTXL) row = MLAT + b * CTXL + (dir ? CTXL - 1 - step : step);
            else { const int s2 = step - CTXL; row = b * SEQ + (dir ? SEQ - 1 - s2 : s2); }
            const float ig = G32[(size_t)row * 32 + dir * 8 + h] + bi, fg = G32[(size_t)row * 32 + dir * 8 + 4 + h] + bfg;
            const float lf = log_sigmoid(fg);
            const float mn = fmaxf(lf + m, ig), fw = __expf(lf + m - mn), iw = __expf(ig - mn);
            m = mn;
            const float v = bf2f(P[(size_t)row * ML_LD + 1024 + h * 256 + sl * 64 + dvl]);
            const u32x4* qp = (const u32x4*)(QC + (size_t)row * D + h * 256 + g * 32);
            const u32x4* kp = (const u32x4*)(KC + (size_t)row * D + h * 256 + g * 32);
            float part = 0.f, dpart = 0.f;
#pragma unroll
            for (int i = 0; i < 4; ++i) {
                float qf[8], kf[8]; unpack8(qp[i], qf); unpack8(kp[i], kf);
#pragma unroll
                for (int e = 0; e < 8; ++e) {
                    const int j = 8 * i + e;
                    C[j] = fw * C[j] + (iw * kf[e]) * v; n[j] = fw * n[j] + iw * kf[e];
                    part += qf[e] * C[j]; dpart += qf[e] * n[j];
                }
            }
            const int pb = step & 1;
            red[(pb * 8 + g) * 64 + dvl] = part;
            if (dvl == 0) redd[pb * 8 + g] = dpart;
            __syncthreads();
            if (tid < 64) {
                float num = 0.f, den = 0.f;
#pragma unroll
                for (int w = 0; w < 8; ++w) { num += red[(pb * 8 + w) * 64 + tid]; den += redd[pb * 8 + w]; }
                HS[((size_t)dir * MTOT + row) * D + h * 256 + sl * 64 + tid] = num / fmaxf(fabsf(den), __expf(-m));
            }
        }
        __syncthreads();
    }
}
__device__ void ml_readout_phase(const bf16_t* P, const bf16_t* HS, const float* ng, bf16_t* U) {
    const int lane = TID() & 63, gw = BID() * 8 + (TID() >> 6), ngw = GDIM() * 8;
    for (int row = gw; row < MTOT; row += ngw) {
        const int c0 = lane * 16;
        float v[16]; float ss = 0.f;
#pragma unroll
        for (int i = 0; i < 2; ++i) {
            float f0[8], f1[8]; unpack8(*(const u32x4*)(HS + (size_t)row * D + c0 + 8 * i), f0); unpack8(*(const u32x4*)(HS + ((size_t)MTOT + row) * D + c0 + 8 * i), f1);
#pragma unroll
            for (int e = 0; e < 8; ++e) { v[8 * i + e] = f0[e] + f1[e]; ss += v[8 * i + e] * v[8 * i + e]; }
        }
        ss += shx(ss, 1); ss += shx(ss, 2); ss += shx(ss, 4); ss += shx(ss, 8);
        const float rstd = rsqrtf(ss * (1.f / 256.f) + 1e-6f);
        const bf16_t* op = P + (size_t)row * ML_LD + ML_NKVG + D + c0;
        unsigned o[8];
#pragma unroll
        for (int i = 0; i < 8; ++i) {
            const float y0 = sigmoidf_(bf2f(op[2 * i])) * v[2 * i] * rstd * ng[c0 + 2 * i], y1 = sigmoidf_(bf2f(op[2 * i + 1])) * v[2 * i + 1] * rstd * ng[c0 + 2 * i + 1];
            o[i] = pk2(y0, y1);
        }
        u32x4* up = (u32x4*)(U + (size_t)row * D + c0);
        up[0] = (u32x4){o[0], o[1], o[2], o[3]}; up[1] = (u32x4){o[4], o[5], o[6], o[7]};
    }
}

constexpr int GL_LD = 3328, GL_NKVG = 1568;
__device__ void gla_prep_phase(const float* G32, const float* wgu, const float* bg, float* LA) {
    const int gt = BID() * 512 + TID(), ngt = GDIM() * 512;
    for (long it = gt; it < (long)2 * MTOT * 512; it += ngt) {
        const int c = (int)(it & 511), row = (int)((it >> 9) % MTOT), dir = (int)(it / ((long)MTOT * 512));
        const float* low = G32 + (size_t)row * 32 + dir * 16;
        float acc = bg[dir * 512 + c];
#pragma unroll
        for (int r = 0; r < 16; ++r) acc += low[r] * wgu[(dir * 16 + r) * 512 + c];
        LA[((size_t)dir * MTOT + row) * 512 + c] = log_sigmoid(acc) * (1.f / 16.f);
    }
}
__device__ void gla_scan_naive_phase(const bf16_t* P, const float* LA, float* HS, LAS unsigned char* lds) {
    const int tid = TID(), dvl = tid & 63, g = tid >> 6;
    LAS float* red = (LAS float*)lds;
    for (int item = BID(); item < 256; item += GDIM()) {
        const int dir = item >> 7, b = (item >> 4) & 7, h = (item >> 2) & 3, sl = item & 3;
        float S[16];
#pragma unroll
        for (int j = 0; j < 16; ++j) S[j] = 0.f;
        for (int step = 0; step < CTXL + SEQ; ++step) {
            int row;
            if (step < CTXL) row = MLAT + b * CTXL + (dir ? CTXL - 1 - step : step);
            else { const int s2 = step - CTXL; row = b * SEQ + (dir ? SEQ - 1 - s2 : s2); }
            const float v = bf2f(P[(size_t)row * GL_LD + 512 + h * 256 + sl * 64 + dvl]);
            const u32x4* kp = (const u32x4*)(P + (size_t)row * GL_LD + h * 128 + g * 16);
            const u32x4* qp = (const u32x4*)(P + (size_t)row * GL_LD + GL_NKVG + h * 128 + g * 16);
            const f32x4* lp = (const f32x4*)(LA + ((size_t)dir * MTOT + row) * 512 + h * 128 + g * 16);
            float part = 0.f;
#pragma unroll
            for (int i = 0; i < 2; ++i) {
                float qf[8], kf[8]; unpack8(qp[i], qf); unpack8(kp[i], kf);
                const f32x4 la0 = lp[2 * i], la1 = lp[2 * i + 1];
#pragma unroll
                for (int e = 0; e < 8; ++e) {
                    const int j = 8 * i + e; const float al = __expf(e < 4 ? la0[e] : la1[e - 4]);
                    S[j] = al * S[j] + kf[e] * v; part += qf[e] * S[j];
                }
            }
            const int pb = step & 1;
            red[(pb * 8 + g) * 64 + dvl] = part;
            __syncthreads();
            if (tid < 64 && step >= CTXL) {
                float num = 0.f;
#pragma unroll
                for (int w = 0; w < 8; ++w) num += red[(pb * 8 + w) * 64 + tid];
                HS[((size_t)dir * MTOT + row) * D + h * 256 + sl * 64 + tid] = num * 0.08838834764831845f;
            }
        }
        __syncthreads();
    }
}
__device__ void gla_readout_phase(const bf16_t* P, const bf16_t* HS, const float* ng, bf16_t* U) {
    const int lane = TID() & 63, gw = BID() * 8 + (TID() >> 6), ngw = GDIM() * 8;
    for (int row = gw; row < MLAT; row += ngw) {
        const int c0 = lane * 16;
        float v[16]; float ss = 0.f;
#pragma unroll
        for (int i = 0; i < 2; ++i) {
            float f0[8], f1[8]; unpack8(*(const u32x4*)(HS + (size_t)row * D + c0 + 8 * i), f0); unpack8(*(const u32x4*)(HS + ((size_t)MTOT + row) * D + c0 + 8 * i), f1);
#pragma unroll
            for (int e = 0; e < 8; ++e) { v[8 * i + e] = f0[e] + f1[e]; ss += v[8 * i + e] * v[8 * i + e]; }
        }
        ss += shx(ss, 1); ss += shx(ss, 2); ss += shx(ss, 4); ss += shx(ss, 8);
        const float rstd = rsqrtf(ss * (1.f / 256.f) + 1e-6f);
        const bf16_t* rp = P + (size_t)row * GL_LD + GL_NKVG + 512 + c0;
        unsigned o[8];
#pragma unroll
        for (int i = 0; i < 8; ++i) {
            const float y0 = silu(bf2f(rp[2 * i])) * v[2 * i] * rstd * ng[c0 + 2 * i], y1 = silu(bf2f(rp[2 * i + 1])) * v[2 * i + 1] * rstd * ng[c0 + 2 * i + 1];
            o[i] = pk2(y0, y1);
        }
        u32x4* up = (u32x4*)(U + (size_t)row * D + c0);
        up[0] = (u32x4){o[0], o[1], o[2], o[3]}; up[1] = (u32x4){o[4], o[5], o[6], o[7]};
    }
}


__device__ __forceinline__ int chunk_row0(int cidx) { return cidx < 256 ? (cidx >> 5) * 2048 + (cidx & 31) * 64 : MLAT + ((cidx - 256) >> 2) * 256 + ((cidx - 256) & 3) * 64; }
__device__ void ml_prep2_phase(const bf16_t* P, const float* G32, const float* gate_b, const float* convw, bf16_t* QC, bf16_t* KC, bf16_t* KBT, unsigned char* sc, LAS unsigned char* lds) {
    constexpr int KTS = 258;
    const int tid = TID();
    LAS bf16_t* ktile = (LAS bf16_t*)lds;
    LAS float* lfL = (LAS float*)(lds + 64 * KTS * 2);
    LAS float* igL = lfL + 128; LAS float* aL = igL + 128; LAS float* aeL = aL + 128;
    float* SA = (float*)(sc + SC_SA); float* SMX = (float*)(sc + SC_SMX); float* SB = (float*)(sc + SC_SB); float* CE = (float*)(sc + SC_CE);
    for (int item = BID(); item < 288 * 4; item += GDIM()) {
        const int cidx = item >> 2, h = item & 3, row0 = chunk_row0(cidx);
        const int p0 = cidx < 256 ? (cidx & 31) * 64 : ((cidx - 256) & 3) * 64, len = cidx < 256 ? 2048 : 256;
        if (tid < 128) { const int dir = tid >> 6, tau = tid & 63; const float* gp = G32 + (size_t)(row0 + tau) * 32 + dir * 8 + h;
            igL[dir * 64 + tau] = gp[0] + gate_b[dir * 8 + h]; lfL[dir * 64 + tau] = log_sigmoid(gp[4] + gate_b[dir * 8 + 4 + h]); }
        for (int idx = tid; idx < 2 * 64 * 256; idx += 512) {
            const int isq = idx >> 14, tau = (idx >> 8) & 63, ch = idx & 255, c = h * 256 + ch, row = row0 + tau, pos = p0 + tau;
            const float w0 = convw[0 * 2048 + isq * 1024 + c], w1 = convw[1 * 2048 + isq * 1024 + c], w2 = convw[2 * 2048 + isq * 1024 + c];
            const bf16_t* pp = P + (size_t)row * ML_LD + (isq ? ML_NKVG + c : c);
            float v = w1 * bf2f(pp[0]);
            if (pos > 0) v += w0 * bf2f(pp[-ML_LD]);
            if (pos < len - 1) v += w2 * bf2f(pp[ML_LD]);
            v = silu(v);
            if (isq) QC[(size_t)row * D + c] = (bf16_t)f2bf(v);
            else { const bf16_t kb = (bf16_t)f2bf(v * 0.0625f); KC[(size_t)row * D + c] = kb; ktile[tau * KTS + ch] = kb; }
        }
        __syncthreads();
        if (tid < 2) {
            const int dir = tid; float run = 0.f, mx = -1e30f;
            for (int pp = 0; pp < 64; ++pp) {
                const int tau = dir ? 63 - pp : pp;
                run += lfL[dir * 64 + tau]; const float av = igL[dir * 64 + tau] - run; mx = fmaxf(mx, av);
                const size_t o = ((size_t)(dir * 4 + h)) * MTOT + row0 + tau;
                SB[o] = run; SA[o] = av; SMX[o] = mx; aL[dir * 64 + tau] = av;
            }
            CE[((dir * 4 + h) * 288 + cidx) * 2] = mx; CE[((dir * 4 + h) * 288 + cidx) * 2 + 1] = run; aeL[dir] = mx;
        }
        __syncthreads();
        for (int idx = tid; idx < 2 * 256 * 8; idx += 512) {
            const int dir = idx >> 11, dk = (idx >> 3) & 255, sc8 = idx & 7; const float ae = aeL[dir];
            unsigned o[4];
#pragma unroll
            for (int i = 0; i < 4; ++i) { const int s0 = sc8 * 8 + 2 * i;
                o[i] = pk2(bf2f(ktile[s0 * KTS + dk]) * __expf(aL[dir * 64 + s0] - ae), bf2f(ktile[(s0 + 1) * KTS + dk]) * __expf(aL[dir * 64 + s0 + 1] - ae)); }
            *(u32x4*)(KBT + ((size_t)dir * D + h * 256 + dk) * MTOT + row0 + sc8 * 8) = (u32x4){o[0], o[1], o[2], o[3]};
        }
        __syncthreads();
    }
}
__device__ void gla_prep2_phase(const bf16_t* P, const float* G32, const float* wgu, const float* bg, bf16_t* QA, bf16_t* KA, bf16_t* KBT, unsigned char* sc, LAS unsigned char* lds) {
    const int tid = TID();
    LAS float* laL = (LAS float*)lds;
    LAS float* beL = laL + 2 * 64 * 128;
    float* DEC = (float*)(sc + SC_DEC);
    for (int item = BID(); item < 288 * 4; item += GDIM()) {
        const int cidx = item >> 2, h = item & 3, row0 = chunk_row0(cidx);
        {
            const int dk = tid & 127, dir = (tid >> 7) & 1, tg = tid >> 8;
            float w[16];
#pragma unroll
            for (int r = 0; r < 16; ++r) w[r] = wgu[(dir * 16 + r) * 512 + h * 128 + dk];
            const float bgv = bg[dir * 512 + h * 128 + dk];
            for (int tau = tg * 32; tau < tg * 32 + 32; ++tau) {
                const float* low = G32 + (size_t)(row0 + tau) * 32 + dir * 16;
                float acc = bgv;
#pragma unroll
                for (int r = 0; r < 16; ++r) acc += low[r] * w[r];
                laL[(dir * 64 + tau) * 128 + dk] = log_sigmoid(acc) * (1.f / 16.f);
            }
        }
        __syncthreads();
        if (tid < 256) {
            const int dir = tid >> 7, dk = tid & 127; float run = 0.f;
            for (int pp = 0; pp < 64; ++pp) { const int tau = dir ? 63 - pp : pp; run += laL[(dir * 64 + tau) * 128 + dk]; laL[(dir * 64 + tau) * 128 + dk] = run; }
            beL[dir * 128 + dk] = run; DEC[((size_t)dir * 288 + cidx) * 512 + h * 128 + dk] = __expf(run);
        }
        __syncthreads();
        for (int idx = tid; idx < 2 * 64 * 128; idx += 512) {
            const int dir = idx >> 13, tau = (idx >> 7) & 63, dk = idx & 127; const float bc = laL[(dir * 64 + tau) * 128 + dk];
            const bf16_t* pp = P + (size_t)(row0 + tau) * GL_LD + h * 128 + dk;
            const size_t o = ((size_t)dir * MTOT + row0 + tau) * 512 + h * 128 + dk;
            QA[o] = (bf16_t)f2bf(bf2f(pp[GL_NKVG]) * __expf(bc) * 0.08838834764831845f); KA[o] = (bf16_t)f2bf(bf2f(pp[0]) * __expf(-bc));
        }
        for (int idx = tid; idx < 2 * 128 * 8; idx += 512) {
            const int dir = idx >> 10, dk = (idx >> 3) & 127, sc8 = idx & 7; const float be = beL[dir * 128 + dk];
            unsigned o[4];
#pragma unroll
            for (int i = 0; i < 4; ++i) { const int s0 = sc8 * 8 + 2 * i; const bf16_t* pp = P + (size_t)(row0 + s0) * GL_LD + h * 128 + dk;
                o[i] = pk2(bf2f(pp[0]) * __expf(be - laL[(dir * 64 + s0) * 128 + dk]), bf2f(pp[GL_LD]) * __expf(be - laL[(dir * 64 + s0 + 1) * 128 + dk])); }
            *(u32x4*)(KBT + ((size_t)dir * 512 + h * 128 + dk) * MTOT + row0 + sc8 * 8) = (u32x4){o[0], o[1], o[2], o[3]};
        }
        __syncthreads();
    }
}
template <int DK, bool ML>
__device__ void chunk_scan_phase(const bf16_t* QAg, const bf16_t* KAg, size_t qa_dir_stride, const bf16_t* KBT, const bf16_t* VT, const unsigned char* sc, bf16_t* HS, LAS unsigned char* lds) {
    constexpr int RS = 4 * DK;
    constexpr int QS = DK * 2 + 16, VS = 144;
    constexpr int NG = DK / 64;
    constexpr int OFF_QA = 0, OFF_KA = 64 * QS, OFF_KBT = 2 * 64 * QS, OFF_VT = OFF_KBT + DK * VS, OFF_PT = OFF_VT + 64 * VS, OFF_TAB = OFF_PT + 8192;
    static_assert(OFF_TAB + 8192 <= 135168, "LDS");
    const int tid = TID(), lane = tid & 63, wid = tid >> 6, m16 = lane & 15, quad = lane >> 4, dt = wid & 3, kh = wid >> 2;
    LAS float* aL = (LAS float*)(lds + OFF_TAB);
    LAS float* mxL = aL + 64; LAS float* bL = aL + 128;
    LAS float* rsL = aL + 256;
    LAS float* qnL = aL + 384;
    LAS float* nL = aL + 896;
    LAS float* decL = aL;
    LAS f32x4* XL = (LAS f32x4*)(lds + OFF_KA);
    const float* SA = (const float*)(sc + SC_SA); const float* SMX = (const float*)(sc + SC_SMX); const float* SB = (const float*)(sc + SC_SB); const float* CE = (const float*)(sc + SC_CE);
    const float* DEC = (const float*)(sc + SC_DEC);
    for (int item = BID(); item < 256; item += GDIM()) {
        const int dir = item >> 7, b = (item >> 4) & 7, h = (item >> 2) & 3, sl = item & 3;
        const bf16_t* QAd = QAg + dir * qa_dir_stride; const bf16_t* KAd = KAg + dir * qa_dir_stride;
        const bf16_t* KBTd = KBT + ((size_t)dir * 4 * DK + h * DK) * MTOT;
        const bf16_t* VTd = VT + (size_t)(h * 256 + sl * 64) * MTOT;
        f32x4 Cst[NG][2];
#pragma unroll
        for (int g = 0; g < NG; ++g) { Cst[g][0] = (f32x4){0.f, 0.f, 0.f, 0.f}; Cst[g][1] = (f32x4){0.f, 0.f, 0.f, 0.f}; }
        float mrun = 0.f;
        if (ML && tid < 256) nL[tid] = 0.f;
#pragma unroll 1
        for (int ci = 0; ci < 36; ++ci) {
            int cidx;
            if (ci < 4) cidx = 256 + b * 4 + (dir ? 3 - ci : ci); else cidx = b * 32 + (dir ? 35 - ci : ci - 4);
            const int row0 = chunk_row0(cidx);
            for (int c = tid; c < 64 * DK / 8; c += 512) {
                const int r = c / (DK / 8), cc = c % (DK / 8);
                const u32x4 vq = *(const u32x4*)(QAd + (size_t)(row0 + r) * RS + h * DK + cc * 8), vk = *(const u32x4*)(KAd + (size_t)(row0 + r) * RS + h * DK + cc * 8);
                const int rho = ((r >> 5) * 2 + ((r >> 2) & 1)) * 16 + ((r >> 3) & 3) * 4 + (r & 3);
                *(LAS u32x4*)(lds + OFF_QA + r * QS + cc * 16) = vq; *(LAS u32x4*)(lds + OFF_KA + rho * QS + cc * 16) = vk;
            }
            for (int c = tid; c < DK * 8; c += 512) {
                const int r = c >> 3, cc = c & 7;
                const u32x4 v = *(const u32x4*)(KBTd + (size_t)r * MTOT + row0 + cc * 8);
                const int rho = (r & ~31) + ((r >> 2) & 1) * 16 + ((r >> 3) & 3) * 4 + (r & 3);
                *(LAS u32x4*)(lds + OFF_KBT + rho * VS + cc * 16) = v;
            }
            { const int r = tid >> 3, cc = tid & 7; *(LAS u32x4*)(lds + OFF_VT + r * VS + cc * 16) = *(const u32x4*)(VTd + (size_t)r * MTOT + row0 + cc * 8); }
            float ae = 0.f, be = 0.f;
            if (ML) {
                if (tid < 64) aL[tid] = SA[(size_t)(dir * 4 + h) * MTOT + row0 + tid];
                else if (tid < 128) aL[tid] = SMX[(size_t)(dir * 4 + h) * MTOT + row0 + tid - 64];
                else if (tid < 192) aL[tid] = SB[(size_t)(dir * 4 + h) * MTOT + row0 + tid - 128];
                ae = CE[((dir * 4 + h) * 288 + cidx) * 2]; be = CE[((dir * 4 + h) * 288 + cidx) * 2 + 1];
            } else {
                if (tid < DK) decL[tid] = DEC[((size_t)dir * 288 + cidx) * 512 + h * DK + tid];
            }
            __syncthreads();
            f32x4 st[2] = {(f32x4){0.f, 0.f, 0.f, 0.f}, (f32x4){0.f, 0.f, 0.f, 0.f}};
#pragma unroll
            for (int ks = 0; ks < DK / 32; ++ks) {
                const bf16x8 Bq = *(LAS const bf16x8*)(lds + OFF_QA + (dt * 16 + m16) * QS + (ks * 32 + quad * 8) * 2);
#pragma unroll
                for (int T = 0; T < 2; ++T) {
                    const bf16x8 Ak = *(LAS const bf16x8*)(lds + OFF_KA + ((kh * 2 + T) * 16 + m16) * QS + (ks * 32 + quad * 8) * 2);
                    st[T] = __builtin_amdgcn_mfma_f32_16x16x32_bf16(Ak, Bq, st[T], 0, 0, 0);
                }
            }
            const int tloc = dt * 16 + m16;
            float Mt = 0.f;
            if (ML) Mt = fmaxf(mrun, mxL[tloc]);
            float rsum = 0.f;
#pragma unroll
            for (int T = 0; T < 2; ++T)
#pragma unroll
                for (int e = 0; e < 4; ++e) {
                    const int sloc = kh * 32 + quad * 8 + T * 4 + e;
                    const bool valid = dir ? (sloc >= tloc) : (sloc <= tloc);
                    float wgt = valid ? 1.f : 0.f;
                    if (ML) wgt = valid ? __expf(aL[sloc] - Mt) : 0.f;
                    const float pv = st[T][e] * wgt; st[T][e] = pv; rsum += pv;
                }
            *(LAS bf16x8*)(lds + OFF_PT + ((kh * 4 + dt) * 64 + lane) * 16) = pack8(st[0], st[1]);
            if (ML) {
                rsum += shx(rsum, 16); rsum += shx(rsum, 32);
                if (quad == 0) rsL[kh * 64 + tloc] = rsum;
                float qn = 0.f;
#pragma unroll
                for (int i = 0; i < 4; ++i) { float qf8[8]; unpack8(*(LAS const u32x4*)(lds + OFF_QA + lane * QS + (wid * 32 + i * 8) * 2), qf8);
#pragma unroll
                    for (int e = 0; e < 8; ++e) qn += qf8[e] * nL[wid * 32 + i * 8 + e]; }
                qnL[wid * 64 + lane] = qn;
            }
            __syncthreads();
            f32x4 numT[4];
#pragma unroll
            for (int tt = 0; tt < 4; ++tt) numT[tt] = (f32x4){0.f, 0.f, 0.f, 0.f};
#pragma unroll
            for (int g = 0; g < NG; ++g) {
                const bf16x8 Ac = pack8(Cst[g][0], Cst[g][1]);
#pragma unroll
                for (int tt = 0; tt < 4; ++tt) {
                    const bf16x8 Bq = *(LAS const bf16x8*)(lds + OFF_QA + (tt * 16 + m16) * QS + (kh * (DK / 2) + g * 32 + quad * 8) * 2);
                    numT[tt] = __builtin_amdgcn_mfma_f32_16x16x32_bf16(Ac, Bq, numT[tt], 0, 0, 0);
                }
            }
            if (ML) {
#pragma unroll
                for (int tt = 0; tt < 4; ++tt) { const float wi = __expf(mrun - fmaxf(mrun, mxL[tt * 16 + m16])); numT[tt] = numT[tt] * wi; }
            }
            {
                const bf16x8 Av = *(LAS const bf16x8*)(lds + OFF_VT + (dt * 16 + m16) * VS + (kh * 32 + quad * 8) * 2);
#pragma unroll
                for (int tt = 0; tt < 4; ++tt) {
                    const bf16x8 Bp = *(LAS const bf16x8*)(lds + OFF_PT + ((kh * 4 + tt) * 64 + lane) * 16);
                    numT[tt] = __builtin_amdgcn_mfma_f32_16x16x32_bf16(Av, Bp, numT[tt], 0, 0, 0);
                }
            }
            {
                f32x4 Ust[NG][2];
#pragma unroll
                for (int g = 0; g < NG; ++g) { Ust[g][0] = (f32x4){0.f, 0.f, 0.f, 0.f}; Ust[g][1] = (f32x4){0.f, 0.f, 0.f, 0.f}; }
#pragma unroll
                for (int k2 = 0; k2 < 2; ++k2) {
                    const bf16x8 Bv = *(LAS const bf16x8*)(lds + OFF_VT + (dt * 16 + m16) * VS + (k2 * 32 + quad * 8) * 2);
#pragma unroll
                    for (int g = 0; g < NG; ++g)
#pragma unroll
                        for (int T = 0; T < 2; ++T) {
                            const bf16x8 Ak = *(LAS const bf16x8*)(lds + OFF_KBT + (kh * (DK / 2) + g * 32 + T * 16 + m16) * VS + (k2 * 32 + quad * 8) * 2);
                            Ust[g][T] = __builtin_amdgcn_mfma_f32_16x16x32_bf16(Ak, Bv, Ust[g][T], 0, 0, 0);
                        }
                }
                if (ML) {
                    const float mm = fmaxf(mrun, ae), wold = __expf(mrun - mm), cs = __expf(ae - mm);
#pragma unroll
                    for (int g = 0; g < NG; ++g) { Cst[g][0] = Cst[g][0] * wold + Ust[g][0] * cs; Cst[g][1] = Cst[g][1] * wold + Ust[g][1] * cs; }
                } else {
#pragma unroll
                    for (int g = 0; g < NG; ++g)
#pragma unroll
                        for (int T = 0; T < 2; ++T) { const f32x4 d4 = *(LAS const f32x4*)(decL + kh * (DK / 2) + g * 32 + quad * 8 + T * 4); Cst[g][T] = Cst[g][T] * d4 + Ust[g][T]; }
                }
            }
            XL[(dt * 4 + (1 - kh) * 2 + 0) * 64 + lane] = numT[(1 - kh) * 2 + 0];
            XL[(dt * 4 + (1 - kh) * 2 + 1) * 64 + lane] = numT[(1 - kh) * 2 + 1];
            __syncthreads();
            const bool want_out = ML || ci >= 4;
            if (want_out) {
#pragma unroll
                for (int q2 = 0; q2 < 2; ++q2) {
                    const int tt = kh * 2 + q2, t = tt * 16 + m16;
                    f32x4 v = (kh ? numT[2 + q2] : numT[q2]) + XL[(dt * 4 + tt) * 64 + lane];
                    if (ML) {
                        const float Mtt = fmaxf(mrun, mxL[t]), wi = __expf(mrun - Mtt);
                        float qn = 0.f;
#pragma unroll
                        for (int pp = 0; pp < 8; ++pp) qn += qnL[pp * 64 + t];
                        const float den = wi * qn + rsL[t] + rsL[64 + t];
                        v = v * (1.f / fmaxf(fabsf(den), __expf(-(bL[t] + Mtt))));
                    }
                    u32x2 o; o.x = pk2(v[0], v[1]); o.y = pk2(v[2], v[3]);
                    *(u32x2*)(HS + ((size_t)dir * MTOT + row0 + t) * D + h * 256 + sl * 64 + dt * 16 + quad * 4) = o;
                }
            }
            if (ML) {
                const float mm = fmaxf(mrun, ae), wold = __expf(mrun - mm), cs = __expf(ae - mm);
                __syncthreads();
                if (tid < 256) {
                    const int rho = (tid & ~31) + ((tid >> 2) & 1) * 16 + ((tid >> 3) & 3) * 4 + (tid & 3);
                    float sm = 0.f;
#pragma unroll
                    for (int i = 0; i < 8; ++i) { float kf8[8]; unpack8(*(LAS const u32x4*)(lds + OFF_KBT + rho * VS + i * 16), kf8);
#pragma unroll
                        for (int e = 0; e < 8; ++e) sm += kf8[e]; }
                    nL[tid] = wold * nL[tid] + cs * sm;
                }
                mrun = be + mm;
            }
            __syncthreads();
        }
    }
}

__device__ __forceinline__ bool phase_exists(int ph) {
    if (ph == 0 || ph == 49) return true;
    const int l = (ph - 1) / 12, k = (ph - 1) % 12;
    if (k == 6 || k == 7) return (l & 1) != 0;
    return true;
}
template <class Epi>
__device__ __forceinline__ void run_gemm(LAS unsigned char* lds, const bf16_t* A, const bf16_t* Bt, int M, int N, int K, const Epi& E) {
    pg8::Gemm g; g.A = A; g.Bt = Bt; g.M = M; g.N = N; g.K = K;
    pg8::StaticOrder S; S.init(M, N, (int)GDIM(), (int)BID());
    pg8::gemm_phase<Epi, pg8::StaticOrder, true, true>(lds, g, S, E);
}
__device__ void run_phase(const Args& a, int ph, LAS unsigned char* lds) {
    unsigned char* ws = a.ws; asm volatile("" : "+s"(ws));
    float* H = (float*)(ws + WS_H); bf16_t* U = (bf16_t*)(ws + WS_U); bf16_t* P = (bf16_t*)(ws + WS_P); float* G32 = (float*)(ws + WS_G32);
    bf16_t* QC = (bf16_t*)(ws + WS_QC); bf16_t* KC = (bf16_t*)(ws + WS_KC); bf16_t* HS = (bf16_t*)(ws + WS_HS); bf16_t* KBT = (bf16_t*)(ws + WS_KBT); const bf16_t* VTb = (const bf16_t*)(ws + WS_VT); unsigned char* scb = ws + WS_SC;
    if (ph == 0) { p0_prologue(a, lds); return; }
    if (ph == 49) { final_norm_phase(H, a.in[I_FINALG], a.out); return; }
    const int l = (ph - 1) / 12, k = (ph - 1) % 12;
    const float* modl = (const float*)(ws + WS_MOD) + (size_t)l * 9 * MODLD;
    const float* ng = a.in[I_NORMG] + (size_t)l * 3 * D;
    switch (k) {
    case 0: norm_phase(H, ng, modl, 0, U, MTOT); break;
    case 1: case 10: { const int f = k == 10 ? 1 : 0; pg8::EpiSwiglu E; E.O = P; E.ldc = DFF; run_gemm(lds, U, (const bf16_t*)(ws + WS_W13T + (size_t)(l * 2 + f) * W13T_SZ), MTOT, 2 * DFF, D, E); } break;
    case 2: case 8: case 11: {
        pg8::EpiResid E; E.H = H; E.gate_ld = MODLD; E.gate = modl + (k == 2 ? 2 : k == 8 ? 5 : 8) * D; E.scale = k == 8 ? 1.0f : 0.5f;
        const bf16_t* A = k == 8 ? U : P; const int K = k == 8 ? D : DFF;
        const bf16_t* Bt = (const bf16_t*)(ws + (k == 8 ? WS_WO + (size_t)l * D * D * 2 : WS_W2T + (size_t)(l * 2 + (k == 11 ? 1 : 0)) * W2T_SZ));
        run_gemm(lds, A, Bt, MTOT, D, K, E);
    } break;
    case 3: norm_phase(H, ng + D, modl, 3, U, MTOT); break;
    case 4: {
        const size_t woff = l == 0 ? WS_WIN0 : l == 1 ? WS_WIN1 : l == 2 ? WS_WIN2 : WS_WIN3;
        if (l == 2 || l == 0) { pg8::EpiProjAttn E; E.P = P; E.VT = (bf16_t*)(ws + WS_VT); E.R = (const float*)(ws + WS_ROPE); E.rope = l == 2 ? 1 : 0; run_gemm(lds, U, (const bf16_t*)(ws + woff), MTOT, 3072, D, E); }
        else { pg8::EpiProj E; E.P = P; E.G32 = G32; E.ldc = NPAD_IN[l]; E.gcol0 = l == 1 ? 2048 : (l == 3 ? 1536 : 1 << 30); E.gn = l == 1 ? 16 : 32; E.VT = (bf16_t*)(ws + WS_VT); E.vcol0 = l == 1 ? 1024 : (l == 3 ? 512 : 1 << 30);
            run_gemm(lds, U, (const bf16_t*)(ws + woff), MTOT, NPAD_IN[l], D, E); }
    } break;
    case 5:
        if (l == 0) na_mfma_phase(P, VTb, a.in[I_NARPB], U);
        else if (l == 1) ml_prep2_phase(P, G32, a.in[I_MLGB], a.in[I_MLCONV], QC, KC, KBT, scb, lds);
        else if (l == 2) da_flash_phase(P, (const bf16_t*)(ws + WS_VT), a.in[I_DALAM], a.in[I_DANG], U, lds);
        else gla_prep2_phase(P, G32, a.in[I_GLAGU], a.in[I_GLABG], QC, KC, KBT, scb, lds);
        break;
    case 6:
        if (l == 1) chunk_scan_phase<256, true>(QC, KC, 0, KBT, VTb, scb, HS, lds);
        else if (l == 3) chunk_scan_phase<128, false>(QC, KC, (size_t)MTOT * 512, KBT, VTb, scb, HS, lds);
        break;
    case 7:
        if (l == 1) ml_readout_phase(P, HS, a.in[I_MLNG], U);
        else if (l == 3) gla_readout_phase(P, HS, a.in[I_GLANG], U);
        break;
    case 9: norm_phase(H, ng + 2 * D, modl, 6, U, MTOT); break;
    }
}

constexpr int LDS_BYTES = 135168;
__global__ void __launch_bounds__(512) mega(Args a) {
    extern __shared__ __attribute__((aligned(16))) unsigned char lds_raw[];
    LAS unsigned char* lds = (LAS unsigned char*)lds_raw;
    cg::grid_group grid = cg::this_grid();
    bool first = true;
    for (int ph = a.ph_lo; ph < a.ph_hi; ++ph) {
        if (!phase_exists(ph)) continue;
        if (!first) grid.sync();
        first = false;
        run_phase(a, ph, lds);
        __syncthreads();
    }
}

extern "C" void kernel_launch(void* const* d_in, const int* in_sizes, int n_in, void* d_out, int out_size,
                              void* d_ws, size_t ws_size, hipStream_t stream) {
    static int grid = 0;
    if (grid == 0) {
        int dev = 0, cus = 0, per_cu = 0;
        (void)hipGetDevice(&dev);
        (void)hipDeviceGetAttribute(&cus, hipDeviceAttributeMultiprocessorCount, dev);
        (void)hipFuncSetAttribute((const void*)mega, hipFuncAttributeMaxDynamicSharedMemorySize, LDS_BYTES);
        (void)hipOccupancyMaxActiveBlocksPerMultiprocessor(&per_cu, (const void*)mega, 512, LDS_BYTES);
        grid = cus > 0 ? cus : 256;
        if (n_in != N_IN || ws_size < WS_END) { fprintf(stderr, "kernel_launch: n_in %d ws %zu (need %zu)\n", n_in, ws_size, (size_t)WS_END); }
    }
    Args a{};
    for (int i = 0; i < N_IN; ++i) a.in[i] = (const float*)d_in[i];
    a.out = (float*)d_out; a.ws = (unsigned char*)d_ws; a.ph_lo = 0; a.ph_hi = 50;
    void* args[] = {&a};
    hipError_t e = hipLaunchCooperativeKernel((const void*)mega, dim3(grid), dim3(512), args, LDS_BYTES, stream);
    if (e != hipSuccess) fprintf(stderr, "cooperative launch failed: %s\n", hipGetErrorString(e));
}
```

```cpp
#include <hip/hip_runtime.h>
#include <hip/hip_cooperative_groups.h>
#include <cstdio>
#include <cstdint>
__device__ __forceinline__ int TID() { int t = threadIdx.x; asm volatile("" : "+v"(t)); return t; }
__device__ __forceinline__ int GDIM() { int t = gridDim.x; asm volatile("" : "+s"(t)); return t; }
__device__ __forceinline__ float shx(float v, int o) { const int lane = TID() & 63; return __builtin_bit_cast(float, __builtin_amdgcn_ds_bpermute((lane ^ o) << 2, __builtin_bit_cast(int, v))); }
__device__ __forceinline__ float rdl(float v, int src) { return __builtin_bit_cast(float, __builtin_amdgcn_readlane(__builtin_bit_cast(int, v), src)); }
__device__ __forceinline__ int BID() { int t = blockIdx.x; asm volatile("" : "+s"(t)); return t; }
namespace pg8 {
#define PG8_LAS __attribute__((address_space(3)))
typedef unsigned short bf16_t;
typedef short bf16x8 __attribute__((ext_vector_type(8)));
typedef float f32x4 __attribute__((ext_vector_type(4)));
typedef unsigned u32x4 __attribute__((ext_vector_type(4)));
constexpr int BM = 256, BK = 64, HALF = 128, HTB = HALF * BK * 2  , STAGE_BYTES = 8 * HTB, NXCD = 8, WGM = 8;

__host__ __device__ __forceinline__ int lds_byte(int r, int c) { const int st = (r >> 4) * 2 + (c >> 5), rr = r & 15, cc = c & 31, ob = rr * 64 + cc * 2; return st * 1024 + (ob ^ (((ob >> 9) & 1) << 5)); }
__host__ __device__ __forceinline__ void stage_rc(int b, int& R, int& C) { const int st = b / 1024, sb = b % 1024, swz = sb ^ (((sb >> 9) & 1) << 5); R = (st >> 1) * 16 + swz / 64; C = (st & 1) * 32 + (swz % 64) / 2; }
__host__ __device__ __forceinline__ int perm32(int rho) { const int n = rho >> 4, i = rho & 15; return 8 * (i >> 2) + 4 * n + (i & 3); }

struct Unit { int pm, pn, k0t, nt, sp; };
struct Gemm { const bf16_t* A; const bf16_t* Bt; int M, N, K, Kc; };

struct StaticOrder {
    int nM, nN, nwg, G, c, ntk;
    __host__ __device__ void init(int M, int N, int K, int G_, int c_) { nM = M / BM; nN = N / BM; nwg = nM * nN; G = G_; c = c_; ntk = K / BK; }
    __host__ __device__ bool next(int i, Unit& u) const {
        const long L = (long)i * G + c; if (L >= nwg) return false;
        u.k0t = 0; u.nt = ntk; u.sp = 0;
        int wgid = (int)L; { const int q = nwg / NXCD, r = nwg % NXCD, xcd = wgid % NXCD, off = wgid / NXCD; wgid = (xcd < r ? xcd * (q + 1) : r * (q + 1) + (xcd - r) * q) + off; }
        const int nig = WGM * nN, gid = wgid / nig, fm = gid * WGM, gsz = (nM - fm) < WGM ? (nM - fm) : WGM;
        u.pm = fm + ((wgid % nig) % gsz); u.pn = (wgid % nig) / gsz; return true;
    }
    __device__ __forceinline__ void a_ready(const Unit&) const {}
    __device__ __forceinline__ void done(const Unit&) const {}
};

struct ResidOrder {
    StaticOrder lat; int nctx, ntk, G, c;
    __host__ __device__ void init(int K, int with_ctx, int G_, int c_) { lat.init(16384, 1024, K, G_, c_); nctx = with_ctx ? 128 : 0; ntk = K / BK; G = G_; c = c_; }
    __host__ __device__ bool next(int i, Unit& u) const {
        Unit a; a.pm = 0; a.pn = 0; a.k0t = 0; a.nt = ntk; a.sp = 0;
        const bool is_lat = lat.next(i, a);
        const long L = (long)i * G + c - lat.nwg;
        const int j = (int)L, sp = j & 3, tile = j >> 2;
        const int q4 = (ntk / 4) & ~1, big = (ntk - 4 * q4) / 2;
        const int e0 = 2 * (int)(big > 0), e2 = 2 * (int)(big > 1);
        const int cnt = q4 + e0 * (int)(sp == 0) + e2 * (int)(sp == 2), ck0 = sp * q4 + e0 * (int)(sp >= 1) + e2 * (int)(sp >= 3);
        u.pm = is_lat ? a.pm : 64 + (tile >> 2); u.pn = is_lat ? a.pn : (tile & 3); u.sp = is_lat ? 0 : sp; u.nt = is_lat ? ntk : cnt; u.k0t = is_lat ? 0 : ck0;
        return is_lat || L < nctx;
    }
    __device__ __forceinline__ void a_ready(const Unit&) const {}
    __device__ __forceinline__ void done(const Unit&) const {}
};

__device__ __forceinline__ unsigned cvt_pk_bf16(float lo, float hi) { unsigned r; asm volatile("v_cvt_pk_bf16_f32 %0, %1, %2" : "=v"(r) : "v"(lo), "v"(hi)); return r; }
typedef unsigned u32x2 __attribute__((ext_vector_type(2)));
__device__ __forceinline__ float silu_f(float x) { return x / (1.f + __expf(-x)); }
struct EpiSwiglu {
    static constexpr bool PERM = true, AFTER_DRAIN = false;
    bf16_t* O; int ldc;
    __device__ __forceinline__ void operator()(const f32x4 (&acc)[2][2][4][2], const Unit& u, int wr, int wc, int fr, int fq) const {
        const int row0 = u.pm * BM + wr * 64 + fr, col0 = u.pn * HALF + wc * 32 + 8 * fq;
#pragma unroll
        for (int ai = 0; ai < 2; ++ai)
#pragma unroll
            for (int m = 0; m < 4; ++m) {
                bf16_t* rowp = O + (size_t)(row0 + ai * HALF + m * 16) * ldc + col0;
                const f32x4 g0 = acc[ai][0][m][0], g1 = acc[ai][0][m][1], u0 = acc[ai][1][m][0], u1 = acc[ai][1][m][1];
                u32x4 w;
                w.x = cvt_pk_bf16(silu_f(g0[0]) * u0[0], silu_f(g0[1]) * u0[1]);
                w.y = cvt_pk_bf16(silu_f(g0[2]) * u0[2], silu_f(g0[3]) * u0[3]);
                w.z = cvt_pk_bf16(silu_f(g1[0]) * u1[0], silu_f(g1[1]) * u1[1]);
                w.w = cvt_pk_bf16(silu_f(g1[2]) * u1[2], silu_f(g1[3]) * u1[3]);
                *(u32x4*)rowp = w;
            }
    }
};
constexpr long DPOFF = 116195328;
struct EpiResid {
    static constexpr bool PERM = false, AFTER_DRAIN = false;
    float* H; const float* gate;
    __device__ __forceinline__ void operator()(const f32x4 (&acc)[2][2][4][2], const Unit& u, int wr, int wc, int fr, int fq) const {
        const int mrow = u.pm < 64 ? (u.pm >> 3) : 8;
        const float* gp = gate + (size_t)mrow * 9216; float* DP = H + DPOFF;
        const int row0 = u.pm * BM + wr * 64 + fr, col0 = u.pn * BM + wc * 32 + 4 * fq;
#pragma unroll
        for (int bj = 0; bj < 2; ++bj)
#pragma unroll
            for (int n = 0; n < 2; ++n) {
                const int col = col0 + bj * HALF + n * 16;
                const f32x4 g = *(const f32x4*)(gp + col);
#pragma unroll
                for (int ai = 0; ai < 2; ++ai)
#pragma unroll
                    for (int m = 0; m < 4; ++m) {
                        float* hp = H + (size_t)(row0 + ai * HALF + m * 16) * 1024 + col;
                        const f32x4 d = g * acc[ai][bj][m][n];
                        if (u.sp) *(f32x4*)(DP + ((size_t)(u.sp - 1) * 2048 + (row0 + ai * HALF + m * 16 - 16384)) * 1024 + col) = d;
                        else { f32x4 h = *(const f32x4*)hp; h = h + d; *(f32x4*)hp = h; }
                    }
            }
    }
};
struct EpiProj {
    static constexpr bool PERM = true, AFTER_DRAIN = false;
    bf16_t* P; int ldc; float* G32; int gcol0, gn; bf16_t* VT; int vcol0;
    __device__ __forceinline__ void operator()(const f32x4 (&acc)[2][2][4][2], const Unit& u, int wr, int wc, int fr, int fq) const {
        const int row0 = u.pm * BM + wr * 64 + fr, col0 = u.pn * BM + wc * 32 + 8 * fq;
#pragma unroll
        for (int bj = 0; bj < 2; ++bj) {
            const int col = col0 + bj * HALF;
            const bool gs = (col >= gcol0) && (col < gcol0 + gn);
            const bool vs = (col >= vcol0) && (col < vcol0 + 1024);
#pragma unroll
            for (int ai = 0; ai < 2; ++ai)
#pragma unroll
                for (int m = 0; m < 4; ++m) {
                    const size_t row = (size_t)(row0 + ai * HALF + m * 16);
                    const f32x4 v0 = acc[ai][bj][m][0], v1 = acc[ai][bj][m][1];
                    u32x4 w; w.x = cvt_pk_bf16(v0[0], v0[1]); w.y = cvt_pk_bf16(v0[2], v0[3]); w.z = cvt_pk_bf16(v1[0], v1[1]); w.w = cvt_pk_bf16(v1[2], v1[3]);
                    *(u32x4*)(P + row * ldc + col) = w;
                    if (gs) { float* gp = G32 + row * 32 + (col - gcol0); *(f32x4*)gp = v0; *(f32x4*)(gp + 4) = v1; }
                    if (vs) { bf16_t* vp = VT + (size_t)(col - vcol0) * 18432 + row;
                        vp[0] = (bf16_t)(w.x & 0xffffu); vp[18432] = (bf16_t)(w.x >> 16); vp[2 * 18432] = (bf16_t)(w.y & 0xffffu); vp[3 * 18432] = (bf16_t)(w.y >> 16);
                        vp[4 * 18432] = (bf16_t)(w.z & 0xffffu); vp[5 * 18432] = (bf16_t)(w.z >> 16); vp[6 * 18432] = (bf16_t)(w.w & 0xffffu); vp[7 * 18432] = (bf16_t)(w.w >> 16); }
                }
        }
    }
};

struct EpiProjAttn {
    static constexpr bool PERM = false, AFTER_DRAIN = false;
    bf16_t* P; bf16_t* VT; const float* R; int rope;
    __device__ __forceinline__ void operator()(const f32x4 (&acc)[2][2][4][2], const Unit& u, int wr, int wc, int fr, int fq) const {
        const int sec = u.pn >> 2;
        const int row0 = u.pm * BM + wr * 64 + fr, col0 = u.pn * BM + wc * 32 + 4 * fq;
        if (sec == 1) {
#pragma unroll
            for (int ai = 0; ai < 2; ++ai)
#pragma unroll
                for (int m = 0; m < 4; ++m) {
                    const int row = row0 + ai * HALF + m * 16;
#pragma unroll
                    for (int bj = 0; bj < 2; ++bj)
#pragma unroll
                        for (int n = 0; n < 2; ++n) {
                            const int col = col0 + bj * HALF + n * 16 - 1024;
                            const f32x4 v = acc[ai][bj][m][n];
#pragma unroll
                            for (int e = 0; e < 4; ++e) VT[(size_t)(col + e) * 18432 + row] = (bf16_t)(cvt_pk_bf16(v[e], 0.f) & 0xffffu);
                        }
                }
            return;
        }
        const float sc = sec == 2 ? 0.125f : 1.f;
        const bool do_rope = rope && u.pm < 64;
        const int axis = wc & 1;
#pragma unroll
        for (int ai = 0; ai < 2; ++ai)
#pragma unroll
            for (int m = 0; m < 4; ++m) {
                const int row = row0 + ai * HALF + m * 16;
                f32x4 cs = (f32x4){1.f, 1.f, 1.f, 1.f}, sn = (f32x4){0.f, 0.f, 0.f, 0.f};
                if (do_rope) { const int t = row & 2047, pos = axis ? (t & 63) : (t >> 6); cs = *(const f32x4*)(R + pos * 16 + 4 * fq); sn = *(const f32x4*)(R + 1024 + pos * 16 + 4 * fq); }
#pragma unroll
                for (int bj = 0; bj < 2; ++bj) {
                    const f32x4 x1 = acc[ai][bj][m][0] * sc, x2 = acc[ai][bj][m][1] * sc;
                    const f32x4 y1 = x1 * cs - x2 * sn, y2 = x2 * cs + x1 * sn;
                    bf16_t* pp = P + (size_t)row * 3072 + col0 + bj * HALF;
                    u32x2 o1, o2; o1.x = cvt_pk_bf16(y1[0], y1[1]); o1.y = cvt_pk_bf16(y1[2], y1[3]); o2.x = cvt_pk_bf16(y2[0], y2[1]); o2.y = cvt_pk_bf16(y2[2], y2[3]);
                    *(u32x2*)pp = o1; *(u32x2*)(pp + 16) = o2;
                }
            }
    }
};

template <class Epi, class Sched, bool ALIGN_EPI = false, bool SP2 = false>
__device__ __forceinline__ void gemm_phase(PG8_LAS unsigned char* lds, const Gemm g, const Sched& S, const Epi& E) {
    const int tid = TID(), wid = __builtin_amdgcn_readfirstlane(tid >> 6), lane = tid & 63, wr = wid >> 2, wc = wid & 3, fr = lane & 15, fq = lane >> 4;
    const int K = g.K;
    unsigned voffA[2], voffB[2];
#pragma unroll
    for (int i = 0; i < 2; ++i) { int R, C; stage_rc(tid * 16 + i * 8192, R, C); const int Rb = Epi::PERM ? ((R & ~31) + perm32(R & 31)) : R;
        voffA[i] = (unsigned)(R * K + C) * 2u; voffB[i] = (unsigned)(Rb * K + C) * 2u; }
    const size_t kstep = (size_t)(BK * 2);
    const size_t hstep = (size_t)HALF * K * 2;
    const size_t tstep = 2 * hstep;
    const unsigned ldsw = (unsigned)wid * 1024u;
    const int aoff = lds_byte(wr * 64 + fr, fq * 8), boff = lds_byte(wc * 32 + fr, fq * 8);
#define PG8_SA(b, h) (((b) * 2 + (h)) * HTB)
#define PG8_SB(b, h) ((4 + (b) * 2 + (h)) * HTB)
#define PG8_STAGE(bufoff, gbase, voff) do { _Pragma("unroll") for (int _i = 0; _i < 2; ++_i) \
        __builtin_amdgcn_global_load_lds((const unsigned*)((const char*)(gbase) + (voff)[_i]), (PG8_LAS unsigned*)(lds + (bufoff) + ldsw + _i * 8192), 16, 0, 0); } while (0)
#define PG8_LDA(dst, b, h) do { _Pragma("unroll") for (int m = 0; m < 4; ++m) _Pragma("unroll") for (int k = 0; k < 2; ++k) dst[m][k] = *(const PG8_LAS bf16x8*)(lds + PG8_SA(b, h) + aoff + m * 2048 + k * 1024); } while (0)
#define PG8_LDB(dst, b, h) do { _Pragma("unroll") for (int n = 0; n < 2; ++n) _Pragma("unroll") for (int k = 0; k < 2; ++k) dst[n][k] = *(const PG8_LAS bf16x8*)(lds + PG8_SB(b, h) + boff + n * 2048 + k * 1024); } while (0)
#define PG8_MMA(ai, bj, At, Bt) do { __builtin_amdgcn_s_setprio(1); _Pragma("unroll") for (int m = 0; m < 4; ++m) _Pragma("unroll") for (int n = 0; n < 2; ++n) _Pragma("unroll") for (int k = 0; k < 2; ++k) \
        acc[ai][bj][m][n] = __builtin_amdgcn_mfma_f32_16x16x32_bf16(Bt[n][k], At[m][k], acc[ai][bj][m][n], 0, 0, 0); __builtin_amdgcn_s_setprio(0); } while (0)
#define PG8_WAIT_V(n) asm volatile("s_waitcnt vmcnt(" #n ")" ::: "memory")
#define PG8_WAIT_L(n) asm volatile("s_waitcnt lgkmcnt(" #n ")" ::: "memory")
#define PG8_BAR __builtin_amdgcn_s_barrier()
#define PG8_SCHED __builtin_amdgcn_sched_barrier(0)
    Unit cur, nxt; int ui = 0;
    if (!S.next(0, cur)) return;
    f32x4 acc[2][2][4][2];
#pragma unroll
    for (int a = 0; a < 2; ++a)
#pragma unroll
        for (int b = 0; b < 2; ++b)
#pragma unroll
            for (int m = 0; m < 4; ++m)
#pragma unroll
                for (int n = 0; n < 2; ++n) acc[a][b][m][n] = (f32x4){0.f, 0.f, 0.f, 0.f};
    bf16x8 At[4][2], B0[2][2], B1[2][2];
    const char* cA = (const char*)g.A + (size_t)cur.pm * tstep + (size_t)cur.k0t * kstep; const char* cB = (const char*)g.Bt + (size_t)cur.pn * tstep + (size_t)cur.k0t * kstep;
    S.a_ready(cur);
    if constexpr (SP2) {
        PG8_STAGE(PG8_SB(0, 0), cB, voffB); PG8_STAGE(PG8_SB(0, 1), cB + hstep, voffB); PG8_STAGE(PG8_SA(0, 0), cA, voffA); PG8_STAGE(PG8_SA(0, 1), cA + hstep, voffA);
        if (wr == 1) PG8_BAR;
        PG8_WAIT_V(2); PG8_BAR;
        PG8_STAGE(PG8_SB(1, 0), cB + kstep, voffB); PG8_STAGE(PG8_SA(1, 0), cA + kstep, voffA); PG8_STAGE(PG8_SB(1, 1), cB + hstep + kstep, voffB);
        PG8_WAIT_V(6); PG8_BAR;
    } else {
        PG8_STAGE(PG8_SB(0, 0), cB, voffB); PG8_STAGE(PG8_SA(0, 0), cA, voffA); PG8_STAGE(PG8_SB(0, 1), cB + hstep, voffB); PG8_STAGE(PG8_SA(0, 1), cA + hstep, voffA);
        if (wr == 1) PG8_BAR;
        PG8_WAIT_V(4); PG8_BAR;
        PG8_STAGE(PG8_SB(1, 0), cB + kstep, voffB); PG8_STAGE(PG8_SA(1, 0), cA + kstep, voffA); PG8_STAGE(PG8_SB(1, 1), cB + hstep + kstep, voffB);
        PG8_WAIT_V(6); PG8_BAR;
    }
    for (;;) {
        const bool has_next = S.next(ui + 1, nxt);
        const char* nA = has_next ? (const char*)g.A + (size_t)nxt.pm * tstep + (size_t)nxt.k0t * kstep : cA; const char* nB = has_next ? (const char*)g.Bt + (size_t)nxt.pn * tstep + (size_t)nxt.k0t * kstep : cB;
        const int nt = cur.nt;
        for (int t = 0; t < nt; t += 2) {
            const bool last = (t == nt - 2);
            const char* a1 = cA + (size_t)(t + 1) * kstep;
            const char* a2 = last ? nA : cA + (size_t)(t + 2) * kstep; const char* b2 = last ? nB : cB + (size_t)(t + 2) * kstep;
            const char* a3 = a2 + kstep; const char* b3 = b2 + kstep;
            if (last && has_next) S.a_ready(nxt);
            if constexpr (SP2) {
            PG8_LDB(B0, 0, 0); PG8_LDB(B1, 0, 1); PG8_SCHED; PG8_LDA(At, 0, 0); PG8_STAGE(PG8_SA(1, 1), a1 + hstep, voffA);
            PG8_WAIT_V(8); PG8_WAIT_L(0); PG8_BAR; PG8_MMA(0, 0, At, B0); PG8_MMA(0, 1, At, B1); PG8_BAR; PG8_SCHED;
            PG8_LDA(At, 0, 1); PG8_STAGE(PG8_SB(0, 0), b2, voffB); PG8_STAGE(PG8_SB(0, 1), b2 + hstep, voffB); PG8_STAGE(PG8_SA(0, 0), a2, voffA);
            PG8_WAIT_V(8); PG8_WAIT_L(0); PG8_BAR; PG8_MMA(1, 0, At, B0); PG8_MMA(1, 1, At, B1); PG8_BAR; PG8_SCHED;
            PG8_LDB(B0, 1, 0); PG8_LDB(B1, 1, 1); PG8_SCHED; PG8_LDA(At, 1, 0); PG8_STAGE(PG8_SA(0, 1), a2 + hstep, voffA);
            PG8_WAIT_V(8); PG8_WAIT_L(0); PG8_BAR; PG8_MMA(0, 0, At, B0); PG8_MMA(0, 1, At, B1); PG8_BAR; PG8_SCHED;
            PG8_LDA(At, 1, 1); PG8_STAGE(PG8_SB(1, 0), b3, voffB); PG8_STAGE(PG8_SB(1, 1), b3 + hstep, voffB); PG8_STAGE(PG8_SA(1, 0), a3, voffA);
            PG8_WAIT_V(8); PG8_WAIT_L(0); PG8_BAR; PG8_MMA(1, 0, At, B0); PG8_MMA(1, 1, At, B1); PG8_BAR; PG8_SCHED;
            } else {
            PG8_LDB(B0, 0, 0); PG8_SCHED; PG8_LDA(At, 0, 0); PG8_STAGE(PG8_SA(1, 1), a1 + hstep, voffA);
            PG8_WAIT_L(8); PG8_BAR; PG8_WAIT_L(0); PG8_MMA(0, 0, At, B0); PG8_BAR; PG8_SCHED;
            PG8_LDB(B1, 0, 1); PG8_STAGE(PG8_SB(0, 0), b2, voffB);
            PG8_BAR; PG8_WAIT_L(0); PG8_MMA(0, 1, At, B1); PG8_BAR;
            PG8_LDA(At, 0, 1); PG8_STAGE(PG8_SA(0, 0), a2, voffA);
            PG8_BAR; PG8_WAIT_L(0); PG8_MMA(1, 0, At, B0); PG8_BAR; PG8_SCHED;
            PG8_STAGE(PG8_SB(0, 1), b2 + hstep, voffB);
            PG8_WAIT_V(6); PG8_BAR; PG8_MMA(1, 1, At, B1); PG8_BAR;
            PG8_LDB(B0, 1, 0); PG8_SCHED; PG8_LDA(At, 1, 0); PG8_STAGE(PG8_SA(0, 1), a2 + hstep, voffA);
            PG8_WAIT_L(8); PG8_BAR; PG8_WAIT_L(0); PG8_MMA(0, 0, At, B0); PG8_BAR; PG8_SCHED;
            PG8_LDB(B1, 1, 1); PG8_STAGE(PG8_SB(1, 0), b3, voffB);
            PG8_BAR; PG8_WAIT_L(0); PG8_MMA(0, 1, At, B1); PG8_BAR;
            PG8_LDA(At, 1, 1); PG8_STAGE(PG8_SA(1, 0), a3, voffA);
            PG8_BAR; PG8_WAIT_L(0); PG8_MMA(1, 0, At, B0); PG8_BAR; PG8_SCHED;
            PG8_STAGE(PG8_SB(1, 1), b3 + hstep, voffB);
            PG8_WAIT_V(6); PG8_BAR; PG8_MMA(1, 1, At, B1); PG8_BAR;
            }
        }
        if constexpr (ALIGN_EPI) { if (wr == 0) PG8_BAR; }
        if constexpr (!Epi::AFTER_DRAIN) { E(acc, cur, wr, wc, fr, fq); S.done(cur); }
        if (!has_next) break;
#pragma unroll
        for (int a = 0; a < 2; ++a)
#pragma unroll
            for (int b = 0; b < 2; ++b)
#pragma unroll
                for (int m = 0; m < 4; ++m)
#pragma unroll
                    for (int n = 0; n < 2; ++n) acc[a][b][m][n] = (f32x4){0.f, 0.f, 0.f, 0.f};
        cur = nxt; cA = nA; cB = nB; ++ui;
        if constexpr (ALIGN_EPI) { if (wr == 1) PG8_BAR; }
    }
    PG8_WAIT_V(0);
    if constexpr (!ALIGN_EPI) { if (wr == 0) PG8_BAR; }
    PG8_BAR;
    if constexpr (Epi::AFTER_DRAIN) { E.fused(acc, cur, wr, wc, fr, fq, lds, wid, lane); S.done(cur); }
#undef PG8_SA
#undef PG8_SB
#undef PG8_STAGE
#undef PG8_LDA
#undef PG8_LDB
#undef PG8_MMA
#undef PG8_WAIT_V
#undef PG8_WAIT_L
#undef PG8_BAR
#undef PG8_SCHED
}
}
namespace cg = cooperative_groups;
typedef unsigned short bf16_t;
typedef float f32x4 __attribute__((ext_vector_type(4)));
typedef unsigned u32x4 __attribute__((ext_vector_type(4)));
typedef unsigned u32x2 __attribute__((ext_vector_type(2)));
#define LAS __attribute__((address_space(3)))

constexpr int D = 1024, NB = 8, SEQ = 2048, CTXL = 256, DFF = 2816;
constexpr int MLAT = NB * SEQ, MCTX = NB * CTXL, MTOT = MLAT + MCTX;
constexpr int MODLD = 9 * D;
enum { I_X = 0, I_C, I_CTX, I_CCTX, I_ADAW, I_ADAB, I_NORMG, I_W13, I_W2, I_FINALG, I_NAW, I_NARPB, I_NAWO, I_MLW, I_MLGB, I_MLCONV, I_MLNG, I_MLWO,
       I_DAW, I_DALAM, I_DANG, I_DAWO, I_GLAW, I_GLAGU, I_GLABG, I_GLANG, I_GLAWO, N_IN };
constexpr int NPAD_IN[4] = {3072, 4352, 3072, 3328};
constexpr int N_IN_REAL[4] = {3072, 4112, 3072, 3104};
constexpr size_t al256(size_t x) { return (x + 255) & ~(size_t)255; }
constexpr size_t WS_MOD = 0;
constexpr size_t WS_ROPE = al256(WS_MOD + (size_t)4 * 9 * MODLD * 4);
constexpr size_t WS_W13T = al256(WS_ROPE + 2 * 64 * 16 * 4);
constexpr size_t W13T_SZ = (size_t)2 * DFF * D * 2;
constexpr size_t WS_W2T = WS_W13T + 8 * W13T_SZ;
constexpr size_t W2T_SZ = (size_t)D * DFF * 2;
constexpr size_t WS_WIN0 = WS_W2T + 8 * W2T_SZ;
constexpr size_t WS_WIN1 = WS_WIN0 + (size_t)3072 * D * 2;
constexpr size_t WS_WIN2 = WS_WIN1 + (size_t)4352 * D * 2;
constexpr size_t WS_WIN3 = WS_WIN2 + (size_t)3072 * D * 2;
constexpr size_t WS_WO = WS_WIN3 + (size_t)3328 * D * 2;
constexpr size_t WS_H = WS_WO + (size_t)4 * D * D * 2;
constexpr size_t WS_U = WS_H + (size_t)MTOT * D * 4;
constexpr size_t WS_P = WS_U + (size_t)MTOT * D * 2;
constexpr size_t WS_G32 = WS_P + (size_t)MTOT * 4352 * 2;
constexpr size_t WS_QC = WS_G32 + (size_t)MTOT * 32 * 4;
constexpr size_t WS_KC = WS_QC + (size_t)MTOT * D * 2;
constexpr size_t WS_HS = WS_KC + (size_t)MTOT * D * 2;
constexpr size_t WS_VT = WS_HS + (size_t)2 * MTOT * D * 2;
constexpr size_t WS_KBT = WS_VT + (size_t)D * MTOT * 2;
constexpr size_t WS_SC = WS_KBT + (size_t)2 * D * MTOT * 2;
constexpr size_t SC_SA = 0, SC_SMX = (size_t)8 * MTOT * 4, SC_SB = (size_t)16 * MTOT * 4, SC_CE = (size_t)24 * MTOT * 4, SC_DEC = SC_CE + 65536;
constexpr size_t WS_DP = WS_KBT;
constexpr size_t WS_END = WS_SC + SC_DEC + (size_t)2 * 288 * 512 * 4;
constexpr size_t WS_BAR = WS_END;
static_assert(WS_BAR + 16384 <= (size_t)738197504, "workspace");

struct Args { const float* in[N_IN]; float* out; unsigned char* ws; int ph_lo, ph_hi; };

__device__ __forceinline__ unsigned f2bf(float f) { unsigned u = __builtin_bit_cast(unsigned, f); return (u + 0x7fffu + ((u >> 16) & 1u)) >> 16; }
__device__ __forceinline__ unsigned pk2(float lo, float hi) { return f2bf(lo) | (f2bf(hi) << 16); }
__device__ __forceinline__ float bf2f(unsigned short b) { return __builtin_bit_cast(float, (unsigned)b << 16); }
__device__ __forceinline__ float bflo(unsigned w) { return __builtin_bit_cast(float, w << 16); }
__device__ __forceinline__ float bfhi(unsigned w) { return __builtin_bit_cast(float, w & 0xffff0000u); }
__device__ __forceinline__ float wave_sum(float v) {
#pragma unroll
    for (int o = 1; o < 64; o <<= 1) v += shx(v, o);
    return v;
}
__device__ __forceinline__ float wave_max(float v) {
#pragma unroll
    for (int o = 1; o < 64; o <<= 1) v = fmaxf(v, shx(v, o));
    return v;
}
__device__ __forceinline__ float silu(float x) { return x / (1.f + __expf(-x)); }
__device__ __forceinline__ float sigmoidf_(float x) { return 1.f / (1.f + __expf(-x)); }
__device__ __forceinline__ float log_sigmoid(float x) { return fminf(x, 0.f) - log1pf(__expf(-fabsf(x))); }

struct WDesc { const float* src; bf16_t* dst; int K, N, Npad, perm, tiles; };
__device__ __forceinline__ WDesc get_wdesc(const Args& a, unsigned char* ws, int mi) {
    WDesc w;
    if (mi < 8) { w.src = a.in[I_W13] + (size_t)mi * D * 2 * DFF; w.dst = (bf16_t*)(ws + WS_W13T + mi * W13T_SZ); w.K = D; w.N = 2 * DFF; w.Npad = 2 * DFF; w.perm = 1; }
    else if (mi < 16) { const int j = mi - 8; w.src = a.in[I_W2] + (size_t)j * DFF * D; w.dst = (bf16_t*)(ws + WS_W2T + j * W2T_SZ); w.K = DFF; w.N = D; w.Npad = D; w.perm = 0; }
    else if (mi < 20) { const int j = mi - 16;
        w.src = a.in[j == 0 ? I_NAW : j == 1 ? I_MLW : j == 2 ? I_DAW : I_GLAW];
        w.dst = (bf16_t*)(ws + (j == 0 ? WS_WIN0 : j == 1 ? WS_WIN1 : j == 2 ? WS_WIN2 : WS_WIN3));
        w.K = D; w.N = j == 0 ? 3072 : j == 1 ? 4112 : j == 2 ? 3072 : 3104; w.Npad = j == 0 ? 3072 : j == 1 ? 4352 : j == 2 ? 3072 : 3328; w.perm = 0; }
    else { const int j = mi - 20; w.src = a.in[j == 0 ? I_NAWO : j == 1 ? I_MLWO : j == 2 ? I_DAWO : I_GLAWO]; w.dst = (bf16_t*)(ws + WS_WO + (size_t)j * D * D * 2); w.K = D; w.N = D; w.Npad = D; w.perm = 0; }
    w.tiles = (w.K / 64) * (w.Npad / 64);
    return w;
}
constexpr int TILES_W13 = 16 * 88, TILES_W2 = 44 * 16, TILES_WO = 256;
constexpr int TILES_TOTAL = 8 * TILES_W13 + 8 * TILES_W2 + 16 * (48 + 68 + 48 + 52) + 4 * TILES_WO;

__device__ void p0_prologue(const Args& a, LAS unsigned char* lds) {
    const int tid = TID(), lane = tid & 63, wid = tid >> 6;
    unsigned char* ws = a.ws; asm volatile("" : "+s"(ws));
    {
        LAS float* S = (LAS float*)lds;
        LAS float* red = (LAS float*)(lds + 9 * 1024 * 4);
        for (int i = tid; i < 9 * 1024; i += 512) { const float v = i < 8 * 1024 ? a.in[I_C][i] : a.in[I_CCTX][i - 8 * 1024]; S[i] = silu(v); }
        __syncthreads();
        float* MOD = (float*)(ws + WS_MOD);
        for (int item = BID(); item < 4 * 144; item += GDIM()) {
            const int l = item / 144, cgp = item % 144;
            const int cq = tid & 15, kg = tid >> 4;
            const float* W = a.in[I_ADAW] + (size_t)l * D * MODLD + cgp * 64 + cq * 4;
            f32x4 acc[9];
#pragma unroll
            for (int r = 0; r < 9; ++r) acc[r] = (f32x4){0.f, 0.f, 0.f, 0.f};
#pragma unroll 4
            for (int kk = 0; kk < 32; ++kk) {
                const int k = kg * 32 + kk;
                const f32x4 w4 = *(const f32x4*)(W + (size_t)k * MODLD);
#pragma unroll
                for (int r = 0; r < 9; ++r) acc[r] = acc[r] + w4 * S[r * 1024 + k];
            }
#pragma unroll
            for (int r = 0; r < 9; ++r)
#pragma unroll
                for (int e = 0; e < 4; ++e) { float v = acc[r][e]; v += shx(v, 16); v += shx(v, 32); acc[r][e] = v; }
            if (lane < 16) {
#pragma unroll
                for (int r = 0; r < 9; ++r)
#pragma unroll
                    for (int e = 0; e < 4; ++e) red[(wid * 9 + r) * 64 + cq * 4 + e] = acc[r][e];
            }
            __syncthreads();
            for (int o = tid; o < 9 * 64; o += 512) {
                const int r = o >> 6, cc = o & 63; float v = 0.f;
#pragma unroll
                for (int w = 0; w < 8; ++w) v += red[(w * 9 + r) * 64 + cc];
                const int col = cgp * 64 + cc;
                const int slot = col >> 10;
                MOD[((size_t)l * 9 + r) * MODLD + col] = (v + a.in[I_ADAB][(size_t)l * MODLD + col]) * ((slot == 2 || slot == 8) ? 0.5f : 1.f);
            }
            __syncthreads();
        }
    }
    {
        LAS float* tile = (LAS float*)lds;
        for (int item = BID(); item < TILES_TOTAL; item += GDIM()) {
            int mi, t = item;
            if (t < 8 * TILES_W13) { mi = t / TILES_W13; t -= mi * TILES_W13; }
            else if (t < 8 * TILES_W13 + 8 * TILES_W2) { t -= 8 * TILES_W13; mi = t / TILES_W2; t -= mi * TILES_W2; mi += 8; }
            else { t -= 8 * TILES_W13 + 8 * TILES_W2;
                if (t < 16 * 48) { mi = 16; } else if (t < 16 * (48 + 68)) { mi = 17; t -= 16 * 48; } else if (t < 16 * (48 + 68 + 48)) { mi = 18; t -= 16 * (48 + 68); }
                else if (t < 16 * (48 + 68 + 48 + 52)) { mi = 19; t -= 16 * (48 + 68 + 48); } else { t -= 16 * (48 + 68 + 48 + 52); mi = 20 + t / TILES_WO; t = t % TILES_WO; } }
            const WDesc w = get_wdesc(a, ws, mi);
            const int ntn = w.Npad / 64, kt = t / ntn, nt = t % ntn, k0 = kt * 64, n0 = nt * 64;
            {
                const int nn = tid & 63, n = n0 + nn;
#pragma unroll
                for (int i = 0; i < 8; ++i) { const int kk = (tid >> 6) + 8 * i; tile[kk * 65 + nn] = n < w.N ? w.src[(size_t)(k0 + kk) * w.N + n] : 0.f; }
            }
            __syncthreads();
            {
                const int kp = tid & 31;
#pragma unroll
                for (int i = 0; i < 4; ++i) {
                    const int nn = (tid >> 5) + 16 * i, n = n0 + nn;
                    int drow = n;
                    if (w.perm) { const int half = n >= DFF ? 1 : 0, jj = n - half * DFF; drow = (jj >> 7) * 256 + half * 128 + (jj & 127); }
                    *(unsigned*)(w.dst + (size_t)drow * w.K + k0 + 2 * kp) = pk2(tile[(2 * kp) * 65 + nn], tile[(2 * kp + 1) * 65 + nn]);
                }
            }
            __syncthreads();
        }
    }
    {
        f32x4* H4 = (f32x4*)(ws + WS_H);
        const f32x4* x4 = (const f32x4*)a.in[I_X]; const f32x4* c4 = (const f32x4*)a.in[I_CTX];
        const int n1 = MLAT * D / 4, n2 = MTOT * D / 4;
        for (int i = BID() * 512 + tid; i < n2; i += GDIM() * 512) H4[i] = i < n1 ? x4[i] : c4[i - n1];
    }
    if (BID() == 0) {
        float* R = (float*)(ws + WS_ROPE);
        for (int i = tid; i < 64 * 16; i += 512) { const int pos = i >> 4, fi = i & 15; const float f = powf(10000.f, -(float)fi / 16.f); const float ang = (float)pos * f; R[i] = cosf(ang); R[1024 + i] = sinf(ang); }
    }
}

__device__ void norm_phase(float* H, const float* g, const float* modl  , int slot_shift, bf16_t* U, int nrows, const float* DP) {
    const int lane = TID() & 63, gw = BID() * 8 + (TID() >> 6), ngw = GDIM() * 8;
    f32x4 gv[4];
#pragma unroll
    for (int j = 0; j < 4; ++j) gv[j] = *(const f32x4*)(g + j * 256 + lane * 4);
    for (int row = gw; row < nrows; row += ngw) {
        const int mrow = row < MLAT ? (row >> 11) : 8;
        const float* sh = modl + (size_t)mrow * MODLD + slot_shift * D; const float* sc = sh + D;
        f32x4 v[4]; float s = 0.f;
#pragma unroll
        for (int j = 0; j < 4; ++j) { v[j] = *(const f32x4*)(H + (size_t)row * D + j * 256 + lane * 4);
            if (DP != nullptr && row >= MLAT) {
                const float* dp = DP + (size_t)(row - MLAT) * D + j * 256 + lane * 4;
                v[j] = v[j] + *(const f32x4*)dp + *(const f32x4*)(dp + (size_t)MCTX * D) + *(const f32x4*)(dp + (size_t)2 * MCTX * D);
                *(f32x4*)(H + (size_t)row * D + j * 256 + lane * 4) = v[j]; }
            s += (v[j][0] * v[j][0] + v[j][1] * v[j][1]) + (v[j][2] * v[j][2] + v[j][3] * v[j][3]); }
        const float rstd = rsqrtf(wave_sum(s) * (1.f / D) + 1e-6f);
#pragma unroll
        for (int j = 0; j < 4; ++j) {
            const f32x4 s4 = *(const f32x4*)(sh + j * 256 + lane * 4), c4 = *(const f32x4*)(sc + j * 256 + lane * 4);
            const f32x4 y = (v[j] * rstd) * gv[j] * (c4 + 1.f) + s4;
            u32x2 o; o.x = pk2(y[0], y[1]); o.y = pk2(y[2], y[3]);
            *(u32x2*)(U + (size_t)row * D + j * 256 + lane * 4) = o;
        }
    }
}
__device__ void final_norm_phase(const float* H, const float* g, float* out) {
    const int lane = TID() & 63, gw = BID() * 8 + (TID() >> 6), ngw = GDIM() * 8;
    f32x4 gv[4];
#pragma unroll
    for (int j = 0; j < 4; ++j) gv[j] = *(const f32x4*)(g + j * 256 + lane * 4);
    for (int row = gw; row < MLAT; row += ngw) {
        f32x4 v[4]; float s = 0.f;
#pragma unroll
        for (int j = 0; j < 4; ++j) { v[j] = *(const f32x4*)(H + (size_t)row * D + j * 256 + lane * 4); s += (v[j][0] * v[j][0] + v[j][1] * v[j][1]) + (v[j][2] * v[j][2] + v[j][3] * v[j][3]); }
        const float rstd = rsqrtf(wave_sum(s) * (1.f / D) + 1e-6f);
#pragma unroll
        for (int j = 0; j < 4; ++j) *(f32x4*)(out + (size_t)row * D + j * 256 + lane * 4) = (v[j] * rstd) * gv[j];
    }
}

__device__ __forceinline__ void unpack8(const u32x4 w, float* f) { f[0] = bflo(w.x); f[1] = bfhi(w.x); f[2] = bflo(w.y); f[3] = bfhi(w.y); f[4] = bflo(w.z); f[5] = bfhi(w.z); f[6] = bflo(w.w); f[7] = bfhi(w.w); }
__device__ void na_naive_phase(const bf16_t* P, const float* rpb, bf16_t* U, LAS unsigned char* lds) {
    constexpr int LD = 3072;
    const int lane = TID() & 63, gw = BID() * 8 + (TID() >> 6), ngw = GDIM() * 8;
    for (int item = gw; item < MTOT * 16; item += ngw) {
        const int row = item >> 4, h = item & 15;
        const bool lat = row < MLAT;
        const int b = lat ? (row >> 11) : ((row - MLAT) >> 8);
        const int t = row & 2047, r = t >> 6, c = t & 63;
        const int r0 = min(max(r - 4, 0), 24), win0 = min(max(c - 8, 0), 48);
        const int nk = lat ? 384 : 256;
        LAS float* q = (LAS float*)lds + (TID() >> 6) * 64;
        q[lane] = bf2f(P[(size_t)row * LD + 2048 + h * 64 + lane]);
        __builtin_amdgcn_wave_barrier();
        float s[6];
#pragma unroll
        for (int jj = 0; jj < 6; ++jj) s[jj] = -1e30f;
#pragma unroll 1
        for (int jj = 0; jj < 6; ++jj) {
            const int kk = lane + 64 * jj;
            float val = -1e30f;
            if (kk < nk) {
                int krow; float bias = 0.f;
                if (lat && kk < 128) { const int kr = r0 + (kk >> 4), kc = win0 + (kk & 15); krow = b * 2048 + kr * 64 + kc; bias = rpb[(h * 15 + (kr - r + 7)) * 31 + (kc - c + 15)]; }
                else krow = MLAT + b * 256 + (lat ? kk - 128 : kk);
                const u32x4* kp = (const u32x4*)(P + (size_t)krow * LD + h * 64);
                float d = 0.f;
#pragma unroll
                for (int i = 0; i < 8; ++i) { float kf[8]; unpack8(kp[i], kf); const f32x4 qa = *(const LAS f32x4*)(q + 8 * i), qb = *(const LAS f32x4*)(q + 8 * i + 4);
                    d += kf[0] * qa[0] + kf[1] * qa[1] + kf[2] * qa[2] + kf[3] * qa[3] + kf[4] * qb[0] + kf[5] * qb[1] + kf[6] * qb[2] + kf[7] * qb[3]; }
                val = d * 0.125f + bias;
            }
#pragma unroll
            for (int k2 = 0; k2 < 6; ++k2) s[k2] = (jj == k2) ? val : s[k2];
        }
        float mx = s[0];
#pragma unroll
        for (int jj = 1; jj < 6; ++jj) mx = fmaxf(mx, s[jj]);
        mx = wave_max(mx);
        float sum = 0.f;
#pragma unroll
        for (int jj = 0; jj < 6; ++jj) { s[jj] = (lane + 64 * jj < nk) ? __expf(s[jj] - mx) : 0.f; sum += s[jj]; }
        sum = wave_sum(sum);
        float o = 0.f;
#pragma unroll
        for (int jj = 0; jj < 6; ++jj) {
            if (jj * 64 < nk) {
#pragma unroll 4
                for (int src = 0; src < 64; ++src) {
                    const int kk = jj * 64 + src;
                    const float p = rdl(s[jj], src);
                    int krow;
                    if (lat && kk < 128) krow = b * 2048 + (r0 + (kk >> 4)) * 64 + win0 + (kk & 15); else krow = MLAT + b * 256 + (lat ? kk - 128 : kk);
                    o += p * bf2f(P[(size_t)krow * LD + 1024 + h * 64 + lane]);
                }
            }
        }
        U[(size_t)row * D + h * 64 + lane] = (bf16_t)f2bf(o / sum);
        __builtin_amdgcn_wave_barrier();
    }
}

__device__ void da_rope_phase(bf16_t* P, const float* R) {
    constexpr int LD = 3072;
    const int gt = BID() * 512 + TID(), ngt = GDIM() * 512;
    for (long it = gt; it < (long)MLAT * 1024; it += ngt) {
        const int row = (int)(it >> 10), w = (int)(it & 1023), sec = w >> 9, grp = (w >> 5) & 15, axis = (w >> 4) & 1, i = w & 15;
        const int t = row & 2047, pos = axis ? (t & 63) : (t >> 6);
        const float cs = R[pos * 16 + i], sn = R[1024 + pos * 16 + i];
        bf16_t* p = P + (size_t)row * LD + sec * 2048 + grp * 64 + axis * 32 + i;
        const float x1 = bf2f(p[0]), x2 = bf2f(p[16]);
        p[0] = (bf16_t)f2bf(x1 * cs - x2 * sn); p[16] = (bf16_t)f2bf(x2 * cs + x1 * sn);
    }
}
__device__ void da_naive_phase(const bf16_t* P, const float* lamp, const float* ng, bf16_t* U, LAS unsigned char* lds) {
    constexpr int LD = 3072;
    const int lane = TID() & 63, wid = TID() >> 6, gw = BID() * 8 + wid, ngw = GDIM() * 8;
    LAS float* qs = (LAS float*)lds + wid * 128;
    const float lam_init = 0.8f - 0.6f * expf(-0.3f * 2.f);
    const float l01 = wave_sum(lamp[lane] * lamp[64 + lane]), l23 = wave_sum(lamp[128 + lane] * lamp[192 + lane]);
    const float lam = expf(l01) - expf(l23) + lam_init;
    for (int item = gw; item < MTOT * 8; item += ngw) {
        const int row = item >> 3, h = item & 7;
        const bool lat = row < MLAT;
        const int b = lat ? (row >> 11) : ((row - MLAT) >> 8);
        const int nkl = lat ? 36 : 4;
        { const bf16_t* qp = P + (size_t)row * LD + 2048 + h * 128; qs[lane] = bf2f(qp[lane]) * 0.125f; qs[64 + lane] = bf2f(qp[64 + lane]) * 0.125f; }
        __builtin_amdgcn_wave_barrier();
        float m0 = -1e30f, m1 = -1e30f, l0 = 0.f, l1 = 0.f;
#pragma unroll 1
        for (int jj = 0; jj < nkl; ++jj) {
            const int kk = lane + 64 * jj;
            const int krow = lat ? (kk < 2048 ? b * 2048 + kk : MLAT + b * 256 + kk - 2048) : MLAT + b * 256 + kk;
            const u32x4* kp = (const u32x4*)(P + (size_t)krow * LD + h * 128);
            float d0 = 0.f, d1 = 0.f;
#pragma unroll
            for (int i = 0; i < 8; ++i) { float kf[8]; unpack8(kp[i], kf); const f32x4 qa = *(const LAS f32x4*)(qs + 8 * i), qb = *(const LAS f32x4*)(qs + 8 * i + 4);
                d0 += kf[0] * qa[0] + kf[1] * qa[1] + kf[2] * qa[2] + kf[3] * qa[3] + kf[4] * qb[0] + kf[5] * qb[1] + kf[6] * qb[2] + kf[7] * qb[3]; }
#pragma unroll
            for (int i = 0; i < 8; ++i) { float kf[8]; unpack8(kp[8 + i], kf); const f32x4 qa = *(const LAS f32x4*)(qs + 64 + 8 * i), qb = *(const LAS f32x4*)(qs + 64 + 8 * i + 4);
                d1 += kf[0] * qa[0] + kf[1] * qa[1] + kf[2] * qa[2] + kf[3] * qa[3] + kf[4] * qb[0] + kf[5] * qb[1] + kf[6] * qb[2] + kf[7] * qb[3]; }
            const float n0 = fmaxf(m0, d0), n1 = fmaxf(m1, d1);
            l0 = l0 * __expf(m0 - n0) + __expf(d0 - n0); l1 = l1 * __expf(m1 - n1) + __expf(d1 - n1); m0 = n0; m1 = n1;
        }
        { const float g0 = wave_max(m0), g1 = wave_max(m1); l0 = wave_sum(l0 * __expf(m0 - g0)); l1 = wave_sum(l1 * __expf(m1 - g1)); m0 = g0; m1 = g1; }
        const float i0 = 1.f / l0, i1 = lam / l1;
        float o0 = 0.f, o1 = 0.f;
#pragma unroll 1
        for (int jj = 0; jj < nkl; ++jj) {
            const int kk0 = lane + 64 * jj;
            const int krow0 = lat ? (kk0 < 2048 ? b * 2048 + kk0 : MLAT + b * 256 + kk0 - 2048) : MLAT + b * 256 + kk0;
            const u32x4* kp = (const u32x4*)(P + (size_t)krow0 * LD + h * 128);
            float d0 = 0.f, d1 = 0.f;
#pragma unroll
            for (int i = 0; i < 8; ++i) { float kf[8]; unpack8(kp[i], kf); const f32x4 qa = *(const LAS f32x4*)(qs + 8 * i), qb = *(const LAS f32x4*)(qs + 8 * i + 4);
                d0 += kf[0] * qa[0] + kf[1] * qa[1] + kf[2] * qa[2] + kf[3] * qa[3] + kf[4] * qb[0] + kf[5] * qb[1] + kf[6] * qb[2] + kf[7] * qb[3]; }
#pragma unroll
            for (int i = 0; i < 8; ++i) { float kf[8]; unpack8(kp[8 + i], kf); const f32x4 qa = *(const LAS f32x4*)(qs + 64 + 8 * i), qb = *(const LAS f32x4*)(qs + 64 + 8 * i + 4);
                d1 += kf[0] * qa[0] + kf[1] * qa[1] + kf[2] * qa[2] + kf[3] * qa[3] + kf[4] * qb[0] + kf[5] * qb[1] + kf[6] * qb[2] + kf[7] * qb[3]; }
            const float wv = __expf(d0 - m0) * i0 - __expf(d1 - m1) * i1;
#pragma unroll 4
            for (int src = 0; src < 64; ++src) {
                const int kk = jj * 64 + src;
                const int krow = lat ? (kk < 2048 ? b * 2048 + kk : MLAT + b * 256 + kk - 2048) : MLAT + b * 256 + kk;
                const float p = rdl(wv, src);
                const bf16_t* vp = P + (size_t)krow * LD + 1024 + h * 128;
                o0 += p * bf2f(vp[lane]); o1 += p * bf2f(vp[64 + lane]);
            }
        }
        const float rstd = rsqrtf(wave_sum(o0 * o0 + o1 * o1) * (1.f / 128.f) + 1e-6f) * (1.f - lam_init);
        U[(size_t)row * D + h * 128 + lane] = (bf16_t)f2bf(o0 * rstd * ng[h * 128 + lane]);
        U[(size_t)row * D + h * 128 + 64 + lane] = (bf16_t)f2bf(o1 * rstd * ng[h * 128 + 64 + lane]);
        __builtin_amdgcn_wave_barrier();
    }
}


typedef short bf16x8 __attribute__((ext_vector_type(8)));
__device__ __forceinline__ bf16x8 pack8(const f32x4 a, const f32x4 b) { u32x4 w; w.x = pk2(a[0], a[1]); w.y = pk2(a[2], a[3]); w.z = pk2(b[0], b[1]); w.w = pk2(b[2], b[3]); return __builtin_bit_cast(bf16x8, w); }
__device__ void da_flash_phase(const bf16_t* P, const bf16_t* VT, const float* lamp, const float* ng, bf16_t* U, LAS unsigned char* lds) {
    constexpr int LD = 3072, KS = 272, VS = 144, KBUF = 64 * KS, VBUF = 128 * VS, BUF = KBUF + VBUF;
    const int tid = TID(), lane = tid & 63, wid = tid >> 6, m16 = lane & 15, quad = lane >> 4;
    const float lam_init = 0.8f - 0.6f * expf(-0.3f * 2.f);
    const float l01 = wave_sum(lamp[lane] * lamp[64 + lane]), l23 = wave_sum(lamp[128 + lane] * lamp[192 + lane]);
    const float lam = expf(l01) - expf(l23) + lam_init;
    const int kkey = tid >> 3, kch = tid & 7, vdv = tid >> 2, vch = tid & 3;
    const int krho = ((kkey >> 5) * 2 + ((kkey >> 2) & 1)) * 16 + ((kkey >> 3) & 3) * 4 + (kkey & 3);
    for (int item = BID(); item < 1024 + 128; item += GDIM()) {
        const bool lat = item < 1024;
        int b, h, qb;
        if (lat) { b = item >> 7; h = (item >> 4) & 7; qb = item & 15; } else { const int i2 = item - 1024; b = i2 >> 4; h = (i2 >> 1) & 7; qb = i2 & 1; }
        const int qrow = (lat ? b * 2048 : MLAT + b * 256) + qb * 128 + wid * 16 + m16;
        const int nblk = lat ? 36 : 4;
        bf16x8 qf[2][2];
        { const bf16_t* qp = P + (size_t)qrow * LD + 2048 + h * 128 + quad * 8;
#pragma unroll
          for (int j = 0; j < 2; ++j)
#pragma unroll
            for (int ks = 0; ks < 2; ++ks) qf[j][ks] = *(const bf16x8*)(qp + j * 64 + ks * 32); }
        f32x4 O[2][8];
#pragma unroll
        for (int j = 0; j < 2; ++j)
#pragma unroll
            for (int dt = 0; dt < 8; ++dt) O[j][dt] = (f32x4){0.f, 0.f, 0.f, 0.f};
        float mrun[2] = {-1e30f, -1e30f}, lrun[2] = {0.f, 0.f};
        u32x4 rk0, rk1, rv0, rv1;
        {
            const int kr0 = lat ? b * 2048 : MLAT + b * 256;
            const bf16_t* kp = P + (size_t)(kr0 + kkey) * LD + h * 128 + kch * 8;
            rk0 = *(const u32x4*)kp; rk1 = *(const u32x4*)(kp + 64);
            const bf16_t* vp = VT + (size_t)(h * 128 + vdv) * MTOT + kr0 + vch * 8;
            rv0 = *(const u32x4*)vp; rv1 = *(const u32x4*)(vp + 32);
            LAS unsigned char* Kb = lds; LAS unsigned char* Vb = lds + KBUF;
            *(LAS u32x4*)(Kb + krho * KS + kch * 16) = rk0; *(LAS u32x4*)(Kb + krho * KS + (kch + 8) * 16) = rk1;
            *(LAS u32x4*)(Vb + vdv * VS + vch * 16) = rv0; *(LAS u32x4*)(Vb + vdv * VS + (vch + 4) * 16) = rv1;
        }
        __syncthreads();
#pragma unroll 1
        for (int kb = 0; kb < nblk; ++kb) {
            const bool more = kb + 1 < nblk;
            if (more) {
                const int k1 = kb + 1;
                const int kr0 = lat ? (k1 < 32 ? b * 2048 + k1 * 64 : MLAT + b * 256 + (k1 - 32) * 64) : MLAT + b * 256 + k1 * 64;
                const bf16_t* kp = P + (size_t)(kr0 + kkey) * LD + h * 128 + kch * 8;
                rk0 = *(const u32x4*)kp; rk1 = *(const u32x4*)(kp + 64);
                const bf16_t* vp = VT + (size_t)(h * 128 + vdv) * MTOT + kr0 + vch * 8;
                rv0 = *(const u32x4*)vp; rv1 = *(const u32x4*)(vp + 32);
            }
            LAS const unsigned char* Kb = lds + (kb & 1) * BUF; LAS const unsigned char* Vb = Kb + KBUF;
            f32x4 st[2][2][2];
#pragma unroll
            for (int sb = 0; sb < 2; ++sb)
#pragma unroll
                for (int j = 0; j < 2; ++j)
#pragma unroll
                    for (int T = 0; T < 2; ++T) {
                        f32x4 acc = (f32x4){0.f, 0.f, 0.f, 0.f};
#pragma unroll
                        for (int ks = 0; ks < 2; ++ks) {
                            const bf16x8 A = *(LAS const bf16x8*)(Kb + ((sb * 2 + T) * 16 + m16) * KS + (j * 64 + ks * 32 + quad * 8) * 2);
                            acc = __builtin_amdgcn_mfma_f32_16x16x32_bf16(A, qf[j][ks], acc, 0, 0, 0);
                        }
                        st[sb][j][T] = acc;
                    }
#pragma unroll
            for (int j = 0; j < 2; ++j) {
                float mx = -1e30f;
#pragma unroll
                for (int sb = 0; sb < 2; ++sb)
#pragma unroll
                    for (int T = 0; T < 2; ++T)
#pragma unroll
                        for (int e = 0; e < 4; ++e) mx = fmaxf(mx, st[sb][j][T][e]);
                mx = fmaxf(mx, shx(mx, 16)); mx = fmaxf(mx, shx(mx, 32));
                const float mnew = fmaxf(mrun[j], mx), alpha = __expf(mrun[j] - mnew);
                mrun[j] = mnew;
                float ps = 0.f;
#pragma unroll
                for (int sb = 0; sb < 2; ++sb)
#pragma unroll
                    for (int T = 0; T < 2; ++T)
#pragma unroll
                        for (int e = 0; e < 4; ++e) { const float pv = __expf(st[sb][j][T][e] - mnew); st[sb][j][T][e] = pv; ps += pv; }
                lrun[j] = lrun[j] * alpha + ps;
#pragma unroll
                for (int dt = 0; dt < 8; ++dt) O[j][dt] = O[j][dt] * alpha;
            }
#pragma unroll
            for (int sb = 0; sb < 2; ++sb) {
                const bf16x8 p0 = pack8(st[sb][0][0], st[sb][0][1]), p1 = pack8(st[sb][1][0], st[sb][1][1]);
#pragma unroll
                for (int dt = 0; dt < 8; ++dt) {
                    const bf16x8 A = *(LAS const bf16x8*)(Vb + (dt * 16 + m16) * VS + (sb * 32 + quad * 8) * 2);
                    O[0][dt] = __builtin_amdgcn_mfma_f32_16x16x32_bf16(A, p0, O[0][dt], 0, 0, 0);
                    O[1][dt] = __builtin_amdgcn_mfma_f32_16x16x32_bf16(A, p1, O[1][dt], 0, 0, 0);
                }
            }
            if (more) {
                LAS unsigned char* Kn = lds + ((kb + 1) & 1) * BUF; LAS unsigned char* Vn = Kn + KBUF;
                *(LAS u32x4*)(Kn + krho * KS + kch * 16) = rk0; *(LAS u32x4*)(Kn + krho * KS + (kch + 8) * 16) = rk1;
                *(LAS u32x4*)(Vn + vdv * VS + vch * 16) = rv0; *(LAS u32x4*)(Vn + vdv * VS + (vch + 4) * 16) = rv1;
            }
            __syncthreads();
        }
        float l0 = lrun[0], l1 = lrun[1];
        l0 += shx(l0, 16); l0 += shx(l0, 32); l1 += shx(l1, 16); l1 += shx(l1, 32);
        const float i0 = 1.f / l0, i1 = lam / l1;
        float ss = 0.f;
#pragma unroll
        for (int dt = 0; dt < 8; ++dt) { O[0][dt] = O[0][dt] * i0 - O[1][dt] * i1;
#pragma unroll
            for (int e = 0; e < 4; ++e) ss += O[0][dt][e] * O[0][dt][e]; }
        ss += shx(ss, 16); ss += shx(ss, 32);
        const float rstd = rsqrtf(ss * (1.f / 128.f) + 1e-6f) * (1.f - lam_init);
#pragma unroll
        for (int dt = 0; dt < 8; ++dt) {
            const int c = h * 128 + dt * 16 + quad * 4;
            const f32x4 g4 = *(const f32x4*)(ng + c);
            const f32x4 y = O[0][dt] * rstd * g4;
            u32x2 o; o.x = pk2(y[0], y[1]); o.y = pk2(y[2], y[3]);
            *(u32x2*)(U + (size_t)qrow * D + c) = o;
        }
    }
}


__device__ void na_mfma_phase(const bf16_t* P, const bf16_t* VT, const float* rpb, bf16_t* U) {
    constexpr int LD = 3072;
    const int lane = TID() & 63, gw = BID() * 8 + (TID() >> 6), ngw = GDIM() * 8, m16 = lane & 15, quad = lane >> 4;
    const int krow_in = (m16 >> 2) * 8 + (m16 & 3);
    for (int item = gw; item < 16384 + 2048; item += ngw) {
        const bool lat = item < 16384;
        int b, h, r = 0, j = 0, qrow;
        if (lat) { b = item >> 11; h = (item >> 7) & 15; r = (item >> 2) & 31; j = item & 3; qrow = b * 2048 + r * 64 + j * 16 + m16; }
        else { const int i2 = item - 16384; b = i2 >> 8; h = (i2 >> 4) & 15; qrow = MLAT + b * 256 + (i2 & 15) * 16 + m16; }
        const int r0 = min(max(r - 4, 0), 24), kc0 = min(max(16 * j - 8, 0), 32);
        const int c = j * 16 + m16, win0 = min(max(c - 8, 0), 48);
        bf16x8 qf[2];
        { const bf16_t* qp = P + (size_t)qrow * LD + 2048 + h * 64 + quad * 8; qf[0] = *(const bf16x8*)qp; qf[1] = *(const bf16x8*)(qp + 32); }
        f32x4 st[16][2];
        float mx = -1e30f;
#pragma unroll
        for (int sp = 0; sp < 16; ++sp) {
            if (sp < 8 && !lat) { st[sp][0] = (f32x4){-1e30f, -1e30f, -1e30f, -1e30f}; st[sp][1] = st[sp][0]; continue; }
            const int tok0 = sp < 8 ? b * 2048 + (r0 + sp) * 64 + kc0 : MLAT + b * 256 + (sp - 8) * 32;
#pragma unroll
            for (int T = 0; T < 2; ++T) {
                const bf16_t* kp = P + (size_t)(tok0 + krow_in + 4 * T) * LD + h * 64 + quad * 8;
                f32x4 acc = (f32x4){0.f, 0.f, 0.f, 0.f};
                acc = __builtin_amdgcn_mfma_f32_16x16x32_bf16(*(const bf16x8*)kp, qf[0], acc, 0, 0, 0);
                acc = __builtin_amdgcn_mfma_f32_16x16x32_bf16(*(const bf16x8*)(kp + 32), qf[1], acc, 0, 0, 0);
                if (sp < 8) {
                    const int ro = (r0 + sp - r + 7) * 31;
#pragma unroll
                    for (int e = 0; e < 4; ++e) {
                        const int kc = kc0 + quad * 8 + T * 4 + e;
                        const bool inw = (kc >= win0) && (kc < win0 + 16);
                        const float bias = rpb[h * 465 + (inw ? ro + (kc - c + 15) : 0)];
                        acc[e] = inw ? acc[e] + bias : -1e30f;
                    }
                }
                st[sp][T] = acc;
#pragma unroll
                for (int e = 0; e < 4; ++e) mx = fmaxf(mx, acc[e]);
            }
        }
        mx = fmaxf(mx, shx(mx, 16)); mx = fmaxf(mx, shx(mx, 32));
        float sum = 0.f;
        f32x4 O[4];
#pragma unroll
        for (int dt = 0; dt < 4; ++dt) O[dt] = (f32x4){0.f, 0.f, 0.f, 0.f};
#pragma unroll
        for (int sp = 0; sp < 16; ++sp) {
            if (sp < 8 && !lat) continue;
#pragma unroll
            for (int T = 0; T < 2; ++T)
#pragma unroll
                for (int e = 0; e < 4; ++e) { const float pv = __expf(st[sp][T][e] - mx); st[sp][T][e] = pv; sum += pv; }
            const bf16x8 pf = pack8(st[sp][0], st[sp][1]);
            const int tok0 = sp < 8 ? b * 2048 + (r0 + sp) * 64 + kc0 : MLAT + b * 256 + (sp - 8) * 32;
#pragma unroll
            for (int dt = 0; dt < 4; ++dt) {
                const bf16x8 Av = *(const bf16x8*)(VT + (size_t)(h * 64 + dt * 16 + m16) * MTOT + tok0 + quad * 8);
                O[dt] = __builtin_amdgcn_mfma_f32_16x16x32_bf16(Av, pf, O[dt], 0, 0, 0);
            }
        }
        sum += shx(sum, 16); sum += shx(sum, 32);
        const float inv = 1.f / sum;
#pragma unroll
        for (int dt = 0; dt < 4; ++dt) {
            const f32x4 y = O[dt] * inv;
            u32x2 o; o.x = pk2(y[0], y[1]); o.y = pk2(y[2], y[3]);
            *(u32x2*)(U + (size_t)qrow * D + h * 64 + dt * 16 + quad * 4) = o;
        }
    }
}

constexpr int ML_LD = 4352, ML_NKVG = 2064;
__device__ void ml_prep_phase(const bf16_t* P, const float* convw, bf16_t* QC, bf16_t* KC) {
    const int gt = BID() * 512 + TID(), ngt = GDIM() * 512;
    for (long it = gt; it < (long)MTOT * 2048; it += ngt) {
        const int row = (int)(it >> 11), w = (int)(it & 2047), isq = w >> 10, ch = w & 1023;
        const bool lat = row < MLAT;
        const int pos = lat ? (row & 2047) : ((row - MLAT) & 255), len = lat ? 2048 : 256;
        const int col = isq ? (ML_NKVG + ch) : ch;
        const float w0 = convw[0 * 2048 + isq * 1024 + ch], w1 = convw[1 * 2048 + isq * 1024 + ch], w2 = convw[2 * 2048 + isq * 1024 + ch];
        const bf16_t* p = P + (size_t)row * ML_LD + col;
        float v = w1 * bf2f(p[0]);
        if (pos > 0) v += w0 * bf2f(p[-ML_LD]);
        if (pos < len - 1) v += w2 * bf2f(p[ML_LD]);
        v = silu(v);
        if (isq) QC[(size_t)row * D + ch] = (bf16_t)f2bf(v); else KC[(size_t)row * D + ch] = (bf16_t)f2bf(v * 0.0625f);
    }
}
__device__ void ml_scan_naive_phase(const bf16_t* P, const float* G32, const float* gate_b, const bf16_t* QC, const bf16_t* KC, float* HS, LAS unsigned char* lds) {
    const int tid = TID(), dvl = tid & 63, g = tid >> 6;
    LAS float* red = (LAS float*)lds;
    LAS float* redd = red + 2 * 8 * 64;
    for (int item = BID(); item < 256; item += GDIM()) {
        const int dir = item >> 7, b = (item >> 4) & 7, h = (item >> 2) & 3, sl = item & 3;
        const float bi = gate_b[dir * 8 + h], bfg = gate_b[dir * 8 + 4 + h];
        float C[32], n[32];
#pragma unroll
        for (int j = 0; j < 32; ++j) { C[j] = 0.f; n[j] = 0.f; }
        float m = 0.f;
        for (int step = 0; step < CTXL + SEQ; ++step) {
            int row;
            if (step < CTXL) row = MLAT + b * CTXL + (dir ? CTXL - 1 - step : step);
            else { const int s2 = step - CTXL; row = b * SEQ + (dir ? SEQ - 1 - s2 : s2); }
            const float ig = G32[(size_t)row * 32 + dir * 8 + h] + bi, fg = G32[(size_t)row * 32 + dir * 8 + 4 + h] + bfg;
            const float lf = log_sigmoid(fg);
            const float mn = fmaxf(lf + m, ig), fw = __expf(lf + m - mn), iw = __expf(ig - mn);
            m = mn;
            const float v = bf2f(P[(size_t)row * ML_LD + 1024 + h * 256 + sl * 64 + dvl]);
            const u32x4* qp = (const u32x4*)(QC + (size_t)row * D + h * 256 + g * 32);
            const u32x4* kp = (const u32x4*)(KC + (size_t)row * D + h * 256 + g * 32);
            float part = 0.f, dpart = 0.f;
#pragma unroll
            for (int i = 0; i < 4; ++i) {
                float qf[8], kf[8]; unpack8(qp[i], qf); unpack8(kp[i], kf);
#pragma unroll
                for (int e = 0; e < 8; ++e) {
                    const int j = 8 * i + e;
                    C[j] = fw * C[j] + (iw * kf[e]) * v; n[j] = fw * n[j] + iw * kf[e];
                    part += qf[e] * C[j]; dpart += qf[e] * n[j];
                }
            }
            const int pb = step & 1;
            red[(pb * 8 + g) * 64 + dvl] = part;
            if (dvl == 0) redd[pb * 8 + g] = dpart;
            __syncthreads();
            if (tid < 64) {
                float num = 0.f, den = 0.f;
#pragma unroll
                for (int w = 0; w < 8; ++w) { num += red[(pb * 8 + w) * 64 + tid]; den += redd[pb * 8 + w]; }
                HS[((size_t)dir * MTOT + row) * D + h * 256 + sl * 64 + tid] = num / fmaxf(fabsf(den), __expf(-m));
            }
        }
        __syncthreads();
    }
}
__device__ void ml_readout_phase(const bf16_t* P, const bf16_t* HS, const float* ng, bf16_t* U) {
    const int lane = TID() & 63, gw = BID() * 8 + (TID() >> 6), ngw = GDIM() * 8;
    for (int row = gw; row < MTOT; row += ngw) {
        const int c0 = lane * 16;
        float v[16]; float ss = 0.f;
#pragma unroll
        for (int i = 0; i < 2; ++i) {
            float f0[8], f1[8]; unpack8(*(const u32x4*)(HS + (size_t)row * D + c0 + 8 * i), f0); unpack8(*(const u32x4*)(HS + ((size_t)MTOT + row) * D + c0 + 8 * i), f1);
#pragma unroll
            for (int e = 0; e < 8; ++e) { v[8 * i + e] = f0[e] + f1[e]; ss += v[8 * i + e] * v[8 * i + e]; }
        }
        ss += shx(ss, 1); ss += shx(ss, 2); ss += shx(ss, 4); ss += shx(ss, 8);
        const float rstd = rsqrtf(ss * (1.f / 256.f) + 1e-6f);
        const bf16_t* op = P + (size_t)row * ML_LD + ML_NKVG + D + c0;
        unsigned o[8];
#pragma unroll
        for (int i = 0; i < 8; ++i) {
            const float y0 = sigmoidf_(bf2f(op[2 * i])) * v[2 * i] * rstd * ng[c0 + 2 * i], y1 = sigmoidf_(bf2f(op[2 * i + 1])) * v[2 * i + 1] * rstd * ng[c0 + 2 * i + 1];
            o[i] = pk2(y0, y1);
        }
        u32x4* up = (u32x4*)(U + (size_t)row * D + c0);
        up[0] = (u32x4){o[0], o[1], o[2], o[3]}; up[1] = (u32x4){o[4], o[5], o[6], o[7]};
    }
}

constexpr int GL_LD = 3328, GL_NKVG = 1568;
__device__ void gla_prep_phase(const float* G32, const float* wgu, const float* bg, float* LA) {
    const int gt = BID() * 512 + TID(), ngt = GDIM() * 512;
    for (long it = gt; it < (long)2 * MTOT * 512; it += ngt) {
        const int c = (int)(it & 511), row = (int)((it >> 9) % MTOT), dir = (int)(it / ((long)MTOT * 512));
        const float* low = G32 + (size_t)row * 32 + dir * 16;
        float acc = bg[dir * 512 + c];
#pragma unroll
        for (int r = 0; r < 16; ++r) acc += low[r] * wgu[(dir * 16 + r) * 512 + c];
        LA[((size_t)dir * MTOT + row) * 512 + c] = log_sigmoid(acc) * (1.f / 16.f);
    }
}
__device__ void gla_scan_naive_phase(const bf16_t* P, const float* LA, float* HS, LAS unsigned char* lds) {
    const int tid = TID(), dvl = tid & 63, g = tid >> 6;
    LAS float* red = (LAS float*)lds;
    for (int item = BID(); item < 256; item += GDIM()) {
        const int dir = item >> 7, b = (item >> 4) & 7, h = (item >> 2) & 3, sl = item & 3;
        float S[16];
#pragma unroll
        for (int j = 0; j < 16; ++j) S[j] = 0.f;
        for (int step = 0; step < CTXL + SEQ; ++step) {
            int row;
            if (step < CTXL) row = MLAT + b * CTXL + (dir ? CTXL - 1 - step : step);
            else { const int s2 = step - CTXL; row = b * SEQ + (dir ? SEQ - 1 - s2 : s2); }
            const float v = bf2f(P[(size_t)row * GL_LD + 512 + h * 256 + sl * 64 + dvl]);
            const u32x4* kp = (const u32x4*)(P + (size_t)row * GL_LD + h * 128 + g * 16);
            const u32x4* qp = (const u32x4*)(P + (size_t)row * GL_LD + GL_NKVG + h * 128 + g * 16);
            const f32x4* lp = (const f32x4*)(LA + ((size_t)dir * MTOT + row) * 512 + h * 128 + g * 16);
            float part = 0.f;
#pragma unroll
            for (int i = 0; i < 2; ++i) {
                float qf[8], kf[8]; unpack8(qp[i], qf); unpack8(kp[i], kf);
                const f32x4 la0 = lp[2 * i], la1 = lp[2 * i + 1];
#pragma unroll
                for (int e = 0; e < 8; ++e) {
                    const int j = 8 * i + e; const float al = __expf(e < 4 ? la0[e] : la1[e - 4]);
                    S[j] = al * S[j] + kf[e] * v; part += qf[e] * S[j];
                }
            }
            const int pb = step & 1;
            red[(pb * 8 + g) * 64 + dvl] = part;
            __syncthreads();
            if (tid < 64 && step >= CTXL) {
                float num = 0.f;
#pragma unroll
                for (int w = 0; w < 8; ++w) num += red[(pb * 8 + w) * 64 + tid];
                HS[((size_t)dir * MTOT + row) * D + h * 256 + sl * 64 + tid] = num * 0.08838834764831845f;
            }
        }
        __syncthreads();
    }
}
__device__ void gla_readout_phase(const bf16_t* P, const bf16_t* HS, const float* ng, bf16_t* U) {
    const int lane = TID() & 63, gw = BID() * 8 + (TID() >> 6), ngw = GDIM() * 8;
    for (int row = gw; row < MLAT; row += ngw) {
        const int c0 = lane * 16;
        float v[16]; float ss = 0.f;
#pragma unroll
        for (int i = 0; i < 2; ++i) {
            float f0[8], f1[8]; unpack8(*(const u32x4*)(HS + (size_t)row * D + c0 + 8 * i), f0); unpack8(*(const u32x4*)(HS + ((size_t)MTOT + row) * D + c0 + 8 * i), f1);
#pragma unroll
            for (int e = 0; e < 8; ++e) { v[8 * i + e] = f0[e] + f1[e]; ss += v[8 * i + e] * v[8 * i + e]; }
        }
        ss += shx(ss, 1); ss += shx(ss, 2); ss += shx(ss, 4); ss += shx(ss, 8);
        const float rstd = rsqrtf(ss * (1.f / 256.f) + 1e-6f);
        const bf16_t* rp = P + (size_t)row * GL_LD + GL_NKVG + 512 + c0;
        unsigned o[8];
#pragma unroll
        for (int i = 0; i < 8; ++i) {
            const float y0 = silu(bf2f(rp[2 * i])) * v[2 * i] * rstd * ng[c0 + 2 * i], y1 = silu(bf2f(rp[2 * i + 1])) * v[2 * i + 1] * rstd * ng[c0 + 2 * i + 1];
            o[i] = pk2(y0, y1);
        }
        u32x4* up = (u32x4*)(U + (size_t)row * D + c0);
        up[0] = (u32x4){o[0], o[1], o[2], o[3]}; up[1] = (u32x4){o[4], o[5], o[6], o[7]};
    }
}


__device__ __forceinline__ int chunk_row0(int cidx) { return cidx < 256 ? (cidx >> 5) * 2048 + (cidx & 31) * 64 : MLAT + ((cidx - 256) >> 2) * 256 + ((cidx - 256) & 3) * 64; }
__device__ void ml_prep2_phase(const bf16_t* P, const float* G32, const float* gate_b, const float* convw, bf16_t* QC, bf16_t* KC, bf16_t* KBT, unsigned char* sc, LAS unsigned char* lds) {
    constexpr int KTS = 258;
    const int tid = TID();
    LAS bf16_t* ktile = (LAS bf16_t*)lds;
    LAS float* lfL = (LAS float*)(lds + 64 * KTS * 2);
    LAS float* igL = lfL + 128; LAS float* aL = igL + 128; LAS float* aeL = aL + 128;
    float* SA = (float*)(sc + SC_SA); float* SMX = (float*)(sc + SC_SMX); float* SB = (float*)(sc + SC_SB); float* CE = (float*)(sc + SC_CE);
    for (int item = BID(); item < 288 * 4; item += GDIM()) {
        const int cidx = item >> 2, h = item & 3, row0 = chunk_row0(cidx);
        const int p0 = cidx < 256 ? (cidx & 31) * 64 : ((cidx - 256) & 3) * 64, len = cidx < 256 ? 2048 : 256;
        if (tid < 128) { const int dir = tid >> 6, tau = tid & 63; const float* gp = G32 + (size_t)(row0 + tau) * 32 + dir * 8 + h;
            igL[dir * 64 + tau] = gp[0] + gate_b[dir * 8 + h]; lfL[dir * 64 + tau] = log_sigmoid(gp[4] + gate_b[dir * 8 + 4 + h]); }
        for (int idx = tid; idx < 2 * 64 * 256; idx += 512) {
            const int isq = idx >> 14, tau = (idx >> 8) & 63, ch = idx & 255, c = h * 256 + ch, row = row0 + tau, pos = p0 + tau;
            const float w0 = convw[0 * 2048 + isq * 1024 + c], w1 = convw[1 * 2048 + isq * 1024 + c], w2 = convw[2 * 2048 + isq * 1024 + c];
            const bf16_t* pp = P + (size_t)row * ML_LD + (isq ? ML_NKVG + c : c);
            float v = w1 * bf2f(pp[0]);
            if (pos > 0) v += w0 * bf2f(pp[-ML_LD]);
            if (pos < len - 1) v += w2 * bf2f(pp[ML_LD]);
            v = silu(v);
            if (isq) QC[(size_t)row * D + c] = (bf16_t)f2bf(v);
            else { const bf16_t kb = (bf16_t)f2bf(v * 0.0625f); KC[(size_t)row * D + c] = kb; ktile[tau * KTS + ch] = kb; }
        }
        __syncthreads();
        if (tid < 2) {
            const int dir = tid; float run = 0.f, mx = -1e30f;
            for (int pp = 0; pp < 64; ++pp) {
                const int tau = dir ? 63 - pp : pp;
                run += lfL[dir * 64 + tau]; const float av = igL[dir * 64 + tau] - run; mx = fmaxf(mx, av);
                const size_t o = ((size_t)(dir * 4 + h)) * MTOT + row0 + tau;
                SB[o] = run; SA[o] = av; SMX[o] = mx; aL[dir * 64 + tau] = av;
            }
            CE[((dir * 4 + h) * 288 + cidx) * 2] = mx; CE[((dir * 4 + h) * 288 + cidx) * 2 + 1] = run; aeL[dir] = mx;
        }
        __syncthreads();
        for (int idx = tid; idx < 2 * 256 * 8; idx += 512) {
            const int dir = idx >> 11, dk = (idx >> 3) & 255, sc8 = idx & 7; const float ae = aeL[dir];
            unsigned o[4];
#pragma unroll
            for (int i = 0; i < 4; ++i) { const int s0 = sc8 * 8 + 2 * i;
                o[i] = pk2(bf2f(ktile[s0 * KTS + dk]) * __expf(aL[dir * 64 + s0] - ae), bf2f(ktile[(s0 + 1) * KTS + dk]) * __expf(aL[dir * 64 + s0 + 1] - ae)); }
            *(u32x4*)(KBT + ((size_t)dir * D + h * 256 + dk) * MTOT + row0 + sc8 * 8) = (u32x4){o[0], o[1], o[2], o[3]};
        }
        __syncthreads();
    }
}
__device__ void gla_prep2_phase(const bf16_t* P, const float* G32, const float* wgu, const float* bg, bf16_t* QA, bf16_t* KA, bf16_t* KBT, unsigned char* sc, LAS unsigned char* lds) {
    const int tid = TID();
    LAS float* laL = (LAS float*)lds;
    LAS float* beL = laL + 2 * 64 * 128;
    float* DEC = (float*)(sc + SC_DEC);
    for (int item = BID(); item < 288 * 4; item += GDIM()) {
        const int cidx = item >> 2, h = item & 3, row0 = chunk_row0(cidx);
        {
            const int dk = tid & 127, dir = (tid >> 7) & 1, tg = tid >> 8;
            float w[16];
#pragma unroll
            for (int r = 0; r < 16; ++r) w[r] = wgu[(dir * 16 + r) * 512 + h * 128 + dk];
            const float bgv = bg[dir * 512 + h * 128 + dk];
            for (int tau = tg * 32; tau < tg * 32 + 32; ++tau) {
                const float* low = G32 + (size_t)(row0 + tau) * 32 + dir * 16;
                float acc = bgv;
#pragma unroll
                for (int r = 0; r < 16; ++r) acc += low[r] * w[r];
                laL[(dir * 64 + tau) * 128 + dk] = log_sigmoid(acc) * (1.f / 16.f);
            }
        }
        __syncthreads();
        if (tid < 256) {
            const int dir = tid >> 7, dk = tid & 127; float run = 0.f;
            for (int pp = 0; pp < 64; ++pp) { const int tau = dir ? 63 - pp : pp; run += laL[(dir * 64 + tau) * 128 + dk]; laL[(dir * 64 + tau) * 128 + dk] = run; }
            beL[dir * 128 + dk] = run; DEC[((size_t)dir * 288 + cidx) * 512 + h * 128 + dk] = __expf(run);
        }
        __syncthreads();
        for (int idx = tid; idx < 2 * 64 * 128; idx += 512) {
            const int dir = idx >> 13, tau = (idx >> 7) & 63, dk = idx & 127; const float bc = laL[(dir * 64 + tau) * 128 + dk];
            const bf16_t* pp = P + (size_t)(row0 + tau) * GL_LD + h * 128 + dk;
            const size_t o = ((size_t)dir * MTOT + row0 + tau) * 512 + h * 128 + dk;
            QA[o] = (bf16_t)f2bf(bf2f(pp[GL_NKVG]) * __expf(bc) * 0.08838834764831845f); KA[o] = (bf16_t)f2bf(bf2f(pp[0]) * __expf(-bc));
        }
        for (int idx = tid; idx < 2 * 128 * 8; idx += 512) {
            const int dir = idx >> 10, dk = (idx >> 3) & 127, sc8 = idx & 7; const float be = beL[dir * 128 + dk];
            unsigned o[4];
#pragma unroll
            for (int i = 0; i < 4; ++i) { const int s0 = sc8 * 8 + 2 * i; const bf16_t* pp = P + (size_t)(row0 + s0) * GL_LD + h * 128 + dk;
                o[i] = pk2(bf2f(pp[0]) * __expf(be - laL[(dir * 64 + s0) * 128 + dk]), bf2f(pp[GL_LD]) * __expf(be - laL[(dir * 64 + s0 + 1) * 128 + dk])); }
            *(u32x4*)(KBT + ((size_t)dir * 512 + h * 128 + dk) * MTOT + row0 + sc8 * 8) = (u32x4){o[0], o[1], o[2], o[3]};
        }
        __syncthreads();
    }
}
template <int DK, bool ML>
__device__ void chunk_scan_phase(const bf16_t* QAg, const bf16_t* KAg, size_t qa_dir_stride, const bf16_t* KBT, const bf16_t* VT, const unsigned char* sc, bf16_t* HS, LAS unsigned char* lds) {
    constexpr int RS = 4 * DK;
    constexpr int QS = DK * 2 + 16, VS = 144;
    constexpr int NG = DK / 64;
    constexpr int OFF_QA = 0, OFF_KA = 64 * QS, OFF_KBT = 2 * 64 * QS, OFF_VT = OFF_KBT + DK * VS, OFF_PT = OFF_VT + 64 * VS, OFF_TAB = OFF_PT + 8192;
    static_assert(OFF_TAB + 8192 <= 135168, "LDS");
    const int tid = TID(), lane = tid & 63, wid = tid >> 6, m16 = lane & 15, quad = lane >> 4, dt = wid & 3, kh = wid >> 2;
    LAS float* aL = (LAS float*)(lds + OFF_TAB);
    LAS float* mxL = aL + 64; LAS float* bL = aL + 128;
    LAS float* rsL = aL + 256;
    LAS float* qnL = aL + 384;
    LAS float* nL = aL + 896;
    LAS float* decL = aL;
    LAS f32x4* XL = (LAS f32x4*)(lds + OFF_KA);
    const float* SA = (const float*)(sc + SC_SA); const float* SMX = (const float*)(sc + SC_SMX); const float* SB = (const float*)(sc + SC_SB); const float* CE = (const float*)(sc + SC_CE);
    const float* DEC = (const float*)(sc + SC_DEC);
    for (int item = BID(); item < 256; item += GDIM()) {
        const int dir = item >> 7, b = (item >> 4) & 7, h = (item >> 2) & 3, sl = item & 3;
        const bf16_t* QAd = QAg + dir * qa_dir_stride; const bf16_t* KAd = KAg + dir * qa_dir_stride;
        const bf16_t* KBTd = KBT + ((size_t)dir * 4 * DK + h * DK) * MTOT;
        const bf16_t* VTd = VT + (size_t)(h * 256 + sl * 64) * MTOT;
        f32x4 Cst[NG][2];
#pragma unroll
        for (int g = 0; g < NG; ++g) { Cst[g][0] = (f32x4){0.f, 0.f, 0.f, 0.f}; Cst[g][1] = (f32x4){0.f, 0.f, 0.f, 0.f}; }
        float mrun = 0.f;
        if (ML && tid < 256) nL[tid] = 0.f;
#pragma unroll 1
        for (int ci = 0; ci < 36; ++ci) {
            int cidx;
            if (ci < 4) cidx = 256 + b * 4 + (dir ? 3 - ci : ci); else cidx = b * 32 + (dir ? 35 - ci : ci - 4);
            const int row0 = chunk_row0(cidx);
            for (int c = tid; c < 64 * DK / 8; c += 512) {
                const int r = c / (DK / 8), cc = c % (DK / 8);
                const u32x4 vq = *(const u32x4*)(QAd + (size_t)(row0 + r) * RS + h * DK + cc * 8), vk = *(const u32x4*)(KAd + (size_t)(row0 + r) * RS + h * DK + cc * 8);
                const int rho = ((r >> 5) * 2 + ((r >> 2) & 1)) * 16 + ((r >> 3) & 3) * 4 + (r & 3);
                *(LAS u32x4*)(lds + OFF_QA + r * QS + cc * 16) = vq; *(LAS u32x4*)(lds + OFF_KA + rho * QS + cc * 16) = vk;
            }
            for (int c = tid; c < DK * 8; c += 512) {
                const int r = c >> 3, cc = c & 7;
                const u32x4 v = *(const u32x4*)(KBTd + (size_t)r * MTOT + row0 + cc * 8);
                const int rho = (r & ~31) + ((r >> 2) & 1) * 16 + ((r >> 3) & 3) * 4 + (r & 3);
                *(LAS u32x4*)(lds + OFF_KBT + rho * VS + cc * 16) = v;
            }
            { const int r = tid >> 3, cc = tid & 7; *(LAS u32x4*)(lds + OFF_VT + r * VS + cc * 16) = *(const u32x4*)(VTd + (size_t)r * MTOT + row0 + cc * 8); }
            float ae = 0.f, be = 0.f;
            if (ML) {
                if (tid < 64) aL[tid] = SA[(size_t)(dir * 4 + h) * MTOT + row0 + tid];
                else if (tid < 128) aL[tid] = SMX[(size_t)(dir * 4 + h) * MTOT + row0 + tid - 64];
                else if (tid < 192) aL[tid] = SB[(size_t)(dir * 4 + h) * MTOT + row0 + tid - 128];
                ae = CE[((dir * 4 + h) * 288 + cidx) * 2]; be = CE[((dir * 4 + h) * 288 + cidx) * 2 + 1];
            } else {
                if (tid < DK) decL[tid] = DEC[((size_t)dir * 288 + cidx) * 512 + h * DK + tid];
            }
            __syncthreads();
            f32x4 st[2] = {(f32x4){0.f, 0.f, 0.f, 0.f}, (f32x4){0.f, 0.f, 0.f, 0.f}};
#pragma unroll
            for (int ks = 0; ks < DK / 32; ++ks) {
                const bf16x8 Bq = *(LAS const bf16x8*)(lds + OFF_QA + (dt * 16 + m16) * QS + (ks * 32 + quad * 8) * 2);
#pragma unroll
                for (int T = 0; T < 2; ++T) {
                    const bf16x8 Ak = *(LAS const bf16x8*)(lds + OFF_KA + ((kh * 2 + T) * 16 + m16) * QS + (ks * 32 + quad * 8) * 2);
                    st[T] = __builtin_amdgcn_mfma_f32_16x16x32_bf16(Ak, Bq, st[T], 0, 0, 0);
                }
            }
            const int tloc = dt * 16 + m16;
            float Mt = 0.f;
            if (ML) Mt = fmaxf(mrun, mxL[tloc]);
            float rsum = 0.f;
#pragma unroll
            for (int T = 0; T < 2; ++T)
#pragma unroll
                for (int e = 0; e < 4; ++e) {
                    const int sloc = kh * 32 + quad * 8 + T * 4 + e;
                    const bool valid = dir ? (sloc >= tloc) : (sloc <= tloc);
                    float wgt = valid ? 1.f : 0.f;
                    if (ML) wgt = valid ? __expf(aL[sloc] - Mt) : 0.f;
                    const float pv = st[T][e] * wgt; st[T][e] = pv; rsum += pv;
                }
            *(LAS bf16x8*)(lds + OFF_PT + ((kh * 4 + dt) * 64 + lane) * 16) = pack8(st[0], st[1]);
            if (ML) {
                rsum += shx(rsum, 16); rsum += shx(rsum, 32);
                if (quad == 0) rsL[kh * 64 + tloc] = rsum;
                float qn = 0.f;
#pragma unroll
                for (int i = 0; i < 4; ++i) { float qf8[8]; unpack8(*(LAS const u32x4*)(lds + OFF_QA + lane * QS + (wid * 32 + i * 8) * 2), qf8);
#pragma unroll
                    for (int e = 0; e < 8; ++e) qn += qf8[e] * nL[wid * 32 + i * 8 + e]; }
                qnL[wid * 64 + lane] = qn;
            }
            __syncthreads();
            f32x4 numT[4];
#pragma unroll
            for (int tt = 0; tt < 4; ++tt) numT[tt] = (f32x4){0.f, 0.f, 0.f, 0.f};
#pragma unroll
            for (int g = 0; g < NG; ++g) {
                const bf16x8 Ac = pack8(Cst[g][0], Cst[g][1]);
#pragma unroll
                for (int tt = 0; tt < 4; ++tt) {
                    const bf16x8 Bq = *(LAS const bf16x8*)(lds + OFF_QA + (tt * 16 + m16) * QS + (kh * (DK / 2) + g * 32 + quad * 8) * 2);
                    numT[tt] = __builtin_amdgcn_mfma_f32_16x16x32_bf16(Ac, Bq, numT[tt], 0, 0, 0);
                }
            }
            if (ML) {
#pragma unroll
                for (int tt = 0; tt < 4; ++tt) { const float wi = __expf(mrun - fmaxf(mrun, mxL[tt * 16 + m16])); numT[tt] = numT[tt] * wi; }
            }
            {
                const bf16x8 Av = *(LAS const bf16x8*)(lds + OFF_VT + (dt * 16 + m16) * VS + (kh * 32 + quad * 8) * 2);
#pragma unroll
                for (int tt = 0; tt < 4; ++tt) {
                    const bf16x8 Bp = *(LAS const bf16x8*)(lds + OFF_PT + ((kh * 4 + tt) * 64 + lane) * 16);
                    numT[tt] = __builtin_amdgcn_mfma_f32_16x16x32_bf16(Av, Bp, numT[tt], 0, 0, 0);
                }
            }
            {
                f32x4 Ust[NG][2];
#pragma unroll
                for (int g = 0; g < NG; ++g) { Ust[g][0] = (f32x4){0.f, 0.f, 0.f, 0.f}; Ust[g][1] = (f32x4){0.f, 0.f, 0.f, 0.f}; }
#pragma unroll
                for (int k2 = 0; k2 < 2; ++k2) {
                    const bf16x8 Bv = *(LAS const bf16x8*)(lds + OFF_VT + (dt * 16 + m16) * VS + (k2 * 32 + quad * 8) * 2);
#pragma unroll
                    for (int g = 0; g < NG; ++g)
#pragma unroll
                        for (int T = 0; T < 2; ++T) {
                            const bf16x8 Ak = *(LAS const bf16x8*)(lds + OFF_KBT + (kh * (DK / 2) + g * 32 + T * 16 + m16) * VS + (k2 * 32 + quad * 8) * 2);
                            Ust[g][T] = __builtin_amdgcn_mfma_f32_16x16x32_bf16(Ak, Bv, Ust[g][T], 0, 0, 0);
                        }
                }
                if (ML) {
                    const float mm = fmaxf(mrun, ae), wold = __expf(mrun - mm), cs = __expf(ae - mm);
#pragma unroll
                    for (int g = 0; g < NG; ++g) { Cst[g][0] = Cst[g][0] * wold + Ust[g][0] * cs; Cst[g][1] = Cst[g][1] * wold + Ust[g][1] * cs; }
                } else {
#pragma unroll
                    for (int g = 0; g < NG; ++g)
#pragma unroll
                        for (int T = 0; T < 2; ++T) { const f32x4 d4 = *(LAS const f32x4*)(decL + kh * (DK / 2) + g * 32 + quad * 8 + T * 4); Cst[g][T] = Cst[g][T] * d4 + Ust[g][T]; }
                }
            }
            XL[(dt * 4 + (1 - kh) * 2 + 0) * 64 + lane] = numT[(1 - kh) * 2 + 0];
            XL[(dt * 4 + (1 - kh) * 2 + 1) * 64 + lane] = numT[(1 - kh) * 2 + 1];
            __syncthreads();
            const bool want_out = ML || ci >= 4;
            if (want_out) {
#pragma unroll
                for (int q2 = 0; q2 < 2; ++q2) {
                    const int tt = kh * 2 + q2, t = tt * 16 + m16;
                    f32x4 v = (kh ? numT[2 + q2] : numT[q2]) + XL[(dt * 4 + tt) * 64 + lane];
                    if (ML) {
                        const float Mtt = fmaxf(mrun, mxL[t]), wi = __expf(mrun - Mtt);
                        float qn = 0.f;
#pragma unroll
                        for (int pp = 0; pp < 8; ++pp) qn += qnL[pp * 64 + t];
                        const float den = wi * qn + rsL[t] + rsL[64 + t];
                        v = v * (1.f / fmaxf(fabsf(den), __expf(-(bL[t] + Mtt))));
                    }
                    u32x2 o; o.x = pk2(v[0], v[1]); o.y = pk2(v[2], v[3]);
                    *(u32x2*)(HS + ((size_t)dir * MTOT + row0 + t) * D + h * 256 + sl * 64 + dt * 16 + quad * 4) = o;
                }
            }
            if (ML) {
                const float mm = fmaxf(mrun, ae), wold = __expf(mrun - mm), cs = __expf(ae - mm);
                __syncthreads();
                if (tid < 256) {
                    const int rho = (tid & ~31) + ((tid >> 2) & 1) * 16 + ((tid >> 3) & 3) * 4 + (tid & 3);
                    float sm = 0.f;
#pragma unroll
                    for (int i = 0; i < 8; ++i) { float kf8[8]; unpack8(*(LAS const u32x4*)(lds + OFF_KBT + rho * VS + i * 16), kf8);
#pragma unroll
                        for (int e = 0; e < 8; ++e) sm += kf8[e]; }
                    nL[tid] = wold * nL[tid] + cs * sm;
                }
                mrun = be + mm;
            }
            __syncthreads();
        }
    }
}

__device__ __forceinline__ bool phase_exists(int ph) {
    if (ph == 0 || ph == 49) return true;
    const int l = (ph - 1) / 12, k = (ph - 1) % 12;
    if (k == 6 || k == 7) return (l & 1) != 0;
    return true;
}
template <class Epi>
__device__ __forceinline__ void run_gemm(LAS unsigned char* lds, const bf16_t* A, const bf16_t* Bt, int M, int N, int K, const Epi& E) {
    pg8::Gemm g; g.A = A; g.Bt = Bt; g.M = M; g.N = N; g.K = K; g.Kc = K;
    pg8::StaticOrder S; S.init(M, N, K, (int)GDIM(), (int)BID());
    pg8::gemm_phase<Epi, pg8::StaticOrder, true, true>(lds, g, S, E);
}
static_assert((WS_DP - WS_H) / 4 == (size_t)pg8::DPOFF && (WS_DP - WS_H) % 4 == 0, "DPOFF");
__device__ __forceinline__ void run_resid_gemm(LAS unsigned char* lds, const bf16_t* A, const bf16_t* Bt, int Mr, int K, float* H, const float* gate) {
    pg8::EpiResid E; E.H = H; E.gate = gate;
    pg8::Gemm g; g.A = A; g.Bt = Bt; g.M = Mr; g.N = D; g.K = K; g.Kc = K;
    pg8::ResidOrder S; S.init(K, Mr == MTOT ? 1 : 0, (int)GDIM(), (int)BID());
    pg8::gemm_phase<pg8::EpiResid, pg8::ResidOrder, true, true>(lds, g, S, E);
}
__device__ void run_phase(const Args& a, int ph, LAS unsigned char* lds) {
    unsigned char* ws = a.ws; asm volatile("" : "+s"(ws));
    float* H = (float*)(ws + WS_H); bf16_t* U = (bf16_t*)(ws + WS_U); bf16_t* P = (bf16_t*)(ws + WS_P); float* G32 = (float*)(ws + WS_G32);
    bf16_t* QC = (bf16_t*)(ws + WS_QC); bf16_t* KC = (bf16_t*)(ws + WS_KC); bf16_t* HS = (bf16_t*)(ws + WS_HS); bf16_t* KBT = (bf16_t*)(ws + WS_KBT); const bf16_t* VTb = (const bf16_t*)(ws + WS_VT); unsigned char* scb = ws + WS_SC;
    if (ph == 0) { p0_prologue(a, lds); return; }
    if (ph == 49) { final_norm_phase(H, a.in[I_FINALG], a.out); return; }
    const int l = (ph - 1) / 12, k = (ph - 1) % 12;
    const float* modl = (const float*)(ws + WS_MOD) + (size_t)l * 9 * MODLD;
    const float* ng = a.in[I_NORMG] + (size_t)l * 3 * D;
    switch (k) {
    case 0: norm_phase(H, ng, modl, 0, U, MTOT, l > 0 ? (const float*)(ws + WS_DP) : nullptr); break;
    case 1: case 10: { const int f = k == 10 ? 1 : 0; pg8::EpiSwiglu E; E.O = P; E.ldc = DFF; run_gemm(lds, U, (const bf16_t*)(ws + WS_W13T + (size_t)(l * 2 + f) * W13T_SZ), (l == 3 && f == 1) ? MLAT : MTOT, 2 * DFF, D, E); } break;
    case 2: case 8: case 11: {
        const int Mr = (l == 3 && k >= 8) ? MLAT : MTOT;
        const bf16_t* A = k == 8 ? U : P; const int K = k == 8 ? D : DFF;
        const bf16_t* Bt = (const bf16_t*)(ws + (k == 8 ? WS_WO + (size_t)l * D * D * 2 : WS_W2T + (size_t)(l * 2 + (k == 11 ? 1 : 0)) * W2T_SZ));
        run_resid_gemm(lds, A, Bt, Mr, K, H, modl + (k == 2 ? 2 : k == 8 ? 5 : 8) * D);
    } break;
    case 3: norm_phase(H, ng + D, modl, 3, U, MTOT, (const float*)(ws + WS_DP)); break;
    case 4: {
        const size_t woff = l == 0 ? WS_WIN0 : l == 1 ? WS_WIN1 : l == 2 ? WS_WIN2 : WS_WIN3;
        if (l == 2 || l == 0) { pg8::EpiProjAttn E; E.P = P; E.VT = (bf16_t*)(ws + WS_VT); E.R = (const float*)(ws + WS_ROPE); E.rope = l == 2 ? 1 : 0; run_gemm(lds, U, (const bf16_t*)(ws + woff), MTOT, 3072, D, E); }
        else { pg8::EpiProj E; E.P = P; E.G32 = G32; E.ldc = NPAD_IN[l]; E.gcol0 = l == 1 ? 2048 : (l == 3 ? 1536 : 1 << 30); E.gn = l == 1 ? 16 : 32; E.VT = (bf16_t*)(ws + WS_VT); E.vcol0 = l == 1 ? 1024 : (l == 3 ? 512 : 1 << 30);
            run_gemm(lds, U, (const bf16_t*)(ws + woff), MTOT, NPAD_IN[l], D, E); }
    } break;
    case 5:
        if (l == 0) na_mfma_phase(P, VTb, a.in[I_NARPB], U);
        else if (l == 1) ml_prep2_phase(P, G32, a.in[I_MLGB], a.in[I_MLCONV], QC, KC, KBT, scb, lds);
        else if (l == 2) da_flash_phase(P, (const bf16_t*)(ws + WS_VT), a.in[I_DALAM], a.in[I_DANG], U, lds);
        else gla_prep2_phase(P, G32, a.in[I_GLAGU], a.in[I_GLABG], QC, KC, KBT, scb, lds);
        break;
    case 6:
        if (l == 1) chunk_scan_phase<256, true>(QC, KC, 0, KBT, VTb, scb, HS, lds);
        else if (l == 3) chunk_scan_phase<128, false>(QC, KC, (size_t)MTOT * 512, KBT, VTb, scb, HS, lds);
        break;
    case 7:
        if (l == 1) ml_readout_phase(P, HS, a.in[I_MLNG], U);
        else if (l == 3) gla_readout_phase(P, HS, a.in[I_GLANG], U);
        break;
    case 9: norm_phase(H, ng + 2 * D, modl, 6, U, l == 3 ? MLAT : MTOT, (const float*)(ws + WS_DP)); break;
    }
}


#define XB_TMO      128
#define XB_XCNT(j)  (256  + 64 * (j))
#define XB_XSUB(j)  (1280 + 64 * (j))
#define XB_XGEN(j)  (2304 + 64 * (j))
#define XB_TOP      3328
#define XB_TOPGEN   3392
#define XCD_BAR_WORDS 3456
#define XB_SPIN_CAP (1u << 18)

__device__ __forceinline__ unsigned xb_ld(unsigned* p)              { return __hip_atomic_load(p, __ATOMIC_RELAXED, __HIP_MEMORY_SCOPE_AGENT); }
__device__ __forceinline__ unsigned xb_add(unsigned* p, unsigned v) { return __hip_atomic_fetch_add(p, v, __ATOMIC_RELAXED, __HIP_MEMORY_SCOPE_AGENT); }
__device__ __forceinline__ unsigned xb_xcc_id() { return (unsigned)__builtin_amdgcn_s_getreg((3 << 11) | 20) & 0xFu; }
#define XB_SPIN(cond, bar) do { unsigned _sp = 0; while (cond) { __builtin_amdgcn_s_sleep(1); \
    if ((++_sp & 255u) == 0u) { if (xb_ld(&(bar)[XB_TMO])) break; if (_sp > XB_SPIN_CAP) { atomicAdd(&(bar)[XB_TMO], 1u); break; } } } } while (0)

struct XcdBarrier {
    unsigned* bar; unsigned x;
    volatile LAS unsigned* st;
};

__device__ __forceinline__ XcdBarrier xcd_barrier_post(unsigned* bar, volatile LAS unsigned* st) {
    XcdBarrier b; b.bar = bar; b.x = xb_xcc_id(); b.st = st;
    if (threadIdx.x == 0) (void)xb_add(&bar[XB_XCNT(b.x)], 1u);
    return b;
}
__device__ __forceinline__ void xcd_barrier_complete(unsigned* bar, unsigned x, unsigned& nloc, unsigned& nx) {
    const unsigned G = gridDim.x * gridDim.y * gridDim.z;
    unsigned sum, cnt, mine, sp = 0u;
    for (;;) {
        sum = 0u; cnt = 0u; mine = 0u;
#pragma unroll
        for (unsigned j = 0; j < 16; ++j) { const unsigned c = xb_ld(&bar[XB_XCNT(j)]); sum += c; cnt += (c > 0u) ? 1u : 0u; mine = (j == x) ? c : mine; }
        if (sum == G) break;
        __builtin_amdgcn_s_sleep(1);
        if ((++sp & 255u) == 0u) { if (xb_ld(&bar[XB_TMO])) break; if (sp > XB_SPIN_CAP) { atomicAdd(&bar[XB_TMO], 1u); break; } }
    }
    nloc = mine > 0u ? mine : 1u; nx = cnt > 0u ? cnt : 1u;
}

__device__ __forceinline__ void xcd_barrier(const XcdBarrier& b) {
    asm volatile("s_waitcnt vmcnt(0)" ::: "memory");
    __syncthreads();
    if (threadIdx.x == 0) {
        unsigned* bar = b.bar;
        __builtin_amdgcn_s_waitcnt(0);
        unsigned nloc = b.st[0], nx = b.st[1];
        if (nloc == 0u) { xcd_barrier_complete(bar, b.x, nloc, nx); b.st[0] = nloc; b.st[1] = nx; }
        const unsigned old = xb_add(&bar[XB_XSUB(b.x)], 1u);
        const unsigned gen = old / nloc;
        if (old + 1u == (gen + 1u) * nloc) {
            __builtin_amdgcn_fence(__ATOMIC_RELEASE, "agent");
            asm volatile("s_waitcnt vmcnt(0)" ::: "memory");
            const unsigned og = xb_add(&bar[XB_TOP], 1u);
            const unsigned tg = og / nx;
            if (og + 1u == (tg + 1u) * nx) xb_add(&bar[XB_TOPGEN], 1u);
            else XB_SPIN(xb_ld(&bar[XB_TOPGEN]) == tg, bar);
            __builtin_amdgcn_fence(__ATOMIC_ACQUIRE, "agent");
            xb_add(&bar[XB_XGEN(b.x)], 1u);
            asm volatile("s_waitcnt vmcnt(0)" ::: "memory");
        } else {
            XB_SPIN(xb_ld(&bar[XB_XGEN(b.x)]) == gen, bar);
            __builtin_amdgcn_fence(__ATOMIC_ACQUIRE, "agent");
            asm volatile("s_waitcnt vmcnt(0)" ::: "memory");
        }
    }
    __syncthreads();
}

constexpr int LDS_BYTES = 135168;
__global__ void __launch_bounds__(512) mega(Args a) {
    extern __shared__ __attribute__((aligned(16))) unsigned char lds_raw[];
    LAS unsigned char* lds = (LAS unsigned char*)lds_raw;
    cg::grid_group grid = cg::this_grid();
    volatile LAS unsigned* xbst = (volatile LAS unsigned*)(lds + LDS_BYTES - 16);
    if (threadIdx.x == 0) { xbst[0] = 0u; xbst[1] = 0u; }
    __syncthreads();
    const XcdBarrier xb = xcd_barrier_post((unsigned*)(a.ws + WS_BAR), xbst);
    int nsync = 0;
    for (int ph = a.ph_lo; ph < a.ph_hi; ++ph) {
        if (!phase_exists(ph)) continue;
        if (nsync == 1) grid.sync();
        else if (nsync > 1) xcd_barrier(xb);
        ++nsync;
        run_phase(a, ph, lds);
        __syncthreads();
    }
}

extern "C" void kernel_launch(void* const* d_in, const int* in_sizes, int n_in, void* d_out, int out_size,
                              void* d_ws, size_t ws_size, hipStream_t stream) {
    static int grid = 0;
    if (grid == 0) {
        int dev = 0, cus = 0, per_cu = 0;
        (void)hipGetDevice(&dev);
        (void)hipDeviceGetAttribute(&cus, hipDeviceAttributeMultiprocessorCount, dev);
        (void)hipFuncSetAttribute((const void*)mega, hipFuncAttributeMaxDynamicSharedMemorySize, LDS_BYTES);
        (void)hipOccupancyMaxActiveBlocksPerMultiprocessor(&per_cu, (const void*)mega, 512, LDS_BYTES);
        grid = cus > 0 ? cus : 256;
        if (n_in != N_IN || ws_size < WS_END) { fprintf(stderr, "kernel_launch: n_in %d ws %zu (need %zu)\n", n_in, ws_size, (size_t)WS_END); }
    }
    (void)hipMemsetAsync((unsigned char*)d_ws + WS_BAR, 0, 16384, stream);
    Args a{};
    for (int i = 0; i < N_IN; ++i) a.in[i] = (const float*)d_in[i];
    a.out = (float*)d_out; a.ws = (unsigned char*)d_ws; a.ph_lo = 0; a.ph_hi = 50;
    void* args[] = {&a};
    hipError_t e = hipLaunchCooperativeKernel((const void*)mega, dim3(grid), dim3(512), args, LDS_BYTES, stream);
    if (e != hipSuccess) fprintf(stderr, "cooperative launch failed: %s\n", hipGetErrorString(e));
}
```

```cpp
#include <hip/hip_runtime.h>
#include <hip/hip_cooperative_groups.h>
#include <cstdio>
#include <cstdint>
__device__ __forceinline__ int TID() { int t = threadIdx.x; asm volatile("" : "+v"(t)); return t; }
__device__ __forceinline__ int GDIM() { int t = gridDim.x; asm volatile("" : "+s"(t)); return t; }
__device__ __forceinline__ float shx(float v, int o) { const int lane = TID() & 63; return __builtin_bit_cast(float, __builtin_amdgcn_ds_bpermute((lane ^ o) << 2, __builtin_bit_cast(int, v))); }
__device__ __forceinline__ float rdl(float v, int src) { return __builtin_bit_cast(float, __builtin_amdgcn_readlane(__builtin_bit_cast(int, v), src)); }
__device__ __forceinline__ int BID() { int t = blockIdx.x; asm volatile("" : "+s"(t)); return t; }
namespace pg8 {
#define PG8_LAS __attribute__((address_space(3)))
typedef unsigned short bf16_t;
typedef short bf16x8 __attribute__((ext_vector_type(8)));
typedef float f32x4 __attribute__((ext_vector_type(4)));
typedef unsigned u32x4 __attribute__((ext_vector_type(4)));
constexpr int BM = 256, BK = 64, HALF = 128, HTB = HALF * BK * 2  , STAGE_BYTES = 8 * HTB, NXCD = 8, WGM = 8;

__host__ __device__ __forceinline__ int lds_byte(int r, int c) { const int st = (r >> 4) * 2 + (c >> 5), rr = r & 15, cc = c & 31, ob = rr * 64 + cc * 2; return st * 1024 + (ob ^ (((ob >> 9) & 1) << 5)); }
__host__ __device__ __forceinline__ void stage_rc(int b, int& R, int& C) { const int st = b / 1024, sb = b % 1024, swz = sb ^ (((sb >> 9) & 1) << 5); R = (st >> 1) * 16 + swz / 64; C = (st & 1) * 32 + (swz % 64) / 2; }
__host__ __device__ __forceinline__ int perm32(int rho) { const int n = rho >> 4, i = rho & 15; return 8 * (i >> 2) + 4 * n + (i & 3); }

struct Unit { int pm, pn, k0t, nt, sp; };
struct Gemm { const bf16_t* A; const bf16_t* Bt; int M, N, K, Kc; };

struct StaticOrder {
    int nM, nN, nwg, G, c, ntk;
    __host__ __device__ void init(int M, int N, int K, int G_, int c_) { nM = M / BM; nN = N / BM; nwg = nM * nN; G = G_; c = c_; ntk = K / BK; }
    __host__ __device__ bool next(int i, Unit& u) const {
        const long L = (long)i * G + c; if (L >= nwg) return false;
        u.k0t = 0; u.nt = ntk; u.sp = 0;
        int wgid = (int)L; { const int q = nwg / NXCD, r = nwg % NXCD, xcd = wgid % NXCD, off = wgid / NXCD; wgid = (xcd < r ? xcd * (q + 1) : r * (q + 1) + (xcd - r) * q) + off; }
        const int nig = WGM * nN, gid = wgid / nig, fm = gid * WGM, gsz = (nM - fm) < WGM ? (nM - fm) : WGM;
        u.pm = fm + ((wgid % nig) % gsz); u.pn = (wgid % nig) / gsz; return true;
    }
    __device__ __forceinline__ void a_ready(const Unit&) const {}
    __device__ __forceinline__ void done(const Unit&) const {}
};

struct ResidOrder {
    StaticOrder lat; int nctx, ntk, G, c;
    __host__ __device__ void init(int K, int with_ctx, int G_, int c_) { lat.init(16384, 1024, K, G_, c_); nctx = with_ctx ? 128 : 0; ntk = K / BK; G = G_; c = c_; }
    __host__ __device__ bool next(int i, Unit& u) const {
        Unit a; a.pm = 0; a.pn = 0; a.k0t = 0; a.nt = ntk; a.sp = 0;
        const bool is_lat = lat.next(i, a);
        const long L = (long)i * G + c - lat.nwg;
        const int j = (int)L, sp = j & 3, tile = j >> 2;
        const int q4 = (ntk / 4) & ~1, big = (ntk - 4 * q4) / 2;
        const int e0 = 2 * (int)(big > 0), e2 = 2 * (int)(big > 1);
        const int cnt = q4 + e0 * (int)(sp == 0) + e2 * (int)(sp == 2), ck0 = sp * q4 + e0 * (int)(sp >= 1) + e2 * (int)(sp >= 3);
        u.pm = is_lat ? a.pm : 64 + (tile >> 2); u.pn = is_lat ? a.pn : (tile & 3); u.sp = is_lat ? 0 : sp; u.nt = is_lat ? ntk : cnt; u.k0t = is_lat ? 0 : ck0;
        return is_lat || L < nctx;
    }
    __device__ __forceinline__ void a_ready(const Unit&) const {}
    __device__ __forceinline__ void done(const Unit&) const {}
};

__device__ __forceinline__ unsigned cvt_pk_bf16(float lo, float hi) { unsigned r; asm volatile("v_cvt_pk_bf16_f32 %0, %1, %2" : "=v"(r) : "v"(lo), "v"(hi)); return r; }
typedef unsigned u32x2 __attribute__((ext_vector_type(2)));
__device__ __forceinline__ float silu_f(float x) { return x / (1.f + __expf(-x)); }
struct EpiSwiglu {
    static constexpr bool PERM = true, AFTER_DRAIN = false;
    bf16_t* O; int ldc;
    __device__ __forceinline__ void operator()(const f32x4 (&acc)[2][2][4][2], const Unit& u, int wr, int wc, int fr, int fq) const {
        const int row0 = u.pm * BM + wr * 64 + fr, col0 = u.pn * HALF + wc * 32 + 8 * fq;
#pragma unroll
        for (int ai = 0; ai < 2; ++ai)
#pragma unroll
            for (int m = 0; m < 4; ++m) {
                bf16_t* rowp = O + (size_t)(row0 + ai * HALF + m * 16) * ldc + col0;
                const f32x4 g0 = acc[ai][0][m][0], g1 = acc[ai][0][m][1], u0 = acc[ai][1][m][0], u1 = acc[ai][1][m][1];
                u32x4 w;
                w.x = cvt_pk_bf16(silu_f(g0[0]) * u0[0], silu_f(g0[1]) * u0[1]);
                w.y = cvt_pk_bf16(silu_f(g0[2]) * u0[2], silu_f(g0[3]) * u0[3]);
                w.z = cvt_pk_bf16(silu_f(g1[0]) * u1[0], silu_f(g1[1]) * u1[1]);
                w.w = cvt_pk_bf16(silu_f(g1[2]) * u1[2], silu_f(g1[3]) * u1[3]);
                *(u32x4*)rowp = w;
            }
    }
};
constexpr long DPOFF = 116195328;
struct EpiResid {
    static constexpr bool PERM = false, AFTER_DRAIN = false;
    float* H; const float* gate;
    __device__ __forceinline__ void operator()(const f32x4 (&acc)[2][2][4][2], const Unit& u, int wr, int wc, int fr, int fq) const {
        const int mrow = u.pm < 64 ? (u.pm >> 3) : 8;
        const float* gp = gate + (size_t)mrow * 9216; float* DP = H + DPOFF;
        const int row0 = u.pm * BM + wr * 64 + fr, col0 = u.pn * BM + wc * 32 + 4 * fq;
#pragma unroll
        for (int bj = 0; bj < 2; ++bj)
#pragma unroll
            for (int n = 0; n < 2; ++n) {
                const int col = col0 + bj * HALF + n * 16;
                const f32x4 g = *(const f32x4*)(gp + col);
#pragma unroll
                for (int ai = 0; ai < 2; ++ai)
#pragma unroll
                    for (int m = 0; m < 4; ++m) {
                        float* hp = H + (size_t)(row0 + ai * HALF + m * 16) * 1024 + col;
                        const f32x4 d = g * acc[ai][bj][m][n];
                        if (u.sp) *(f32x4*)(DP + ((size_t)(u.sp - 1) * 2048 + (row0 + ai * HALF + m * 16 - 16384)) * 1024 + col) = d;
                        else { f32x4 h = *(const f32x4*)hp; h = h + d; *(f32x4*)hp = h; }
                    }
            }
    }
};
struct EpiProj {
    static constexpr bool PERM = true, AFTER_DRAIN = false;
    bf16_t* P; int ldc; float* G32; int gcol0, gn; bf16_t* VT; int vcol0;
    __device__ __forceinline__ void operator()(const f32x4 (&acc)[2][2][4][2], const Unit& u, int wr, int wc, int fr, int fq) const {
        const int row0 = u.pm * BM + wr * 64 + fr, col0 = u.pn * BM + wc * 32 + 8 * fq;
#pragma unroll
        for (int bj = 0; bj < 2; ++bj) {
            const int col = col0 + bj * HALF;
            const bool gs = (col >= gcol0) && (col < gcol0 + gn);
            const bool vs = (col >= vcol0) && (col < vcol0 + 1024);
#pragma unroll
            for (int ai = 0; ai < 2; ++ai)
#pragma unroll
                for (int m = 0; m < 4; ++m) {
                    const size_t row = (size_t)(row0 + ai * HALF + m * 16);
                    const f32x4 v0 = acc[ai][bj][m][0], v1 = acc[ai][bj][m][1];
                    u32x4 w; w.x = cvt_pk_bf16(v0[0], v0[1]); w.y = cvt_pk_bf16(v0[2], v0[3]); w.z = cvt_pk_bf16(v1[0], v1[1]); w.w = cvt_pk_bf16(v1[2], v1[3]);
                    *(u32x4*)(P + row * ldc + col) = w;
                    if (gs) { float* gp = G32 + row * 32 + (col - gcol0); *(f32x4*)gp = v0; *(f32x4*)(gp + 4) = v1; }
                    if (vs) { bf16_t* vp = VT + (size_t)(col - vcol0) * 18432 + row;
                        vp[0] = (bf16_t)(w.x & 0xffffu); vp[18432] = (bf16_t)(w.x >> 16); vp[2 * 18432] = (bf16_t)(w.y & 0xffffu); vp[3 * 18432] = (bf16_t)(w.y >> 16);
                        vp[4 * 18432] = (bf16_t)(w.z & 0xffffu); vp[5 * 18432] = (bf16_t)(w.z >> 16); vp[6 * 18432] = (bf16_t)(w.w & 0xffffu); vp[7 * 18432] = (bf16_t)(w.w >> 16); }
                }
        }
    }
};

struct EpiProjAttn {
    static constexpr bool PERM = false, AFTER_DRAIN = false;
    bf16_t* P; bf16_t* VT; const float* R; int rope;
    __device__ __forceinline__ void operator()(const f32x4 (&acc)[2][2][4][2], const Unit& u, int wr, int wc, int fr, int fq) const {
        const int sec = u.pn >> 2;
        const int row0 = u.pm * BM + wr * 64 + fr, col0 = u.pn * BM + wc * 32 + 4 * fq;
        if (sec == 1) {
#pragma unroll
            for (int ai = 0; ai < 2; ++ai)
#pragma unroll
                for (int m = 0; m < 4; ++m) {
                    const int row = row0 + ai * HALF + m * 16;
#pragma unroll
                    for (int bj = 0; bj < 2; ++bj)
#pragma unroll
                        for (int n = 0; n < 2; ++n) {
                            const int col = col0 + bj * HALF + n * 16 - 1024;
                            const f32x4 v = acc[ai][bj][m][n];
#pragma unroll
                            for (int e = 0; e < 4; ++e) VT[(size_t)(col + e) * 18432 + row] = (bf16_t)(cvt_pk_bf16(v[e], 0.f) & 0xffffu);
                        }
                }
            return;
        }
        const float sc = sec == 2 ? 0.125f : 1.f;
        const bool do_rope = rope && u.pm < 64;
        const int axis = wc & 1;
#pragma unroll
        for (int ai = 0; ai < 2; ++ai)
#pragma unroll
            for (int m = 0; m < 4; ++m) {
                const int row = row0 + ai * HALF + m * 16;
                f32x4 cs = (f32x4){1.f, 1.f, 1.f, 1.f}, sn = (f32x4){0.f, 0.f, 0.f, 0.f};
                if (do_rope) { const int t = row & 2047, pos = axis ? (t & 63) : (t >> 6); cs = *(const f32x4*)(R + pos * 16 + 4 * fq); sn = *(const f32x4*)(R + 1024 + pos * 16 + 4 * fq); }
#pragma unroll
                for (int bj = 0; bj < 2; ++bj) {
                    const f32x4 x1 = acc[ai][bj][m][0] * sc, x2 = acc[ai][bj][m][1] * sc;
                    const f32x4 y1 = x1 * cs - x2 * sn, y2 = x2 * cs + x1 * sn;
                    bf16_t* pp = P + (size_t)row * 3072 + col0 + bj * HALF;
                    u32x2 o1, o2; o1.x = cvt_pk_bf16(y1[0], y1[1]); o1.y = cvt_pk_bf16(y1[2], y1[3]); o2.x = cvt_pk_bf16(y2[0], y2[1]); o2.y = cvt_pk_bf16(y2[2], y2[3]);
                    *(u32x2*)pp = o1; *(u32x2*)(pp + 16) = o2;
                }
            }
    }
};

template <class Epi, class Sched, bool ALIGN_EPI = false, bool SP2 = false>
__device__ __forceinline__ void gemm_phase(PG8_LAS unsigned char* lds, const Gemm g, const Sched& S, const Epi& E) {
    const int tid = TID(), wid = __builtin_amdgcn_readfirstlane(tid >> 6), lane = tid & 63, wr = wid >> 2, wc = wid & 3, fr = lane & 15, fq = lane >> 4;
    const int K = g.K;
    unsigned voffA[2], voffB[2];
#pragma unroll
    for (int i = 0; i < 2; ++i) { int R, C; stage_rc(tid * 16 + i * 8192, R, C); const int Rb = Epi::PERM ? ((R & ~31) + perm32(R & 31)) : R;
        voffA[i] = (unsigned)(R * K + C) * 2u; voffB[i] = (unsigned)(Rb * K + C) * 2u; }
    const size_t kstep = (size_t)(BK * 2);
    const size_t hstep = (size_t)HALF * K * 2;
    const size_t tstep = 2 * hstep;
    const unsigned ldsw = (unsigned)wid * 1024u;
    const int aoff = lds_byte(wr * 64 + fr, fq * 8), boff = lds_byte(wc * 32 + fr, fq * 8);
#define PG8_SA(b, h) (((b) * 2 + (h)) * HTB)
#define PG8_SB(b, h) ((4 + (b) * 2 + (h)) * HTB)
#define PG8_STAGE(bufoff, gbase, voff) do { _Pragma("unroll") for (int _i = 0; _i < 2; ++_i) \
        __builtin_amdgcn_global_load_lds((const unsigned*)((const char*)(gbase) + (voff)[_i]), (PG8_LAS unsigned*)(lds + (bufoff) + ldsw + _i * 8192), 16, 0, 0); } while (0)
#define PG8_LDA(dst, b, h) do { _Pragma("unroll") for (int m = 0; m < 4; ++m) _Pragma("unroll") for (int k = 0; k < 2; ++k) dst[m][k] = *(const PG8_LAS bf16x8*)(lds + PG8_SA(b, h) + aoff + m * 2048 + k * 1024); } while (0)
#define PG8_LDB(dst, b, h) do { _Pragma("unroll") for (int n = 0; n < 2; ++n) _Pragma("unroll") for (int k = 0; k < 2; ++k) dst[n][k] = *(const PG8_LAS bf16x8*)(lds + PG8_SB(b, h) + boff + n * 2048 + k * 1024); } while (0)
#define PG8_MMA(ai, bj, At, Bt) do { __builtin_amdgcn_s_setprio(1); _Pragma("unroll") for (int m = 0; m < 4; ++m) _Pragma("unroll") for (int n = 0; n < 2; ++n) _Pragma("unroll") for (int k = 0; k < 2; ++k) \
        acc[ai][bj][m][n] = __builtin_amdgcn_mfma_f32_16x16x32_bf16(Bt[n][k], At[m][k], acc[ai][bj][m][n], 0, 0, 0); __builtin_amdgcn_s_setprio(0); } while (0)
#define PG8_WAIT_V(n) asm volatile("s_waitcnt vmcnt(" #n ")" ::: "memory")
#define PG8_WAIT_L(n) asm volatile("s_waitcnt lgkmcnt(" #n ")" ::: "memory")
#define PG8_BAR __builtin_amdgcn_s_barrier()
#define PG8_SCHED __builtin_amdgcn_sched_barrier(0)
    Unit cur, nxt; int ui = 0;
    if (!S.next(0, cur)) return;
    f32x4 acc[2][2][4][2];
#pragma unroll
    for (int a = 0; a < 2; ++a)
#pragma unroll
        for (int b = 0; b < 2; ++b)
#pragma unroll
            for (int m = 0; m < 4; ++m)
#pragma unroll
                for (int n = 0; n < 2; ++n) acc[a][b][m][n] = (f32x4){0.f, 0.f, 0.f, 0.f};
    bf16x8 At[4][2], B0[2][2], B1[2][2];
    const char* cA = (const char*)g.A + (size_t)cur.pm * tstep + (size_t)cur.k0t * kstep; const char* cB = (const char*)g.Bt + (size_t)cur.pn * tstep + (size_t)cur.k0t * kstep;
    S.a_ready(cur);
    if constexpr (SP2) {
        PG8_STAGE(PG8_SB(0, 0), cB, voffB); PG8_STAGE(PG8_SB(0, 1), cB + hstep, voffB); PG8_STAGE(PG8_SA(0, 0), cA, voffA); PG8_STAGE(PG8_SA(0, 1), cA + hstep, voffA);
        if (wr == 1) PG8_BAR;
        PG8_WAIT_V(2); PG8_BAR;
        PG8_STAGE(PG8_SB(1, 0), cB + kstep, voffB); PG8_STAGE(PG8_SA(1, 0), cA + kstep, voffA); PG8_STAGE(PG8_SB(1, 1), cB + hstep + kstep, voffB);
        PG8_WAIT_V(6); PG8_BAR;
    } else {
        PG8_STAGE(PG8_SB(0, 0), cB, voffB); PG8_STAGE(PG8_SA(0, 0), cA, voffA); PG8_STAGE(PG8_SB(0, 1), cB + hstep, voffB); PG8_STAGE(PG8_SA(0, 1), cA + hstep, voffA);
        if (wr == 1) PG8_BAR;
        PG8_WAIT_V(4); PG8_BAR;
        PG8_STAGE(PG8_SB(1, 0), cB + kstep, voffB); PG8_STAGE(PG8_SA(1, 0), cA + kstep, voffA); PG8_STAGE(PG8_SB(1, 1), cB + hstep + kstep, voffB);
        PG8_WAIT_V(6); PG8_BAR;
    }
    for (;;) {
        const bool has_next = S.next(ui + 1, nxt);
        const char* nA = has_next ? (const char*)g.A + (size_t)nxt.pm * tstep + (size_t)nxt.k0t * kstep : cA; const char* nB = has_next ? (const char*)g.Bt + (size_t)nxt.pn * tstep + (size_t)nxt.k0t * kstep : cB;
        const int nt = cur.nt;
        for (int t = 0; t < nt; t += 2) {
            const bool last = (t == nt - 2);
            const char* a1 = cA + (size_t)(t + 1) * kstep;
            const char* a2 = last ? nA : cA + (size_t)(t + 2) * kstep; const char* b2 = last ? nB : cB + (size_t)(t + 2) * kstep;
            const char* a3 = a2 + kstep; const char* b3 = b2 + kstep;
            if (last && has_next) S.a_ready(nxt);
            if constexpr (SP2) {
            PG8_LDB(B0, 0, 0); PG8_LDB(B1, 0, 1); PG8_SCHED; PG8_LDA(At, 0, 0); PG8_STAGE(PG8_SA(1, 1), a1 + hstep, voffA);
            PG8_WAIT_V(8); PG8_WAIT_L(0); PG8_BAR; PG8_MMA(0, 0, At, B0); PG8_MMA(0, 1, At, B1); PG8_BAR; PG8_SCHED;
            PG8_LDA(At, 0, 1); PG8_STAGE(PG8_SB(0, 0), b2, voffB); PG8_STAGE(PG8_SB(0, 1), b2 + hstep, voffB); PG8_STAGE(PG8_SA(0, 0), a2, voffA);
            PG8_WAIT_V(8); PG8_WAIT_L(0); PG8_BAR; PG8_MMA(1, 0, At, B0); PG8_MMA(1, 1, At, B1); PG8_BAR; PG8_SCHED;
            PG8_LDB(B0, 1, 0); PG8_LDB(B1, 1, 1); PG8_SCHED; PG8_LDA(At, 1, 0); PG8_STAGE(PG8_SA(0, 1), a2 + hstep, voffA);
            PG8_WAIT_V(8); PG8_WAIT_L(0); PG8_BAR; PG8_MMA(0, 0, At, B0); PG8_MMA(0, 1, At, B1); PG8_BAR; PG8_SCHED;
            PG8_LDA(At, 1, 1); PG8_STAGE(PG8_SB(1, 0), b3, voffB); PG8_STAGE(PG8_SB(1, 1), b3 + hstep, voffB); PG8_STAGE(PG8_SA(1, 0), a3, voffA);
            PG8_WAIT_V(8); PG8_WAIT_L(0); PG8_BAR; PG8_MMA(1, 0, At, B0); PG8_MMA(1, 1, At, B1); PG8_BAR; PG8_SCHED;
            } else {
            PG8_LDB(B0, 0, 0); PG8_SCHED; PG8_LDA(At, 0, 0); PG8_STAGE(PG8_SA(1, 1), a1 + hstep, voffA);
            PG8_WAIT_L(8); PG8_BAR; PG8_WAIT_L(0); PG8_MMA(0, 0, At, B0); PG8_BAR; PG8_SCHED;
            PG8_LDB(B1, 0, 1); PG8_STAGE(PG8_SB(0, 0), b2, voffB);
            PG8_BAR; PG8_WAIT_L(0); PG8_MMA(0, 1, At, B1); PG8_BAR;
            PG8_LDA(At, 0, 1); PG8_STAGE(PG8_SA(0, 0), a2, voffA);
            PG8_BAR; PG8_WAIT_L(0); PG8_MMA(1, 0, At, B0); PG8_BAR; PG8_SCHED;
            PG8_STAGE(PG8_SB(0, 1), b2 + hstep, voffB);
            PG8_WAIT_V(6); PG8_BAR; PG8_MMA(1, 1, At, B1); PG8_BAR;
            PG8_LDB(B0, 1, 0); PG8_SCHED; PG8_LDA(At, 1, 0); PG8_STAGE(PG8_SA(0, 1), a2 + hstep, voffA);
            PG8_WAIT_L(8); PG8_BAR; PG8_WAIT_L(0); PG8_MMA(0, 0, At, B0); PG8_BAR; PG8_SCHED;
            PG8_LDB(B1, 1, 1); PG8_STAGE(PG8_SB(1, 0), b3, voffB);
            PG8_BAR; PG8_WAIT_L(0); PG8_MMA(0, 1, At, B1); PG8_BAR;
            PG8_LDA(At, 1, 1); PG8_STAGE(PG8_SA(1, 0), a3, voffA);
            PG8_BAR; PG8_WAIT_L(0); PG8_MMA(1, 0, At, B0); PG8_BAR; PG8_SCHED;
            PG8_STAGE(PG8_SB(1, 1), b3 + hstep, voffB);
            PG8_WAIT_V(6); PG8_BAR; PG8_MMA(1, 1, At, B1); PG8_BAR;
            }
        }
        if constexpr (ALIGN_EPI) { if (wr == 0) PG8_BAR; }
        if constexpr (!Epi::AFTER_DRAIN) { E(acc, cur, wr, wc, fr, fq); S.done(cur); }
        if (!has_next) break;
#pragma unroll
        for (int a = 0; a < 2; ++a)
#pragma unroll
            for (int b = 0; b < 2; ++b)
#pragma unroll
                for (int m = 0; m < 4; ++m)
#pragma unroll
                    for (int n = 0; n < 2; ++n) acc[a][b][m][n] = (f32x4){0.f, 0.f, 0.f, 0.f};
        cur = nxt; cA = nA; cB = nB; ++ui;
        if constexpr (ALIGN_EPI) { if (wr == 1) PG8_BAR; }
    }
    PG8_WAIT_V(0);
    if constexpr (!ALIGN_EPI) { if (wr == 0) PG8_BAR; }
    PG8_BAR;
    if constexpr (Epi::AFTER_DRAIN) { E.fused(acc, cur, wr, wc, fr, fq, lds, wid, lane); S.done(cur); }
#undef PG8_SA
#undef PG8_SB
#undef PG8_STAGE
#undef PG8_LDA
#undef PG8_LDB
#undef PG8_MMA
#undef PG8_WAIT_V
#undef PG8_WAIT_L
#undef PG8_BAR
#undef PG8_SCHED
}
}
namespace cg = cooperative_groups;
typedef unsigned short bf16_t;
typedef float f32x4 __attribute__((ext_vector_type(4)));
typedef unsigned u32x4 __attribute__((ext_vector_type(4)));
typedef unsigned u32x2 __attribute__((ext_vector_type(2)));
#define LAS __attribute__((address_space(3)))

constexpr int D = 1024, NB = 8, SEQ = 2048, CTXL = 256, DFF = 2816;
constexpr int MLAT = NB * SEQ, MCTX = NB * CTXL, MTOT = MLAT + MCTX;
constexpr int MODLD = 9 * D;
enum { I_X = 0, I_C, I_CTX, I_CCTX, I_ADAW, I_ADAB, I_NORMG, I_W13, I_W2, I_FINALG, I_NAW, I_NARPB, I_NAWO, I_MLW, I_MLGB, I_MLCONV, I_MLNG, I_MLWO,
       I_DAW, I_DALAM, I_DANG, I_DAWO, I_GLAW, I_GLAGU, I_GLABG, I_GLANG, I_GLAWO, N_IN };
constexpr int NPAD_IN[4] = {3072, 4352, 3072, 3328};
constexpr int N_IN_REAL[4] = {3072, 4112, 3072, 3104};
constexpr size_t al256(size_t x) { return (x + 255) & ~(size_t)255; }
constexpr size_t WS_MOD = 0;
constexpr size_t WS_ROPE = al256(WS_MOD + (size_t)4 * 9 * MODLD * 4);
constexpr size_t WS_W13T = al256(WS_ROPE + 2 * 64 * 16 * 4);
constexpr size_t W13T_SZ = (size_t)2 * DFF * D * 2;
constexpr size_t WS_W2T = WS_W13T + 8 * W13T_SZ;
constexpr size_t W2T_SZ = (size_t)D * DFF * 2;
constexpr size_t WS_WIN0 = WS_W2T + 8 * W2T_SZ;
constexpr size_t WS_WIN1 = WS_WIN0 + (size_t)3072 * D * 2;
constexpr size_t WS_WIN2 = WS_WIN1 + (size_t)4352 * D * 2;
constexpr size_t WS_WIN3 = WS_WIN2 + (size_t)3072 * D * 2;
constexpr size_t WS_WO = WS_WIN3 + (size_t)3328 * D * 2;
constexpr size_t WS_H = WS_WO + (size_t)4 * D * D * 2;
constexpr size_t WS_U = WS_H + (size_t)MTOT * D * 4;
constexpr size_t WS_P = WS_U + (size_t)MTOT * D * 2;
constexpr size_t WS_G32 = WS_P + (size_t)MTOT * 4352 * 2;
constexpr size_t WS_QC = WS_G32 + (size_t)MTOT * 32 * 4;
constexpr size_t WS_KC = WS_QC + (size_t)MTOT * D * 2;
constexpr size_t WS_HS = WS_KC + (size_t)MTOT * D * 2;
constexpr size_t WS_VT = WS_HS + (size_t)2 * MTOT * D * 2;
constexpr size_t WS_KBT = WS_VT + (size_t)D * MTOT * 2;
constexpr size_t WS_SC = WS_KBT + (size_t)2 * D * MTOT * 2;
constexpr size_t SC_SA = 0, SC_SMX = (size_t)8 * MTOT * 4, SC_SB = (size_t)16 * MTOT * 4, SC_CE = (size_t)24 * MTOT * 4, SC_DEC = SC_CE + 65536;
constexpr size_t WS_DP = WS_KBT;
constexpr size_t WS_END = WS_SC + SC_DEC + (size_t)2 * 288 * 512 * 4;
constexpr size_t WS_BAR = WS_END;
static_assert(WS_BAR + 16384 <= (size_t)738197504, "workspace");

struct Args { const float* in[N_IN]; float* out; unsigned char* ws; int ph_lo, ph_hi; };

__device__ __forceinline__ unsigned f2bf(float f) { unsigned u = __builtin_bit_cast(unsigned, f); return (u + 0x7fffu + ((u >> 16) & 1u)) >> 16; }
__device__ __forceinline__ unsigned pk2(float lo, float hi) { return f2bf(lo) | (f2bf(hi) << 16); }
__device__ __forceinline__ float bf2f(unsigned short b) { return __builtin_bit_cast(float, (unsigned)b << 16); }
__device__ __forceinline__ float bflo(unsigned w) { return __builtin_bit_cast(float, w << 16); }
__device__ __forceinline__ float bfhi(unsigned w) { return __builtin_bit_cast(float, w & 0xffff0000u); }
__device__ __forceinline__ float wave_sum(float v) {
#pragma unroll
    for (int o = 1; o < 64; o <<= 1) v += shx(v, o);
    return v;
}
__device__ __forceinline__ float wave_max(float v) {
#pragma unroll
    for (int o = 1; o < 64; o <<= 1) v = fmaxf(v, shx(v, o));
    return v;
}
__device__ __forceinline__ float silu(float x) { return x / (1.f + __expf(-x)); }
__device__ __forceinline__ float sigmoidf_(float x) { return 1.f / (1.f + __expf(-x)); }
__device__ __forceinline__ float log_sigmoid(float x) { return fminf(x, 0.f) - log1pf(__expf(-fabsf(x))); }

struct WDesc { const float* src; bf16_t* dst; int K, N, Npad, perm, tiles; };
__device__ __forceinline__ WDesc get_wdesc(const Args& a, unsigned char* ws, int mi) {
    WDesc w;
    if (mi < 8) { w.src = a.in[I_W13] + (size_t)mi * D * 2 * DFF; w.dst = (bf16_t*)(ws + WS_W13T + mi * W13T_SZ); w.K = D; w.N = 2 * DFF; w.Npad = 2 * DFF; w.perm = 1; }
    else if (mi < 16) { const int j = mi - 8; w.src = a.in[I_W2] + (size_t)j * DFF * D; w.dst = (bf16_t*)(ws + WS_W2T + j * W2T_SZ); w.K = DFF; w.N = D; w.Npad = D; w.perm = 0; }
    else if (mi < 20) { const int j = mi - 16;
        w.src = a.in[j == 0 ? I_NAW : j == 1 ? I_MLW : j == 2 ? I_DAW : I_GLAW];
        w.dst = (bf16_t*)(ws + (j == 0 ? WS_WIN0 : j == 1 ? WS_WIN1 : j == 2 ? WS_WIN2 : WS_WIN3));
        w.K = D; w.N = j == 0 ? 3072 : j == 1 ? 4112 : j == 2 ? 3072 : 3104; w.Npad = j == 0 ? 3072 : j == 1 ? 4352 : j == 2 ? 3072 : 3328; w.perm = 0; }
    else { const int j = mi - 20; w.src = a.in[j == 0 ? I_NAWO : j == 1 ? I_MLWO : j == 2 ? I_DAWO : I_GLAWO]; w.dst = (bf16_t*)(ws + WS_WO + (size_t)j * D * D * 2); w.K = D; w.N = D; w.Npad = D; w.perm = 0; }
    w.tiles = (w.K / 64) * (w.Npad / 64);
    return w;
}
constexpr int TILES_W13 = 16 * 88, TILES_W2 = 44 * 16, TILES_WO = 256;
constexpr int TILES_TOTAL = 8 * TILES_W13 + 8 * TILES_W2 + 16 * (48 + 68 + 48 + 52) + 4 * TILES_WO;

__device__ void p0_prologue(const Args& a, LAS unsigned char* lds) {
    const int tid = TID(), lane = tid & 63, wid = tid >> 6;
    unsigned char* ws = a.ws; asm volatile("" : "+s"(ws));
    {
        LAS float* S = (LAS float*)lds;
        LAS float* red = (LAS float*)(lds + 9 * 1024 * 4);
        for (int i = tid; i < 9 * 1024; i += 512) { const float v = i < 8 * 1024 ? a.in[I_C][i] : a.in[I_CCTX][i - 8 * 1024]; S[i] = silu(v); }
        __syncthreads();
        float* MOD = (float*)(ws + WS_MOD);
        for (int item = BID(); item < 4 * 144; item += GDIM()) {
            const int l = item / 144, cgp = item % 144;
            const int cq = tid & 15, kg = tid >> 4;
            const float* W = a.in[I_ADAW] + (size_t)l * D * MODLD + cgp * 64 + cq * 4;
            f32x4 acc[9];
#pragma unroll
            for (int r = 0; r < 9; ++r) acc[r] = (f32x4){0.f, 0.f, 0.f, 0.f};
#pragma unroll 4
            for (int kk = 0; kk < 32; ++kk) {
                const int k = kg * 32 + kk;
                const f32x4 w4 = *(const f32x4*)(W + (size_t)k * MODLD);
#pragma unroll
                for (int r = 0; r < 9; ++r) acc[r] = acc[r] + w4 * S[r * 1024 + k];
            }
#pragma unroll
            for (int r = 0; r < 9; ++r)
#pragma unroll
                for (int e = 0; e < 4; ++e) { float v = acc[r][e]; v += shx(v, 16); v += shx(v, 32); acc[r][e] = v; }
            if (lane < 16) {
#pragma unroll
                for (int r = 0; r < 9; ++r)
#pragma unroll
                    for (int e = 0; e < 4; ++e) red[(wid * 9 + r) * 64 + cq * 4 + e] = acc[r][e];
            }
            __syncthreads();
            for (int o = tid; o < 9 * 64; o += 512) {
                const int r = o >> 6, cc = o & 63; float v = 0.f;
#pragma unroll
                for (int w = 0; w < 8; ++w) v += red[(w * 9 + r) * 64 + cc];
                const int col = cgp * 64 + cc;
                const int slot = col >> 10;
                MOD[((size_t)l * 9 + r) * MODLD + col] = (v + a.in[I_ADAB][(size_t)l * MODLD + col]) * ((slot == 2 || slot == 8) ? 0.5f : 1.f);
            }
            __syncthreads();
        }
    }
    {
        LAS float* tile = (LAS float*)lds;
        for (int item = BID(); item < TILES_TOTAL; item += GDIM()) {
            int mi, t = item;
            if (t < 8 * TILES_W13) { mi = t / TILES_W13; t -= mi * TILES_W13; }
            else if (t < 8 * TILES_W13 + 8 * TILES_W2) { t -= 8 * TILES_W13; mi = t / TILES_W2; t -= mi * TILES_W2; mi += 8; }
            else { t -= 8 * TILES_W13 + 8 * TILES_W2;
                if (t < 16 * 48) { mi = 16; } else if (t < 16 * (48 + 68)) { mi = 17; t -= 16 * 48; } else if (t < 16 * (48 + 68 + 48)) { mi = 18; t -= 16 * (48 + 68); }
                else if (t < 16 * (48 + 68 + 48 + 52)) { mi = 19; t -= 16 * (48 + 68 + 48); } else { t -= 16 * (48 + 68 + 48 + 52); mi = 20 + t / TILES_WO; t = t % TILES_WO; } }
            const WDesc w = get_wdesc(a, ws, mi);
            const int ntn = w.Npad / 64, kt = t / ntn, nt = t % ntn, k0 = kt * 64, n0 = nt * 64;
            {
                const int nn = tid & 63, n = n0 + nn;
#pragma unroll
                for (int i = 0; i < 8; ++i) { const int kk = (tid >> 6) + 8 * i; tile[kk * 65 + nn] = n < w.N ? w.src[(size_t)(k0 + kk) * w.N + n] : 0.f; }
            }
            __syncthreads();
            {
                const int kp = tid & 31;
#pragma unroll
                for (int i = 0; i < 4; ++i) {
                    const int nn = (tid >> 5) + 16 * i, n = n0 + nn;
                    int drow = n;
                    if (w.perm) { const int half = n >= DFF ? 1 : 0, jj = n - half * DFF; drow = (jj >> 7) * 256 + half * 128 + (jj & 127); }
                    *(unsigned*)(w.dst + (size_t)drow * w.K + k0 + 2 * kp) = pk2(tile[(2 * kp) * 65 + nn], tile[(2 * kp + 1) * 65 + nn]);
                }
            }
            __syncthreads();
        }
    }
    {
        f32x4* H4 = (f32x4*)(ws + WS_H);
        const f32x4* x4 = (const f32x4*)a.in[I_X]; const f32x4* c4 = (const f32x4*)a.in[I_CTX];
        const int n1 = MLAT * D / 4, n2 = MTOT * D / 4;
        for (int i = BID() * 512 + tid; i < n2; i += GDIM() * 512) H4[i] = i < n1 ? x4[i] : c4[i - n1];
    }
    if (BID() == 0) {
        float* R = (float*)(ws + WS_ROPE);
        for (int i = tid; i < 64 * 16; i += 512) { const int pos = i >> 4, fi = i & 15; const float f = powf(10000.f, -(float)fi / 16.f); const float ang = (float)pos * f; R[i] = cosf(ang); R[1024 + i] = sinf(ang); }
    }
}

__device__ void norm_phase(float* H, const float* g, const float* modl  , int slot_shift, bf16_t* U, int nrows, const float* DP) {
    const int lane = TID() & 63, gw = BID() * 8 + (TID() >> 6), ngw = GDIM() * 8;
    f32x4 gv[4];
#pragma unroll
    for (int j = 0; j < 4; ++j) gv[j] = *(const f32x4*)(g + j * 256 + lane * 4);
    for (int row = gw; row < nrows; row += ngw) {
        const int mrow = row < MLAT ? (row >> 11) : 8;
        const float* sh = modl + (size_t)mrow * MODLD + slot_shift * D; const float* sc = sh + D;
        f32x4 v[4]; float s = 0.f;
#pragma unroll
        for (int j = 0; j < 4; ++j) { v[j] = *(const f32x4*)(H + (size_t)row * D + j * 256 + lane * 4);
            if (DP != nullptr && row >= MLAT) {
                const float* dp = DP + (size_t)(row - MLAT) * D + j * 256 + lane * 4;
                v[j] = v[j] + *(const f32x4*)dp + *(const f32x4*)(dp + (size_t)MCTX * D) + *(const f32x4*)(dp + (size_t)2 * MCTX * D);
                *(f32x4*)(H + (size_t)row * D + j * 256 + lane * 4) = v[j]; }
            s += (v[j][0] * v[j][0] + v[j][1] * v[j][1]) + (v[j][2] * v[j][2] + v[j][3] * v[j][3]); }
        const float rstd = rsqrtf(wave_sum(s) * (1.f / D) + 1e-6f);
#pragma unroll
        for (int j = 0; j < 4; ++j) {
            const f32x4 s4 = *(const f32x4*)(sh + j * 256 + lane * 4), c4 = *(const f32x4*)(sc + j * 256 + lane * 4);
            const f32x4 y = (v[j] * rstd) * gv[j] * (c4 + 1.f) + s4;
            u32x2 o; o.x = pk2(y[0], y[1]); o.y = pk2(y[2], y[3]);
            *(u32x2*)(U + (size_t)row * D + j * 256 + lane * 4) = o;
        }
    }
}
__device__ void final_norm_phase(const float* H, const float* g, float* out) {
    const int lane = TID() & 63, gw = BID() * 8 + (TID() >> 6), ngw = GDIM() * 8;
    f32x4 gv[4];
#pragma unroll
    for (int j = 0; j < 4; ++j) gv[j] = *(const f32x4*)(g + j * 256 + lane * 4);
    for (int row = gw; row < MLAT; row += ngw) {
        f32x4 v[4]; float s = 0.f;
#pragma unroll
        for (int j = 0; j < 4; ++j) { v[j] = *(const f32x4*)(H + (size_t)row * D + j * 256 + lane * 4); s += (v[j][0] * v[j][0] + v[j][1] * v[j][1]) + (v[j][2] * v[j][2] + v[j][3] * v[j][3]); }
        const float rstd = rsqrtf(wave_sum(s) * (1.f / D) + 1e-6f);
#pragma unroll
        for (int j = 0; j < 4; ++j) *(f32x4*)(out + (size_t)row * D + j * 256 + lane * 4) = (v[j] * rstd) * gv[j];
    }
}

__device__ __forceinline__ void unpack8(const u32x4 w, float* f) { f[0] = bflo(w.x); f[1] = bfhi(w.x); f[2] = bflo(w.y); f[3] = bfhi(w.y); f[4] = bflo(w.z); f[5] = bfhi(w.z); f[6] = bflo(w.w); f[7] = bfhi(w.w); }
__device__ void na_naive_phase(const bf16_t* P, const float* rpb, bf16_t* U, LAS unsigned char* lds) {
    constexpr int LD = 3072;
    const int lane = TID() & 63, gw = BID() * 8 + (TID() >> 6), ngw = GDIM() * 8;
    for (int item = gw; item < MTOT * 16; item += ngw) {
        const int row = item >> 4, h = item & 15;
        const bool lat = row < MLAT;
        const int b = lat ? (row >> 11) : ((row - MLAT) >> 8);
        const int t = row & 2047, r = t >> 6, c = t & 63;
        const int r0 = min(max(r - 4, 0), 24), win0 = min(max(c - 8, 0), 48);
        const int nk = lat ? 384 : 256;
        LAS float* q = (LAS float*)lds + (TID() >> 6) * 64;
        q[lane] = bf2f(P[(size_t)row * LD + 2048 + h * 64 + lane]);
        __builtin_amdgcn_wave_barrier();
        float s[6];
#pragma unroll
        for (int jj = 0; jj < 6; ++jj) s[jj] = -1e30f;
#pragma unroll 1
        for (int jj = 0; jj < 6; ++jj) {
            const int kk = lane + 64 * jj;
            float val = -1e30f;
            if (kk < nk) {
                int krow; float bias = 0.f;
                if (lat && kk < 128) { const int kr = r0 + (kk >> 4), kc = win0 + (kk & 15); krow = b * 2048 + kr * 64 + kc; bias = rpb[(h * 15 + (kr - r + 7)) * 31 + (kc - c + 15)]; }
                else krow = MLAT + b * 256 + (lat ? kk - 128 : kk);
                const u32x4* kp = (const u32x4*)(P + (size_t)krow * LD + h * 64);
                float d = 0.f;
#pragma unroll
                for (int i = 0; i < 8; ++i) { float kf[8]; unpack8(kp[i], kf); const f32x4 qa = *(const LAS f32x4*)(q + 8 * i), qb = *(const LAS f32x4*)(q + 8 * i + 4);
                    d += kf[0] * qa[0] + kf[1] * qa[1] + kf[2] * qa[2] + kf[3] * qa[3] + kf[4] * qb[0] + kf[5] * qb[1] + kf[6] * qb[2] + kf[7] * qb[3]; }
                val = d * 0.125f + bias;
            }
#pragma unroll
            for (int k2 = 0; k2 < 6; ++k2) s[k2] = (jj == k2) ? val : s[k2];
        }
        float mx = s[0];
#pragma unroll
        for (int jj = 1; jj < 6; ++jj) mx = fmaxf(mx, s[jj]);
        mx = wave_max(mx);
        float sum = 0.f;
#pragma unroll
        for (int jj = 0; jj < 6; ++jj) { s[jj] = (lane + 64 * jj < nk) ? __expf(s[jj] - mx) : 0.f; sum += s[jj]; }
        sum = wave_sum(sum);
        float o = 0.f;
#pragma unroll
        for (int jj = 0; jj < 6; ++jj) {
            if (jj * 64 < nk) {
#pragma unroll 4
                for (int src = 0; src < 64; ++src) {
                    const int kk = jj * 64 + src;
                    const float p = rdl(s[jj], src);
                    int krow;
                    if (lat && kk < 128) krow = b * 2048 + (r0 + (kk >> 4)) * 64 + win0 + (kk & 15); else krow = MLAT + b * 256 + (lat ? kk - 128 : kk);
                    o += p * bf2f(P[(size_t)krow * LD + 1024 + h * 64 + lane]);
                }
            }
        }
        U[(size_t)row * D + h * 64 + lane] = (bf16_t)f2bf(o / sum);
        __builtin_amdgcn_wave_barrier();
    }
}

__device__ void da_rope_phase(bf16_t* P, const float* R) {
    constexpr int LD = 3072;
    const int gt = BID() * 512 + TID(), ngt = GDIM() * 512;
    for (long it = gt; it < (long)MLAT * 1024; it += ngt) {
        const int row = (int)(it >> 10), w = (int)(it & 1023), sec = w >> 9, grp = (w >> 5) & 15, axis = (w >> 4) & 1, i = w & 15;
        const int t = row & 2047, pos = axis ? (t & 63) : (t >> 6);
        const float cs = R[pos * 16 + i], sn = R[1024 + pos * 16 + i];
        bf16_t* p = P + (size_t)row * LD + sec * 2048 + grp * 64 + axis * 32 + i;
        const float x1 = bf2f(p[0]), x2 = bf2f(p[16]);
        p[0] = (bf16_t)f2bf(x1 * cs - x2 * sn); p[16] = (bf16_t)f2bf(x2 * cs + x1 * sn);
    }
}
__device__ void da_naive_phase(const bf16_t* P, const float* lamp, const float* ng, bf16_t* U, LAS unsigned char* lds) {
    constexpr int LD = 3072;
    const int lane = TID() & 63, wid = TID() >> 6, gw = BID() * 8 + wid, ngw = GDIM() * 8;
    LAS float* qs = (LAS float*)lds + wid * 128;
    const float lam_init = 0.8f - 0.6f * expf(-0.3f * 2.f);
    const float l01 = wave_sum(lamp[lane] * lamp[64 + lane]), l23 = wave_sum(lamp[128 + lane] * lamp[192 + lane]);
    const float lam = expf(l01) - expf(l23) + lam_init;
    for (int item = gw; item < MTOT * 8; item += ngw) {
        const int row = item >> 3, h = item & 7;
        const bool lat = row < MLAT;
        const int b = lat ? (row >> 11) : ((row - MLAT) >> 8);
        const int nkl = lat ? 36 : 4;
        { const bf16_t* qp = P + (size_t)row * LD + 2048 + h * 128; qs[lane] = bf2f(qp[lane]) * 0.125f; qs[64 + lane] = bf2f(qp[64 + lane]) * 0.125f; }
        __builtin_amdgcn_wave_barrier();
        float m0 = -1e30f, m1 = -1e30f, l0 = 0.f, l1 = 0.f;
#pragma unroll 1
        for (int jj = 0; jj < nkl; ++jj) {
            const int kk = lane + 64 * jj;
            const int krow = lat ? (kk < 2048 ? b * 2048 + kk : MLAT + b * 256 + kk - 2048) : MLAT + b * 256 + kk;
            const u32x4* kp = (const u32x4*)(P + (size_t)krow * LD + h * 128);
            float d0 = 0.f, d1 = 0.f;
#pragma unroll
            for (int i = 0; i < 8; ++i) { float kf[8]; unpack8(kp[i], kf); const f32x4 qa = *(const LAS f32x4*)(qs + 8 * i), qb = *(const LAS f32x4*)(qs + 8 * i + 4);
                d0 += kf[0] * qa[0] + kf[1] * qa[1] + kf[2] * qa[2] + kf[3] * qa[3] + kf[4] * qb[0] + kf[5] * qb[1] + kf[6] * qb[2] + kf[7] * qb[3]; }
#pragma unroll
            for (int i = 0; i < 8; ++i) { float kf[8]; unpack8(kp[8 + i], kf); const f32x4 qa = *(const LAS f32x4*)(qs + 64 + 8 * i), qb = *(const LAS f32x4*)(qs + 64 + 8 * i + 4);
                d1 += kf[0] * qa[0] + kf[1] * qa[1] + kf[2] * qa[2] + kf[3] * qa[3] + kf[4] * qb[0] + kf[5] * qb[1] + kf[6] * qb[2] + kf[7] * qb[3]; }
            const float n0 = fmaxf(m0, d0), n1 = fmaxf(m1, d1);
            l0 = l0 * __expf(m0 - n0) + __expf(d0 - n0); l1 = l1 * __expf(m1 - n1) + __expf(d1 - n1); m0 = n0; m1 = n1;
        }
        { const float g0 = wave_max(m0), g1 = wave_max(m1); l0 = wave_sum(l0 * __expf(m0 - g0)); l1 = wave_sum(l1 * __expf(m1 - g1)); m0 = g0; m1 = g1; }
        const float i0 = 1.f / l0, i1 = lam / l1;
        float o0 = 0.f, o1 = 0.f;
#pragma unroll 1
        for (int jj = 0; jj < nkl; ++jj) {
            const int kk0 = lane + 64 * jj;
            const int krow0 = lat ? (kk0 < 2048 ? b * 2048 + kk0 : MLAT + b * 256 + kk0 - 2048) : MLAT + b * 256 + kk0;
            const u32x4* kp = (const u32x4*)(P + (size_t)krow0 * LD + h * 128);
            float d0 = 0.f, d1 = 0.f;
#pragma unroll
            for (int i = 0; i < 8; ++i) { float kf[8]; unpack8(kp[i], kf); const f32x4 qa = *(const LAS f32x4*)(qs + 8 * i), qb = *(const LAS f32x4*)(qs + 8 * i + 4);
                d0 += kf[0] * qa[0] + kf[1] * qa[1] + kf[2] * qa[2] + kf[3] * qa[3] + kf[4] * qb[0] + kf[5] * qb[1] + kf[6] * qb[2] + kf[7] * qb[3]; }
#pragma unroll
            for (int i = 0; i < 8; ++i) { float kf[8]; unpack8(kp[8 + i], kf); const f32x4 qa = *(const LAS f32x4*)(qs + 64 + 8 * i), qb = *(const LAS f32x4*)(qs + 64 + 8 * i + 4);
                d1 += kf[0] * qa[0] + kf[1] * qa[1] + kf[2] * qa[2] + kf[3] * qa[3] + kf[4] * qb[0] + kf[5] * qb[1] + kf[6] * qb[2] + kf[7] * qb[3]; }
            const float wv = __expf(d0 - m0) * i0 - __expf(d1 - m1) * i1;
#pragma unroll 4
            for (int src = 0; src < 64; ++src) {
                const int kk = jj * 64 + src;
                const int krow = lat ? (kk < 2048 ? b * 2048 + kk : MLAT + b * 256 + kk - 2048) : MLAT + b * 256 + kk;
                const float p = rdl(wv, src);
                const bf16_t* vp = P + (size_t)krow * LD + 1024 + h * 128;
                o0 += p * bf2f(vp[lane]); o1 += p * bf2f(vp[64 + lane]);
            }
        }
        const float rstd = rsqrtf(wave_sum(o0 * o0 + o1 * o1) * (1.f / 128.f) + 1e-6f) * (1.f - lam_init);
        U[(size_t)row * D + h * 128 + lane] = (bf16_t)f2bf(o0 * rstd * ng[h * 128 + lane]);
        U[(size_t)row * D + h * 128 + 64 + lane] = (bf16_t)f2bf(o1 * rstd * ng[h * 128 + 64 + lane]);
        __builtin_amdgcn_wave_barrier();
    }
}


typedef short bf16x8 __attribute__((ext_vector_type(8)));
__device__ __forceinline__ bf16x8 pack8(const f32x4 a, const f32x4 b) { u32x4 w; w.x = pk2(a[0], a[1]); w.y = pk2(a[2], a[3]); w.z = pk2(b[0], b[1]); w.w = pk2(b[2], b[3]); return __builtin_bit_cast(bf16x8, w); }
__device__ void da_flash_phase(const bf16_t* P, const bf16_t* VT, const float* lamp, const float* ng, bf16_t* U, LAS unsigned char* lds) {
    constexpr int LD = 3072, KS = 272, VS = 144, KBUF = 64 * KS, VBUF = 128 * VS, BUF = KBUF + VBUF;
    const int tid = TID(), lane = tid & 63, wid = tid >> 6, m16 = lane & 15, quad = lane >> 4;
    const float lam_init = 0.8f - 0.6f * expf(-0.3f * 2.f);
    const float l01 = wave_sum(lamp[lane] * lamp[64 + lane]), l23 = wave_sum(lamp[128 + lane] * lamp[192 + lane]);
    const float lam = expf(l01) - expf(l23) + lam_init;
    const int kkey = tid >> 3, kch = tid & 7, vdv = tid >> 2, vch = tid & 3;
    const int krho = ((kkey >> 5) * 2 + ((kkey >> 2) & 1)) * 16 + ((kkey >> 3) & 3) * 4 + (kkey & 3);
    for (int item = BID(); item < 1024 + 128; item += GDIM()) {
        const bool lat = item < 1024;
        int b, h, qb;
        if (lat) { b = item >> 7; h = (item >> 4) & 7; qb = item & 15; } else { const int i2 = item - 1024; b = i2 >> 4; h = (i2 >> 1) & 7; qb = i2 & 1; }
        const int qrow = (lat ? b * 2048 : MLAT + b * 256) + qb * 128 + wid * 16 + m16;
        const int nblk = lat ? 36 : 4;
        bf16x8 qf[2][2];
        { const bf16_t* qp = P + (size_t)qrow * LD + 2048 + h * 128 + quad * 8;
#pragma unroll
          for (int j = 0; j < 2; ++j)
#pragma unroll
            for (int ks = 0; ks < 2; ++ks) qf[j][ks] = *(const bf16x8*)(qp + j * 64 + ks * 32); }
        f32x4 O[2][8];
#pragma unroll
        for (int j = 0; j < 2; ++j)
#pragma unroll
            for (int dt = 0; dt < 8; ++dt) O[j][dt] = (f32x4){0.f, 0.f, 0.f, 0.f};
        float mrun[2] = {-1e30f, -1e30f}, lrun[2] = {0.f, 0.f};
        u32x4 rk0, rk1, rv0, rv1;
        {
            const int kr0 = lat ? b * 2048 : MLAT + b * 256;
            const bf16_t* kp = P + (size_t)(kr0 + kkey) * LD + h * 128 + kch * 8;
            rk0 = *(const u32x4*)kp; rk1 = *(const u32x4*)(kp + 64);
            const bf16_t* vp = VT + (size_t)(h * 128 + vdv) * MTOT + kr0 + vch * 8;
            rv0 = *(const u32x4*)vp; rv1 = *(const u32x4*)(vp + 32);
            LAS unsigned char* Kb = lds; LAS unsigned char* Vb = lds + KBUF;
            *(LAS u32x4*)(Kb + krho * KS + kch * 16) = rk0; *(LAS u32x4*)(Kb + krho * KS + (kch + 8) * 16) = rk1;
            *(LAS u32x4*)(Vb + vdv * VS + vch * 16) = rv0; *(LAS u32x4*)(Vb + vdv * VS + (vch + 4) * 16) = rv1;
        }
        __syncthreads();
#pragma unroll 1
        for (int kb = 0; kb < nblk; ++kb) {
            const bool more = kb + 1 < nblk;
            if (more) {
                const int k1 = kb + 1;
                const int kr0 = lat ? (k1 < 32 ? b * 2048 + k1 * 64 : MLAT + b * 256 + (k1 - 32) * 64) : MLAT + b * 256 + k1 * 64;
                const bf16_t* kp = P + (size_t)(kr0 + kkey) * LD + h * 128 + kch * 8;
                rk0 = *(const u32x4*)kp; rk1 = *(const u32x4*)(kp + 64);
                const bf16_t* vp = VT + (size_t)(h * 128 + vdv) * MTOT + kr0 + vch * 8;
                rv0 = *(const u32x4*)vp; rv1 = *(const u32x4*)(vp + 32);
            }
            LAS const unsigned char* Kb = lds + (kb & 1) * BUF; LAS const unsigned char* Vb = Kb + KBUF;
            f32x4 st[2][2][2];
#pragma unroll
            for (int sb = 0; sb < 2; ++sb)
#pragma unroll
                for (int j = 0; j < 2; ++j)
#pragma unroll
                    for (int T = 0; T < 2; ++T) {
                        f32x4 acc = (f32x4){0.f, 0.f, 0.f, 0.f};
#pragma unroll
                        for (int ks = 0; ks < 2; ++ks) {
                            const bf16x8 A = *(LAS const bf16x8*)(Kb + ((sb * 2 + T) * 16 + m16) * KS + (j * 64 + ks * 32 + quad * 8) * 2);
                            acc = __builtin_amdgcn_mfma_f32_16x16x32_bf16(A, qf[j][ks], acc, 0, 0, 0);
                        }
                        st[sb][j][T] = acc;
                    }
#pragma unroll
            for (int j = 0; j < 2; ++j) {
                float mx = -1e30f;
#pragma unroll
                for (int sb = 0; sb < 2; ++sb)
#pragma unroll
                    for (int T = 0; T < 2; ++T)
#pragma unroll
                        for (int e = 0; e < 4; ++e) mx = fmaxf(mx, st[sb][j][T][e]);
                mx = fmaxf(mx, shx(mx, 16)); mx = fmaxf(mx, shx(mx, 32));
                const float mnew = fmaxf(mrun[j], mx), alpha = __expf(mrun[j] - mnew);
                mrun[j] = mnew;
                float ps = 0.f;
#pragma unroll
                for (int sb = 0; sb < 2; ++sb)
#pragma unroll
                    for (int T = 0; T < 2; ++T)
#pragma unroll
                        for (int e = 0; e < 4; ++e) { const float pv = __expf(st[sb][j][T][e] - mnew); st[sb][j][T][e] = pv; ps += pv; }
                lrun[j] = lrun[j] * alpha + ps;
#pragma unroll
                for (int dt = 0; dt < 8; ++dt) O[j][dt] = O[j][dt] * alpha;
            }
#pragma unroll
            for (int sb = 0; sb < 2; ++sb) {
                const bf16x8 p0 = pack8(st[sb][0][0], st[sb][0][1]), p1 = pack8(st[sb][1][0], st[sb][1][1]);
#pragma unroll
                for (int dt = 0; dt < 8; ++dt) {
                    const bf16x8 A = *(LAS const bf16x8*)(Vb + (dt * 16 + m16) * VS + (sb * 32 + quad * 8) * 2);
                    O[0][dt] = __builtin_amdgcn_mfma_f32_16x16x32_bf16(A, p0, O[0][dt], 0, 0, 0);
                    O[1][dt] = __builtin_amdgcn_mfma_f32_16x16x32_bf16(A, p1, O[1][dt], 0, 0, 0);
                }
            }
            if (more) {
                LAS unsigned char* Kn = lds + ((kb + 1) & 1) * BUF; LAS unsigned char* Vn = Kn + KBUF;
                *(LAS u32x4*)(Kn + krho * KS + kch * 16) = rk0; *(LAS u32x4*)(Kn + krho * KS + (kch + 8) * 16) = rk1;
                *(LAS u32x4*)(Vn + vdv * VS + vch * 16) = rv0; *(LAS u32x4*)(Vn + vdv * VS + (vch + 4) * 16) = rv1;
            }
            __syncthreads();
        }
        float l0 = lrun[0], l1 = lrun[1];
        l0 += shx(l0, 16); l0 += shx(l0, 32); l1 += shx(l1, 16); l1 += shx(l1, 32);
        const float i0 = 1.f / l0, i1 = lam / l1;
        float ss = 0.f;
#pragma unroll
        for (int dt = 0; dt < 8; ++dt) { O[0][dt] = O[0][dt] * i0 - O[1][dt] * i1;
#pragma unroll
            for (int e = 0; e < 4; ++e) ss += O[0][dt][e] * O[0][dt][e]; }
        ss += shx(ss, 16); ss += shx(ss, 32);
        const float rstd = rsqrtf(ss * (1.f / 128.f) + 1e-6f) * (1.f - lam_init);
#pragma unroll
        for (int dt = 0; dt < 8; ++dt) {
            const int c = h * 128 + dt * 16 + quad * 4;
            const f32x4 g4 = *(const f32x4*)(ng + c);
            const f32x4 y = O[0][dt] * rstd * g4;
            u32x2 o; o.x = pk2(y[0], y[1]); o.y = pk2(y[2], y[3]);
            *(u32x2*)(U + (size_t)qrow * D + c) = o;
        }
    }
}


__device__ void na_mfma_phase(const bf16_t* P, const bf16_t* VT, const float* rpb, bf16_t* U) {
    constexpr int LD = 3072;
    const int lane = TID() & 63, gw = BID() * 8 + (TID() >> 6), ngw = GDIM() * 8, m16 = lane & 15, quad = lane >> 4;
    const int krow_in = (m16 >> 2) * 8 + (m16 & 3);
    for (int item = gw; item < 16384 + 2048; item += ngw) {
        const bool lat = item < 16384;
        int b, h, r = 0, j = 0, qrow;
        if (lat) { b = item >> 11; h = (item >> 7) & 15; r = (item >> 2) & 31; j = item & 3; qrow = b * 2048 + r * 64 + j * 16 + m16; }
        else { const int i2 = item - 16384; b = i2 >> 8; h = (i2 >> 4) & 15; qrow = MLAT + b * 256 + (i2 & 15) * 16 + m16; }
        const int r0 = min(max(r - 4, 0), 24), kc0 = min(max(16 * j - 8, 0), 32);
        const int c = j * 16 + m16, win0 = min(max(c - 8, 0), 48);
        bf16x8 qf[2];
        { const bf16_t* qp = P + (size_t)qrow * LD + 2048 + h * 64 + quad * 8; qf[0] = *(const bf16x8*)qp; qf[1] = *(const bf16x8*)(qp + 32); }
        f32x4 st[16][2];
        float mx = -1e30f;
#pragma unroll
        for (int sp = 0; sp < 16; ++sp) {
            if (sp < 8 && !lat) { st[sp][0] = (f32x4){-1e30f, -1e30f, -1e30f, -1e30f}; st[sp][1] = st[sp][0]; continue; }
            const int tok0 = sp < 8 ? b * 2048 + (r0 + sp) * 64 + kc0 : MLAT + b * 256 + (sp - 8) * 32;
#pragma unroll
            for (int T = 0; T < 2; ++T) {
                const bf16_t* kp = P + (size_t)(tok0 + krow_in + 4 * T) * LD + h * 64 + quad * 8;
                f32x4 acc = (f32x4){0.f, 0.f, 0.f, 0.f};
                acc = __builtin_amdgcn_mfma_f32_16x16x32_bf16(*(const bf16x8*)kp, qf[0], acc, 0, 0, 0);
                acc = __builtin_amdgcn_mfma_f32_16x16x32_bf16(*(const bf16x8*)(kp + 32), qf[1], acc, 0, 0, 0);
                if (sp < 8) {
                    const int ro = (r0 + sp - r + 7) * 31;
#pragma unroll
                    for (int e = 0; e < 4; ++e) {
                        const int kc = kc0 + quad * 8 + T * 4 + e;
                        const bool inw = (kc >= win0) && (kc < win0 + 16);
                        const float bias = rpb[h * 465 + (inw ? ro + (kc - c + 15) : 0)];
                        acc[e] = inw ? acc[e] + bias : -1e30f;
                    }
                }
                st[sp][T] = acc;
#pragma unroll
                for (int e = 0; e < 4; ++e) mx = fmaxf(mx, acc[e]);
            }
        }
        mx = fmaxf(mx, shx(mx, 16)); mx = fmaxf(mx, shx(mx, 32));
        float sum = 0.f;
        f32x4 O[4];
#pragma unroll
        for (int dt = 0; dt < 4; ++dt) O[dt] = (f32x4){0.f, 0.f, 0.f, 0.f};
#pragma unroll
        for (int sp = 0; sp < 16; ++sp) {
            if (sp < 8 && !lat) continue;
#pragma unroll
            for (int T = 0; T < 2; ++T)
#pragma unroll
                for (int e = 0; e < 4; ++e) { const float pv = __expf(st[sp][T][e] - mx); st[sp][T][e] = pv; sum += pv; }
            const bf16x8 pf = pack8(st[sp][0], st[sp][1]);
            const int tok0 = sp < 8 ? b * 2048 + (r0 + sp) * 64 + kc0 : MLAT + b * 256 + (sp - 8) * 32;
#pragma unroll
            for (int dt = 0; dt < 4; ++dt) {
                const bf16x8 Av = *(const bf16x8*)(VT + (size_t)(h * 64 + dt * 16 + m16) * MTOT + tok0 + quad * 8);
                O[dt] = __builtin_amdgcn_mfma_f32_16x16x32_bf16(Av, pf, O[dt], 0, 0, 0);
            }
        }
        sum += shx(sum, 16); sum += shx(sum, 32);
        const float inv = 1.f / sum;
#pragma unroll
        for (int dt = 0; dt < 4; ++dt) {
            const f32x4 y = O[dt] * inv;
            u32x2 o; o.x = pk2(y[0], y[1]); o.y = pk2(y[2], y[3]);
            *(u32x2*)(U + (size_t)qrow * D + h * 64 + dt * 16 + quad * 4) = o;
        }
    }
}

constexpr int ML_LD = 4352, ML_NKVG = 2064;
__device__ void ml_prep_phase(const bf16_t* P, const float* convw, bf16_t* QC, bf16_t* KC) {
    const int gt = BID() * 512 + TID(), ngt = GDIM() * 512;
    for (long it = gt; it < (long)MTOT * 2048; it += ngt) {
        const int row = (int)(it >> 11), w = (int)(it & 2047), isq = w >> 10, ch = w & 1023;
        const bool lat = row < MLAT;
        const int pos = lat ? (row & 2047) : ((row - MLAT) & 255), len = lat ? 2048 : 256;
        const int col = isq ? (ML_NKVG + ch) : ch;
        const float w0 = convw[0 * 2048 + isq * 1024 + ch], w1 = convw[1 * 2048 + isq * 1024 + ch], w2 = convw[2 * 2048 + isq * 1024 + ch];
        const bf16_t* p = P + (size_t)row * ML_LD + col;
        float v = w1 * bf2f(p[0]);
        if (pos > 0) v += w0 * bf2f(p[-ML_LD]);
        if (pos < len - 1) v += w2 * bf2f(p[ML_LD]);
        v = silu(v);
        if (isq) QC[(size_t)row * D + ch] = (bf16_t)f2bf(v); else KC[(size_t)row * D + ch] = (bf16_t)f2bf(v * 0.0625f);
    }
}
__device__ void ml_scan_naive_phase(const bf16_t* P, const float* G32, const float* gate_b, const bf16_t* QC, const bf16_t* KC, float* HS, LAS unsigned char* lds) {
    const int tid = TID(), dvl = tid & 63, g = tid >> 6;
    LAS float* red = (LAS float*)lds;
    LAS float* redd = red + 2 * 8 * 64;
    for (int item = BID(); item < 256; item += GDIM()) {
        const int dir = item >> 7, b = (item >> 4) & 7, h = (item >> 2) & 3, sl = item & 3;
        const float bi = gate_b[dir * 8 + h], bfg = gate_b[dir * 8 + 4 + h];
        float C[32], n[32];
#pragma unroll
        for (int j = 0; j < 32; ++j) { C[j] = 0.f; n[j] = 0.f; }
        float m = 0.f;
        for (int step = 0; step < CTXL + SEQ; ++step) {
            int row;
            if (step < CTXL) row = MLAT + b * CTXL + (dir ? CTXL - 1 - step : step);
            else { const int s2 = step - CTXL; row = b * SEQ + (dir ? SEQ - 1 - s2 : s2); }
            const float ig = G32[(size_t)row * 32 + dir * 8 + h] + bi, fg = G32[(size_t)row * 32 + dir * 8 + 4 + h] + bfg;
            const float lf = log_sigmoid(fg);
            const float mn = fmaxf(lf + m, ig), fw = __expf(lf + m - mn), iw = __expf(ig - mn);
            m = mn;
            const float v = bf2f(P[(size_t)row * ML_LD + 1024 + h * 256 + sl * 64 + dvl]);
            const u32x4* qp = (const u32x4*)(QC + (size_t)row * D + h * 256 + g * 32);
            const u32x4* kp = (const u32x4*)(KC + (size_t)row * D + h * 256 + g * 32);
            float part = 0.f, dpart = 0.f;
#pragma unroll
            for (int i = 0; i < 4; ++i) {
                float qf[8], kf[8]; unpack8(qp[i], qf); unpack8(kp[i], kf);
#pragma unroll
                for (int e = 0; e < 8; ++e) {
                    const int j = 8 * i + e;
                    C[j] = fw * C[j] + (iw * kf[e]) * v; n[j] = fw * n[j] + iw * kf[e];
                    part += qf[e] * C[j]; dpart += qf[e] * n[j];
                }
            }
            const int pb = step & 1;
            red[(pb * 8 + g) * 64 + dvl] = part;
            if (dvl == 0) redd[pb * 8 + g] = dpart;
            __syncthreads();
            if (tid < 64) {
                float num = 0.f, den = 0.f;
#pragma unroll
                for (int w = 0; w < 8; ++w) { num += red[(pb * 8 + w) * 64 + tid]; den += redd[pb * 8 + w]; }
                HS[((size_t)dir * MTOT + row) * D + h * 256 + sl * 64 + tid] = num / fmaxf(fabsf(den), __expf(-m));
            }
        }
        __syncthreads();
    }
}
__device__ void ml_readout_phase(const bf16_t* P, const bf16_t* HS, const float* ng, bf16_t* U) {
    const int lane = TID() & 63, gw = BID() * 8 + (TID() >> 6), ngw = GDIM() * 8;
    for (int row = gw; row < MTOT; row += ngw) {
        const int c0 = lane * 16;
        float v[16]; float ss = 0.f;
#pragma unroll
        for (int i = 0; i < 2; ++i) {
            float f0[8], f1[8]; unpack8(*(const u32x4*)(HS + (size_t)row * D + c0 + 8 * i), f0); unpack8(*(const u32x4*)(HS + ((size_t)MTOT + row) * D + c0 + 8 * i), f1);
#pragma unroll
            for (int e = 0; e < 8; ++e) { v[8 * i + e] = f0[e] + f1[e]; ss += v[8 * i + e] * v[8 * i + e]; }
        }
        ss += shx(ss, 1); ss += shx(ss, 2); ss += shx(ss, 4); ss += shx(ss, 8);
        const float rstd = rsqrtf(ss * (1.f / 256.f) + 1e-6f);
        const bf16_t* op = P + (size_t)row * ML_LD + ML_NKVG + D + c0;
        unsigned o[8];
#pragma unroll
        for (int i = 0; i < 8; ++i) {
            const float y0 = sigmoidf_(bf2f(op[2 * i])) * v[2 * i] * rstd * ng[c0 + 2 * i], y1 = sigmoidf_(bf2f(op[2 * i + 1])) * v[2 * i + 1] * rstd * ng[c0 + 2 * i + 1];
            o[i] = pk2(y0, y1);
        }
        u32x4* up = (u32x4*)(U + (size_t)row * D + c0);
        up[0] = (u32x4){o[0], o[1], o[2], o[3]}; up[1] = (u32x4){o[4], o[5], o[6], o[7]};
    }
}

constexpr int GL_LD = 3328, GL_NKVG = 1568;
__device__ void gla_prep_phase(const float* G32, const float* wgu, const float* bg, float* LA) {
    const int gt = BID() * 512 + TID(), ngt = GDIM() * 512;
    for (long it = gt; it < (long)2 * MTOT * 512; it += ngt) {
        const int c = (int)(it & 511), row = (int)((it >> 9) % MTOT), dir = (int)(it / ((long)MTOT * 512));
        const float* low = G32 + (size_t)row * 32 + dir * 16;
        float acc = bg[dir * 512 + c];
#pragma unroll
        for (int r = 0; r < 16; ++r) acc += low[r] * wgu[(dir * 16 + r) * 512 + c];
        LA[((size_t)dir * MTOT + row) * 512 + c] = log_sigmoid(acc) * (1.f / 16.f);
    }
}
__device__ void gla_scan_naive_phase(const bf16_t* P, const float* LA, float* HS, LAS unsigned char* lds) {
    const int tid = TID(), dvl = tid & 63, g = tid >> 6;
    LAS float* red = (LAS float*)lds;
    for (int item = BID(); item < 256; item += GDIM()) {
        const int dir = item >> 7, b = (item >> 4) & 7, h = (item >> 2) & 3, sl = item & 3;
        float S[16];
#pragma unroll
        for (int j = 0; j < 16; ++j) S[j] = 0.f;
        for (int step = 0; step < CTXL + SEQ; ++step) {
            int row;
            if (step < CTXL) row = MLAT + b * CTXL + (dir ? CTXL - 1 - step : step);
            else { const int s2 = step - CTXL; row = b * SEQ + (dir ? SEQ - 1 - s2 : s2); }
            const float v = bf2f(P[(size_t)row * GL_LD + 512 + h * 256 + sl * 64 + dvl]);
            const u32x4* kp = (const u32x4*)(P + (size_t)row * GL_LD + h * 128 + g * 16);
            const u32x4* qp = (const u32x4*)(P + (size_t)row * GL_LD + GL_NKVG + h * 128 + g * 16);
            const f32x4* lp = (const f32x4*)(LA + ((size_t)dir * MTOT + row) * 512 + h * 128 + g * 16);
            float part = 0.f;
#pragma unroll
            for (int i = 0; i < 2; ++i) {
                float qf[8], kf[8]; unpack8(qp[i], qf); unpack8(kp[i], kf);
                const f32x4 la0 = lp[2 * i], la1 = lp[2 * i + 1];
#pragma unroll
                for (int e = 0; e < 8; ++e) {
                    const int j = 8 * i + e; const float al = __expf(e < 4 ? la0[e] : la1[e - 4]);
                    S[j] = al * S[j] + kf[e] * v; part += qf[e] * S[j];
                }
            }
            const int pb = step & 1;
            red[(pb * 8 + g) * 64 + dvl] = part;
            __syncthreads();
            if (tid < 64 && step >= CTXL) {
                float num = 0.f;
#pragma unroll
                for (int w = 0; w < 8; ++w) num += red[(pb * 8 + w) * 64 + tid];
                HS[((size_t)dir * MTOT + row) * D + h * 256 + sl * 64 + tid] = num * 0.08838834764831845f;
            }
        }
        __syncthreads();
    }
}
__device__ void gla_readout_phase(const bf16_t* P, const bf16_t* HS, const float* ng, bf16_t* U) {
    const int lane = TID() & 63, gw = BID() * 8 + (TID() >> 6), ngw = GDIM() * 8;
    for (int row = gw; row < MLAT; row += ngw) {
        const int c0 = lane * 16;
        float v[16]; float ss = 0.f;
#pragma unroll
        for (int i = 0; i < 2; ++i) {
            float f0[8], f1[8]; unpack8(*(const u32x4*)(HS + (size_t)row * D + c0 + 8 * i), f0); unpack8(*(const u32x4*)(HS + ((size_t)MTOT + row) * D + c0 + 8 * i), f1);
#pragma unroll
            for (int e = 0; e < 8; ++e) { v[8 * i + e] = f0[e] + f1[e]; ss += v[8 * i + e] * v[8 * i + e]; }
        }
        ss += shx(ss, 1); ss += shx(ss, 2); ss += shx(ss, 4); ss += shx(ss, 8);
        const float rstd = rsqrtf(ss * (1.f / 256.f) + 1e-6f);
        const bf16_t* rp = P + (size_t)row * GL_LD + GL_NKVG + 512 + c0;
        unsigned o[8];
#pragma unroll
        for (int i = 0; i < 8; ++i) {
            const float y0 = silu(bf2f(rp[2 * i])) * v[2 * i] * rstd * ng[c0 + 2 * i], y1 = silu(bf2f(rp[2 * i + 1])) * v[2 * i + 1] * rstd * ng[c0 + 2 * i + 1];
            o[i] = pk2(y0, y1);
        }
        u32x4* up = (u32x4*)(U + (size_t)row * D + c0);
        up[0] = (u32x4){o[0], o[1], o[2], o[3]}; up[1] = (u32x4){o[4], o[5], o[6], o[7]};
    }
}


__device__ __forceinline__ int chunk_row0(int cidx) { return cidx < 256 ? (cidx >> 5) * 2048 + (cidx & 31) * 64 : MLAT + ((cidx - 256) >> 2) * 256 + ((cidx - 256) & 3) * 64; }
__device__ void ml_prep2_phase(const bf16_t* P, const float* G32, const float* gate_b, const float* convw, bf16_t* QC, bf16_t* KC, bf16_t* KBT, unsigned char* sc, LAS unsigned char* lds) {
    constexpr int KTS = 258;
    const int tid = TID();
    LAS bf16_t* ktile = (LAS bf16_t*)lds;
    LAS float* lfL = (LAS float*)(lds + 64 * KTS * 2);
    LAS float* igL = lfL + 128; LAS float* aL = igL + 128; LAS float* aeL = aL + 128;
    float* SA = (float*)(sc + SC_SA); float* SMX = (float*)(sc + SC_SMX); float* SB = (float*)(sc + SC_SB); float* CE = (float*)(sc + SC_CE);
    for (int item = BID(); item < 288 * 4; item += GDIM()) {
        const int cidx = item >> 2, h = item & 3, row0 = chunk_row0(cidx);
        const int p0 = cidx < 256 ? (cidx & 31) * 64 : ((cidx - 256) & 3) * 64, len = cidx < 256 ? 2048 : 256;
        if (tid < 128) { const int dir = tid >> 6, tau = tid & 63; const float* gp = G32 + (size_t)(row0 + tau) * 32 + dir * 8 + h;
            igL[dir * 64 + tau] = gp[0] + gate_b[dir * 8 + h]; lfL[dir * 64 + tau] = log_sigmoid(gp[4] + gate_b[dir * 8 + 4 + h]); }
        for (int idx = tid; idx < 2 * 64 * 256; idx += 512) {
            const int isq = idx >> 14, tau = (idx >> 8) & 63, ch = idx & 255, c = h * 256 + ch, row = row0 + tau, pos = p0 + tau;
            const float w0 = convw[0 * 2048 + isq * 1024 + c], w1 = convw[1 * 2048 + isq * 1024 + c], w2 = convw[2 * 2048 + isq * 1024 + c];
            const bf16_t* pp = P + (size_t)row * ML_LD + (isq ? ML_NKVG + c : c);
            float v = w1 * bf2f(pp[0]);
            if (pos > 0) v += w0 * bf2f(pp[-ML_LD]);
            if (pos < len - 1) v += w2 * bf2f(pp[ML_LD]);
            v = silu(v);
            if (isq) QC[(size_t)row * D + c] = (bf16_t)f2bf(v);
            else { const bf16_t kb = (bf16_t)f2bf(v * 0.0625f); KC[(size_t)row * D + c] = kb; ktile[tau * KTS + ch] = kb; }
        }
        __syncthreads();
        if (tid < 2) {
            const int dir = tid; float run = 0.f, mx = -1e30f;
            for (int pp = 0; pp < 64; ++pp) {
                const int tau = dir ? 63 - pp : pp;
                run += lfL[dir * 64 + tau]; const float av = igL[dir * 64 + tau] - run; mx = fmaxf(mx, av);
                const size_t o = ((size_t)(dir * 4 + h)) * MTOT + row0 + tau;
                SB[o] = run; SA[o] = av; SMX[o] = mx; aL[dir * 64 + tau] = av;
            }
            CE[((dir * 4 + h) * 288 + cidx) * 2] = mx; CE[((dir * 4 + h) * 288 + cidx) * 2 + 1] = run; aeL[dir] = mx;
        }
        __syncthreads();
        for (int idx = tid; idx < 2 * 256 * 8; idx += 512) {
            const int dir = idx >> 11, dk = (idx >> 3) & 255, sc8 = idx & 7; const float ae = aeL[dir];
            unsigned o[4];
#pragma unroll
            for (int i = 0; i < 4; ++i) { const int s0 = sc8 * 8 + 2 * i;
                o[i] = pk2(bf2f(ktile[s0 * KTS + dk]) * __expf(aL[dir * 64 + s0] - ae), bf2f(ktile[(s0 + 1) * KTS + dk]) * __expf(aL[dir * 64 + s0 + 1] - ae)); }
            *(u32x4*)(KBT + ((size_t)dir * D + h * 256 + dk) * MTOT + row0 + sc8 * 8) = (u32x4){o[0], o[1], o[2], o[3]};
        }
        __syncthreads();
    }
}
__device__ void gla_prep2_phase(const bf16_t* P, const float* G32, const float* wgu, const float* bg, bf16_t* QA, bf16_t* KA, bf16_t* KBT, unsigned char* sc, LAS unsigned char* lds) {
    const int tid = TID();
    LAS float* laL = (LAS float*)lds;
    LAS float* beL = laL + 2 * 64 * 128;
    float* DEC = (float*)(sc + SC_DEC);
    for (int item = BID(); item < 288 * 4; item += GDIM()) {
        const int cidx = item >> 2, h = item & 3, row0 = chunk_row0(cidx);
        {
            const int dk = tid & 127, dir = (tid >> 7) & 1, tg = tid >> 8;
            float w[16];
#pragma unroll
            for (int r = 0; r < 16; ++r) w[r] = wgu[(dir * 16 + r) * 512 + h * 128 + dk];
            const float bgv = bg[dir * 512 + h * 128 + dk];
            for (int tau = tg * 32; tau < tg * 32 + 32; ++tau) {
                const float* low = G32 + (size_t)(row0 + tau) * 32 + dir * 16;
                float acc = bgv;
#pragma unroll
                for (int r = 0; r < 16; ++r) acc += low[r] * w[r];
                laL[(dir * 64 + tau) * 128 + dk] = log_sigmoid(acc) * (1.f / 16.f);
            }
        }
        __syncthreads();
        if (tid < 256) {
            const int dir = tid >> 7, dk = tid & 127; float run = 0.f;
            for (int pp = 0; pp < 64; ++pp) { const int tau = dir ? 63 - pp : pp; run += laL[(dir * 64 + tau) * 128 + dk]; laL[(dir * 64 + tau) * 128 + dk] = run; }
            beL[dir * 128 + dk] = run; DEC[((size_t)dir * 288 + cidx) * 512 + h * 128 + dk] = __expf(run);
        }
        __syncthreads();
        for (int idx = tid; idx < 2 * 64 * 128; idx += 512) {
            const int dir = idx >> 13, tau = (idx >> 7) & 63, dk = idx & 127; const float bc = laL[(dir * 64 + tau) * 128 + dk];
            const bf16_t* pp = P + (size_t)(row0 + tau) * GL_LD + h * 128 + dk;
            const size_t o = ((size_t)dir * MTOT + row0 + tau) * 512 + h * 128 + dk;
            QA[o] = (bf16_t)f2bf(bf2f(pp[GL_NKVG]) * __expf(bc) * 0.08838834764831845f); KA[o] = (bf16_t)f2bf(bf2f(pp[0]) * __expf(-bc));
        }
        for (int idx = tid; idx < 2 * 128 * 8; idx += 512) {
            const int dir = idx >> 10, dk = (idx >> 3) & 127, sc8 = idx & 7; const float be = beL[dir * 128 + dk];
            unsigned o[4];
#pragma unroll
            for (int i = 0; i < 4; ++i) { const int s0 = sc8 * 8 + 2 * i; const bf16_t* pp = P + (size_t)(row0 + s0) * GL_LD + h * 128 + dk;
                o[i] = pk2(bf2f(pp[0]) * __expf(be - laL[(dir * 64 + s0) * 128 + dk]), bf2f(pp[GL_LD]) * __expf(be - laL[(dir * 64 + s0 + 1) * 128 + dk])); }
            *(u32x4*)(KBT + ((size_t)dir * 512 + h * 128 + dk) * MTOT + row0 + sc8 * 8) = (u32x4){o[0], o[1], o[2], o[3]};
        }
        __syncthreads();
    }
}

__device__ __forceinline__ float lane_up(float v, int lane, int off) { return __builtin_bit_cast(float, __builtin_amdgcn_ds_bpermute(((lane - off) & 63) << 2, __builtin_bit_cast(int, v))); }
__device__ void ml_prep3_phase(const bf16_t* P, const float* G32, const float* gate_b, const float* convw, bf16_t* QC, bf16_t* KC, bf16_t* KBT, unsigned char* sc, LAS unsigned char* lds) {
    const int tid = TID(), lane = tid & 63, wid = tid >> 6;
    LAS float* aL = (LAS float*)lds;
    LAS float* aeL = aL + 128;
    float* SA = (float*)(sc + SC_SA); float* SMX = (float*)(sc + SC_SMX); float* SB = (float*)(sc + SC_SB); float* CE = (float*)(sc + SC_CE);
    for (int item = BID(); item < 288 * 4; item += GDIM()) {
        const int cidx = item >> 2, h = item & 3, row0 = chunk_row0(cidx);
        const int p0 = cidx < 256 ? (cidx & 31) * 64 : ((cidx - 256) & 3) * 64, len = cidx < 256 ? 2048 : 256;
        if (wid < 2) {
            const int dir = wid, tau = dir ? 63 - lane : lane;
            const float* gp = G32 + (size_t)(row0 + tau) * 32 + dir * 8 + h;
            const float ig = gp[0] + gate_b[dir * 8 + h];
            float run = log_sigmoid(gp[4] + gate_b[dir * 8 + 4 + h]);
#pragma unroll
            for (int off = 1; off < 64; off <<= 1) { const float v = lane_up(run, lane, off); if (lane >= off) run += v; }
            const float av = ig - run; float mx = av;
#pragma unroll
            for (int off = 1; off < 64; off <<= 1) { const float v = lane_up(mx, lane, off); if (lane >= off) mx = fmaxf(mx, v); }
            const size_t o = ((size_t)(dir * 4 + h)) * MTOT + row0 + tau;
            SB[o] = run; SA[o] = av; SMX[o] = mx; aL[dir * 64 + tau] = av;
            if (lane == 63) { CE[((dir * 4 + h) * 288 + cidx) * 2] = mx; CE[((dir * 4 + h) * 288 + cidx) * 2 + 1] = run; aeL[dir] = mx; }
        }
        __syncthreads();
        const int c = h * 256 + (tid & 63) * 4, tau0 = (tid >> 6) * 8;
        float kr[8][4];
#pragma unroll
        for (int isq = 0; isq < 2; ++isq) {
            const f32x4 w0 = *(const f32x4*)(convw + 0 * 2048 + isq * 1024 + c), w1 = *(const f32x4*)(convw + 1 * 2048 + isq * 1024 + c), w2 = *(const f32x4*)(convw + 2 * 2048 + isq * 1024 + c);
            const bf16_t* pp = P + (size_t)(row0 + tau0) * ML_LD + (isq ? ML_NKVG + c : c);
            f32x4 x[10];
#pragma unroll
            for (int i = 0; i < 10; ++i) {
                const int pos = p0 + tau0 + i - 1;
                u32x2 v = (u32x2){0u, 0u};
                if (pos >= 0 && pos < len) v = *(const u32x2*)(pp + (long)(i - 1) * ML_LD);
                x[i] = (f32x4){bflo(v.x), bfhi(v.x), bflo(v.y), bfhi(v.y)};
            }
#pragma unroll
            for (int i = 0; i < 8; ++i) {
                f32x4 y = w0 * x[i] + w1 * x[i + 1] + w2 * x[i + 2];
#pragma unroll
                for (int e = 0; e < 4; ++e) y[e] = silu(y[e]);
                if (isq) { u32x2 o; o.x = pk2(y[0], y[1]); o.y = pk2(y[2], y[3]); *(u32x2*)(QC + (size_t)(row0 + tau0 + i) * D + c) = o; }
                else { y = y * 0.0625f; u32x2 o; o.x = pk2(y[0], y[1]); o.y = pk2(y[2], y[3]); *(u32x2*)(KC + (size_t)(row0 + tau0 + i) * D + c) = o;
                    kr[i][0] = bflo(o.x); kr[i][1] = bfhi(o.x); kr[i][2] = bflo(o.y); kr[i][3] = bfhi(o.y); }
            }
        }
#pragma unroll
        for (int dir = 0; dir < 2; ++dir) {
            const float ae = aeL[dir]; float wv[8];
#pragma unroll
            for (int i = 0; i < 8; ++i) wv[i] = __expf(aL[dir * 64 + tau0 + i] - ae);
#pragma unroll
            for (int e = 0; e < 4; ++e) {
                u32x4 o; o.x = pk2(kr[0][e] * wv[0], kr[1][e] * wv[1]); o.y = pk2(kr[2][e] * wv[2], kr[3][e] * wv[3]); o.z = pk2(kr[4][e] * wv[4], kr[5][e] * wv[5]); o.w = pk2(kr[6][e] * wv[6], kr[7][e] * wv[7]);
                *(u32x4*)(KBT + ((size_t)dir * D + c + e) * MTOT + row0 + tau0) = o;
            }
        }
        __syncthreads();
    }
}
__device__ void gla_prep3_phase(const bf16_t* P, const float* G32, const float* wgu, const float* bg, bf16_t* QA, bf16_t* KA, bf16_t* KBT, unsigned char* sc, LAS unsigned char* lds) {
    const int tid = TID(), dk = tid & 127, dir = (tid >> 7) & 1, tg = tid >> 8;
    LAS float* lowL = (LAS float*)lds;
    LAS float* totL = lowL + 2048;
    float* DEC = (float*)(sc + SC_DEC);
    for (int item = BID(); item < 288 * 4; item += GDIM()) {
        const int cidx = item >> 2, h = item & 3, row0 = chunk_row0(cidx);
        *(LAS f32x4*)(lowL + tid * 4) = *(const f32x4*)(G32 + (size_t)row0 * 32 + tid * 4);
        float w[16];
#pragma unroll
        for (int r = 0; r < 16; ++r) w[r] = wgu[(dir * 16 + r) * 512 + h * 128 + dk];
        const float bgv = bg[dir * 512 + h * 128 + dk];
        __syncthreads();
        float la[32];
#pragma unroll
        for (int j = 0; j < 32; ++j) {
            const LAS f32x4* lp = (const LAS f32x4*)(lowL + (tg * 32 + j) * 32 + dir * 16);
            const f32x4 l0 = lp[0], l1 = lp[1], l2 = lp[2], l3 = lp[3];
            float acc = bgv;
#pragma unroll
            for (int e = 0; e < 4; ++e) acc += l0[e] * w[e] + l1[e] * w[4 + e] + l2[e] * w[8 + e] + l3[e] * w[12 + e];
            la[j] = log_sigmoid(acc) * (1.f / 16.f);
        }
        float run = 0.f;
        if (dir == 0) {
#pragma unroll
            for (int j = 0; j < 32; ++j) { run += la[j]; la[j] = run; }
        } else {
#pragma unroll
            for (int j = 31; j >= 0; --j) { run += la[j]; la[j] = run; }
        }
        totL[(dir * 2 + tg) * 128 + dk] = run;
        __syncthreads();
        const float t0 = totL[(dir * 2 + 0) * 128 + dk], t1 = totL[(dir * 2 + 1) * 128 + dk], be = t0 + t1;
        const float offs = dir == 0 ? (tg ? t0 : 0.f) : (tg ? 0.f : t1);
        if (tg == 0) DEC[((size_t)dir * 288 + cidx) * 512 + h * 128 + dk] = __expf(be);
        unsigned kb[16];
#pragma unroll
        for (int j2 = 0; j2 < 16; ++j2) {
            float kv[2];
#pragma unroll
            for (int u = 0; u < 2; ++u) {
                const int j = 2 * j2 + u, row = row0 + tg * 32 + j; const float bc = la[j] + offs;
                const bf16_t* pp = P + (size_t)row * GL_LD + h * 128 + dk;
                const float kf = bf2f(pp[0]), qf = bf2f(pp[GL_NKVG]);
                const size_t o = ((size_t)dir * MTOT + row) * 512 + h * 128 + dk;
                QA[o] = (bf16_t)f2bf(qf * __expf(bc) * 0.08838834764831845f); KA[o] = (bf16_t)f2bf(kf * __expf(-bc));
                kv[u] = kf * __expf(be - bc);
            }
            kb[j2] = pk2(kv[0], kv[1]);
        }
        bf16_t* kp = KBT + ((size_t)dir * 512 + h * 128 + dk) * MTOT + row0 + tg * 32;
#pragma unroll
        for (int i = 0; i < 4; ++i) *(u32x4*)(kp + 8 * i) = (u32x4){kb[4 * i], kb[4 * i + 1], kb[4 * i + 2], kb[4 * i + 3]};
        __syncthreads();
    }
}
template <int DK, bool ML>
__device__ void chunk_scan_phase(const bf16_t* QAg, const bf16_t* KAg, size_t qa_dir_stride, const bf16_t* KBT, const bf16_t* VT, const unsigned char* sc, bf16_t* HS, LAS unsigned char* lds) {
    constexpr int RS = 4 * DK;
    constexpr int QS = DK * 2 + 16, VS = 144;
    constexpr int NG = DK / 64;
    constexpr int OFF_QA = 0, OFF_KA = 64 * QS, OFF_KBT = 2 * 64 * QS, OFF_VT = OFF_KBT + DK * VS, OFF_PT = OFF_VT + 64 * VS, OFF_TAB = OFF_PT + 8192;
    static_assert(OFF_TAB + 8192 <= 135168, "LDS");
    const int tid = TID(), lane = tid & 63, wid = tid >> 6, m16 = lane & 15, quad = lane >> 4, dt = wid & 3, kh = wid >> 2;
    LAS float* aL = (LAS float*)(lds + OFF_TAB);
    LAS float* mxL = aL + 64; LAS float* bL = aL + 128;
    LAS float* rsL = aL + 256;
    LAS float* qnL = aL + 384;
    LAS float* nL = aL + 896;
    LAS float* decL = aL;
    LAS f32x4* XL = (LAS f32x4*)(lds + OFF_KA);
    const float* SA = (const float*)(sc + SC_SA); const float* SMX = (const float*)(sc + SC_SMX); const float* SB = (const float*)(sc + SC_SB); const float* CE = (const float*)(sc + SC_CE);
    const float* DEC = (const float*)(sc + SC_DEC);
    for (int item = BID(); item < 256; item += GDIM()) {
        const int dir = item >> 7, b = (item >> 4) & 7, h = (item >> 2) & 3, sl = item & 3;
        const bf16_t* QAd = QAg + dir * qa_dir_stride; const bf16_t* KAd = KAg + dir * qa_dir_stride;
        const bf16_t* KBTd = KBT + ((size_t)dir * 4 * DK + h * DK) * MTOT;
        const bf16_t* VTd = VT + (size_t)(h * 256 + sl * 64) * MTOT;
        f32x4 Cst[NG][2];
#pragma unroll
        for (int g = 0; g < NG; ++g) { Cst[g][0] = (f32x4){0.f, 0.f, 0.f, 0.f}; Cst[g][1] = (f32x4){0.f, 0.f, 0.f, 0.f}; }
        float mrun = 0.f;
        if (ML && tid < 256) nL[tid] = 0.f;
        constexpr int NQ = DK / 64;
        u32x4 pq[NQ], pk[NQ], pb[NQ], pv;
#define SCAN_ROW0(CI, R0) const int ci_ = (CI); const int cx_ = ci_ < 4 ? 256 + b * 4 + (dir ? 3 - ci_ : ci_) : b * 32 + (dir ? 35 - ci_ : ci_ - 4); const int R0 = chunk_row0(cx_);
#define SCAN_ISSUE_QK(CI) do { SCAN_ROW0(CI, r0_) \
            _Pragma("unroll") for (int i = 0; i < NQ; ++i) { const int c = tid + i * 512, r = c / (DK / 8), cc = c % (DK / 8); \
                pq[i] = *(const u32x4*)(QAd + (size_t)(r0_ + r) * RS + h * DK + cc * 8); pk[i] = *(const u32x4*)(KAd + (size_t)(r0_ + r) * RS + h * DK + cc * 8); } } while (0)
#define SCAN_ISSUE_BV(CI) do { SCAN_ROW0(CI, r0_) \
            _Pragma("unroll") for (int i = 0; i < NQ; ++i) { const int c = tid + i * 512, r = c >> 3, cc = c & 7; pb[i] = *(const u32x4*)(KBTd + (size_t)r * MTOT + r0_ + cc * 8); } \
            { const int r = tid >> 3, cc = tid & 7; pv = *(const u32x4*)(VTd + (size_t)r * MTOT + r0_ + cc * 8); } } while (0)
        SCAN_ISSUE_QK(0);
#pragma unroll 1
        for (int ci = 0; ci < 36; ++ci) {
            int cidx;
            if (ci < 4) cidx = 256 + b * 4 + (dir ? 3 - ci : ci); else cidx = b * 32 + (dir ? 35 - ci : ci - 4);
            const int row0 = chunk_row0(cidx);
#pragma unroll
            for (int i = 0; i < NQ; ++i) {
                const int c = tid + i * 512, r = c / (DK / 8), cc = c % (DK / 8);
                const int rho = ((r >> 5) * 2 + ((r >> 2) & 1)) * 16 + ((r >> 3) & 3) * 4 + (r & 3);
                *(LAS u32x4*)(lds + OFF_QA + r * QS + cc * 16) = pq[i]; *(LAS u32x4*)(lds + OFF_KA + rho * QS + cc * 16) = pk[i];
            }
            SCAN_ISSUE_BV(ci);
            float ae = 0.f, be = 0.f;
            if (ML) {
                if (tid < 64) aL[tid] = SA[(size_t)(dir * 4 + h) * MTOT + row0 + tid];
                else if (tid < 128) aL[tid] = SMX[(size_t)(dir * 4 + h) * MTOT + row0 + tid - 64];
                else if (tid < 192) aL[tid] = SB[(size_t)(dir * 4 + h) * MTOT + row0 + tid - 128];
                ae = CE[((dir * 4 + h) * 288 + cidx) * 2]; be = CE[((dir * 4 + h) * 288 + cidx) * 2 + 1];
            } else {
                if (tid < DK) decL[tid] = DEC[((size_t)dir * 288 + cidx) * 512 + h * DK + tid];
            }
            __syncthreads();
            f32x4 st[2] = {(f32x4){0.f, 0.f, 0.f, 0.f}, (f32x4){0.f, 0.f, 0.f, 0.f}};
#pragma unroll
            for (int ks = 0; ks < DK / 32; ++ks) {
                const bf16x8 Bq = *(LAS const bf16x8*)(lds + OFF_QA + (dt * 16 + m16) * QS + (ks * 32 + quad * 8) * 2);
#pragma unroll
                for (int T = 0; T < 2; ++T) {
                    const bf16x8 Ak = *(LAS const bf16x8*)(lds + OFF_KA + ((kh * 2 + T) * 16 + m16) * QS + (ks * 32 + quad * 8) * 2);
                    st[T] = __builtin_amdgcn_mfma_f32_16x16x32_bf16(Ak, Bq, st[T], 0, 0, 0);
                }
            }
            const int tloc = dt * 16 + m16;
            float Mt = 0.f;
            if (ML) Mt = fmaxf(mrun, mxL[tloc]);
            float rsum = 0.f;
#pragma unroll
            for (int T = 0; T < 2; ++T)
#pragma unroll
                for (int e = 0; e < 4; ++e) {
                    const int sloc = kh * 32 + quad * 8 + T * 4 + e;
                    const bool valid = dir ? (sloc >= tloc) : (sloc <= tloc);
                    float wgt = valid ? 1.f : 0.f;
                    if (ML) wgt = valid ? __expf(aL[sloc] - Mt) : 0.f;
                    const float pv = st[T][e] * wgt; st[T][e] = pv; rsum += pv;
                }
            *(LAS bf16x8*)(lds + OFF_PT + ((kh * 4 + dt) * 64 + lane) * 16) = pack8(st[0], st[1]);
            if (ML) {
                rsum += shx(rsum, 16); rsum += shx(rsum, 32);
                if (quad == 0) rsL[kh * 64 + tloc] = rsum;
                float qn = 0.f;
#pragma unroll
                for (int i = 0; i < 4; ++i) { float qf8[8]; unpack8(*(LAS const u32x4*)(lds + OFF_QA + lane * QS + (wid * 32 + i * 8) * 2), qf8);
#pragma unroll
                    for (int e = 0; e < 8; ++e) qn += qf8[e] * nL[wid * 32 + i * 8 + e]; }
                qnL[wid * 64 + lane] = qn;
            }
#pragma unroll
            for (int i = 0; i < NQ; ++i) {
                const int c = tid + i * 512, r = c >> 3, cc = c & 7;
                const int rho = (r & ~31) + ((r >> 2) & 1) * 16 + ((r >> 3) & 3) * 4 + (r & 3);
                *(LAS u32x4*)(lds + OFF_KBT + rho * VS + cc * 16) = pb[i];
            }
            { const int r = tid >> 3, cc = tid & 7; *(LAS u32x4*)(lds + OFF_VT + r * VS + cc * 16) = pv; }
            __syncthreads();
            if (ci + 1 < 36) SCAN_ISSUE_QK(ci + 1);
            f32x4 numT[4];
#pragma unroll
            for (int tt = 0; tt < 4; ++tt) numT[tt] = (f32x4){0.f, 0.f, 0.f, 0.f};
#pragma unroll
            for (int g = 0; g < NG; ++g) {
                const bf16x8 Ac = pack8(Cst[g][0], Cst[g][1]);
#pragma unroll
                for (int tt = 0; tt < 4; ++tt) {
                    const bf16x8 Bq = *(LAS const bf16x8*)(lds + OFF_QA + (tt * 16 + m16) * QS + (kh * (DK / 2) + g * 32 + quad * 8) * 2);
                    numT[tt] = __builtin_amdgcn_mfma_f32_16x16x32_bf16(Ac, Bq, numT[tt], 0, 0, 0);
                }
            }
            if (ML) {
#pragma unroll
                for (int tt = 0; tt < 4; ++tt) { const float wi = __expf(mrun - fmaxf(mrun, mxL[tt * 16 + m16])); numT[tt] = numT[tt] * wi; }
            }
            {
                const bf16x8 Av = *(LAS const bf16x8*)(lds + OFF_VT + (dt * 16 + m16) * VS + (kh * 32 + quad * 8) * 2);
#pragma unroll
                for (int tt = 0; tt < 4; ++tt) {
                    const bf16x8 Bp = *(LAS const bf16x8*)(lds + OFF_PT + ((kh * 4 + tt) * 64 + lane) * 16);
                    numT[tt] = __builtin_amdgcn_mfma_f32_16x16x32_bf16(Av, Bp, numT[tt], 0, 0, 0);
                }
            }
            {
                float cs = 1.f;
                if (ML) {
                    const float mm = fmaxf(mrun, ae), ratio = __expf(mrun - ae); cs = __expf(ae - mm);
#pragma unroll
                    for (int g = 0; g < NG; ++g) { Cst[g][0] = Cst[g][0] * ratio; Cst[g][1] = Cst[g][1] * ratio; }
                } else {
#pragma unroll
                    for (int g = 0; g < NG; ++g)
#pragma unroll
                        for (int T = 0; T < 2; ++T) { const f32x4 d4 = *(LAS const f32x4*)(decL + kh * (DK / 2) + g * 32 + quad * 8 + T * 4); Cst[g][T] = Cst[g][T] * d4; }
                }
#pragma unroll
                for (int k2 = 0; k2 < 2; ++k2) {
                    const bf16x8 Bv = *(LAS const bf16x8*)(lds + OFF_VT + (dt * 16 + m16) * VS + (k2 * 32 + quad * 8) * 2);
#pragma unroll
                    for (int g = 0; g < NG; ++g)
#pragma unroll
                        for (int T = 0; T < 2; ++T) {
                            const bf16x8 Ak = *(LAS const bf16x8*)(lds + OFF_KBT + (kh * (DK / 2) + g * 32 + T * 16 + m16) * VS + (k2 * 32 + quad * 8) * 2);
                            Cst[g][T] = __builtin_amdgcn_mfma_f32_16x16x32_bf16(Ak, Bv, Cst[g][T], 0, 0, 0);
                        }
                }
                if (ML) {
#pragma unroll
                    for (int g = 0; g < NG; ++g) { Cst[g][0] = Cst[g][0] * cs; Cst[g][1] = Cst[g][1] * cs; }
                }
            }
            XL[(dt * 4 + (1 - kh) * 2 + 0) * 64 + lane] = numT[(1 - kh) * 2 + 0];
            XL[(dt * 4 + (1 - kh) * 2 + 1) * 64 + lane] = numT[(1 - kh) * 2 + 1];
            if (ML && tid < 256) {
                const float mm = fmaxf(mrun, ae), wold = __expf(mrun - mm), cs = __expf(ae - mm);
                const int rho = (tid & ~31) + ((tid >> 2) & 1) * 16 + ((tid >> 3) & 3) * 4 + (tid & 3);
                float sm = 0.f;
#pragma unroll
                for (int i = 0; i < 8; ++i) { float kf8[8]; unpack8(*(LAS const u32x4*)(lds + OFF_KBT + rho * VS + i * 16), kf8);
#pragma unroll
                    for (int e = 0; e < 8; ++e) sm += kf8[e]; }
                nL[tid] = wold * nL[tid] + cs * sm;
            }
            __syncthreads();
            const bool want_out = ML || ci >= 4;
            if (want_out) {
#pragma unroll
                for (int q2 = 0; q2 < 2; ++q2) {
                    const int tt = kh * 2 + q2, t = tt * 16 + m16;
                    f32x4 v = (kh ? numT[2 + q2] : numT[q2]) + XL[(dt * 4 + tt) * 64 + lane];
                    if (ML) {
                        const float Mtt = fmaxf(mrun, mxL[t]), wi = __expf(mrun - Mtt);
                        float qn = 0.f;
#pragma unroll
                        for (int pp = 0; pp < 8; ++pp) qn += qnL[pp * 64 + t];
                        const float den = wi * qn + rsL[t] + rsL[64 + t];
                        v = v * (1.f / fmaxf(fabsf(den), __expf(-(bL[t] + Mtt))));
                    }
                    u32x2 o; o.x = pk2(v[0], v[1]); o.y = pk2(v[2], v[3]);
                    *(u32x2*)(HS + ((size_t)dir * MTOT + row0 + t) * D + h * 256 + sl * 64 + dt * 16 + quad * 4) = o;
                }
            }
            if (ML) { const float mm = fmaxf(mrun, ae); mrun = be + mm; }
            __syncthreads();
        }
    }
}

__device__ __forceinline__ bool phase_exists(int ph) {
    if (ph == 0 || ph == 49) return true;
    const int l = (ph - 1) / 12, k = (ph - 1) % 12;
    if (k == 6 || k == 7) return (l & 1) != 0;
    return true;
}
template <class Epi>
__device__ __forceinline__ void run_gemm(LAS unsigned char* lds, const bf16_t* A, const bf16_t* Bt, int M, int N, int K, const Epi& E) {
    pg8::Gemm g; g.A = A; g.Bt = Bt; g.M = M; g.N = N; g.K = K; g.Kc = K;
    pg8::StaticOrder S; S.init(M, N, K, (int)GDIM(), (int)BID());
    pg8::gemm_phase<Epi, pg8::StaticOrder, true, true>(lds, g, S, E);
}
static_assert((WS_DP - WS_H) / 4 == (size_t)pg8::DPOFF && (WS_DP - WS_H) % 4 == 0, "DPOFF");
__device__ __forceinline__ void run_resid_gemm(LAS unsigned char* lds, const bf16_t* A, const bf16_t* Bt, int Mr, int K, float* H, const float* gate) {
    pg8::EpiResid E; E.H = H; E.gate = gate;
    pg8::Gemm g; g.A = A; g.Bt = Bt; g.M = Mr; g.N = D; g.K = K; g.Kc = K;
    pg8::ResidOrder S; S.init(K, Mr == MTOT ? 1 : 0, (int)GDIM(), (int)BID());
    pg8::gemm_phase<pg8::EpiResid, pg8::ResidOrder, true, true>(lds, g, S, E);
}
__device__ void run_phase(const Args& a, int ph, LAS unsigned char* lds) {
    unsigned char* ws = a.ws; asm volatile("" : "+s"(ws));
    float* H = (float*)(ws + WS_H); bf16_t* U = (bf16_t*)(ws + WS_U); bf16_t* P = (bf16_t*)(ws + WS_P); float* G32 = (float*)(ws + WS_G32);
    bf16_t* QC = (bf16_t*)(ws + WS_QC); bf16_t* KC = (bf16_t*)(ws + WS_KC); bf16_t* HS = (bf16_t*)(ws + WS_HS); bf16_t* KBT = (bf16_t*)(ws + WS_KBT); const bf16_t* VTb = (const bf16_t*)(ws + WS_VT); unsigned char* scb = ws + WS_SC;
    if (ph == 0) { p0_prologue(a, lds); return; }
    if (ph == 49) { final_norm_phase(H, a.in[I_FINALG], a.out); return; }
    const int l = (ph - 1) / 12, k = (ph - 1) % 12;
    const float* modl = (const float*)(ws + WS_MOD) + (size_t)l * 9 * MODLD;
    const float* ng = a.in[I_NORMG] + (size_t)l * 3 * D;
    switch (k) {
    case 0: norm_phase(H, ng, modl, 0, U, MTOT, l > 0 ? (const float*)(ws + WS_DP) : nullptr); break;
    case 1: case 10: { const int f = k == 10 ? 1 : 0; pg8::EpiSwiglu E; E.O = P; E.ldc = DFF; run_gemm(lds, U, (const bf16_t*)(ws + WS_W13T + (size_t)(l * 2 + f) * W13T_SZ), (l == 3 && f == 1) ? MLAT : MTOT, 2 * DFF, D, E); } break;
    case 2: case 8: case 11: {
        const int Mr = (l == 3 && k >= 8) ? MLAT : MTOT;
        const bf16_t* A = k == 8 ? U : P; const int K = k == 8 ? D : DFF;
        const bf16_t* Bt = (const bf16_t*)(ws + (k == 8 ? WS_WO + (size_t)l * D * D * 2 : WS_W2T + (size_t)(l * 2 + (k == 11 ? 1 : 0)) * W2T_SZ));
        run_resid_gemm(lds, A, Bt, Mr, K, H, modl + (k == 2 ? 2 : k == 8 ? 5 : 8) * D);
    } break;
    case 3: norm_phase(H, ng + D, modl, 3, U, MTOT, (const float*)(ws + WS_DP)); break;
    case 4: {
        const size_t woff = l == 0 ? WS_WIN0 : l == 1 ? WS_WIN1 : l == 2 ? WS_WIN2 : WS_WIN3;
        if (l == 2 || l == 0) { pg8::EpiProjAttn E; E.P = P; E.VT = (bf16_t*)(ws + WS_VT); E.R = (const float*)(ws + WS_ROPE); E.rope = l == 2 ? 1 : 0; run_gemm(lds, U, (const bf16_t*)(ws + woff), MTOT, 3072, D, E); }
        else { pg8::EpiProj E; E.P = P; E.G32 = G32; E.ldc = NPAD_IN[l]; E.gcol0 = l == 1 ? 2048 : (l == 3 ? 1536 : 1 << 30); E.gn = l == 1 ? 16 : 32; E.VT = (bf16_t*)(ws + WS_VT); E.vcol0 = l == 1 ? 1024 : (l == 3 ? 512 : 1 << 30);
            run_gemm(lds, U, (const bf16_t*)(ws + woff), MTOT, NPAD_IN[l], D, E); }
    } break;
    case 5:
        if (l == 0) na_mfma_phase(P, VTb, a.in[I_NARPB], U);
        else if (l == 1) ml_prep3_phase(P, G32, a.in[I_MLGB], a.in[I_MLCONV], QC, KC, KBT, scb, lds);
        else if (l == 2) da_flash_phase(P, (const bf16_t*)(ws + WS_VT), a.in[I_DALAM], a.in[I_DANG], U, lds);
        else gla_prep3_phase(P, G32, a.in[I_GLAGU], a.in[I_GLABG], QC, KC, KBT, scb, lds);
        break;
    case 6:
        if (l == 1) chunk_scan_phase<256, true>(QC, KC, 0, KBT, VTb, scb, HS, lds);
        else if (l == 3) chunk_scan_phase<128, false>(QC, KC, (size_t)MTOT * 512, KBT, VTb, scb, HS, lds);
        break;
    case 7:
        if (l == 1) ml_readout_phase(P, HS, a.in[I_MLNG], U);
        else if (l == 3) gla_readout_phase(P, HS, a.in[I_GLANG], U);
        break;
    case 9: norm_phase(H, ng + 2 * D, modl, 6, U, l == 3 ? MLAT : MTOT, (const float*)(ws + WS_DP)); break;
    }
}


#define XB_TMO      128
#define XB_XCNT(j)  (256  + 64 * (j))
#define XB_XSUB(j)  (1280 + 64 * (j))
#define XB_XGEN(j)  (2304 + 64 * (j))
#define XB_TOP      3328
#define XB_TOPGEN   3392
#define XCD_BAR_WORDS 3456
#define XB_SPIN_CAP (1u << 18)

__device__ __forceinline__ unsigned xb_ld(unsigned* p)              { return __hip_atomic_load(p, __ATOMIC_RELAXED, __HIP_MEMORY_SCOPE_AGENT); }
__device__ __forceinline__ unsigned xb_add(unsigned* p, unsigned v) { return __hip_atomic_fetch_add(p, v, __ATOMIC_RELAXED, __HIP_MEMORY_SCOPE_AGENT); }
__device__ __forceinline__ unsigned xb_xcc_id() { return (unsigned)__builtin_amdgcn_s_getreg((3 << 11) | 20) & 0xFu; }
#define XB_SPIN(cond, bar) do { unsigned _sp = 0; while (cond) { __builtin_amdgcn_s_sleep(1); \
    if ((++_sp & 255u) == 0u) { if (xb_ld(&(bar)[XB_TMO])) break; if (_sp > XB_SPIN_CAP) { atomicAdd(&(bar)[XB_TMO], 1u); break; } } } } while (0)

struct XcdBarrier {
    unsigned* bar; unsigned x;
    volatile LAS unsigned* st;
};

__device__ __forceinline__ XcdBarrier xcd_barrier_post(unsigned* bar, volatile LAS unsigned* st) {
    XcdBarrier b; b.bar = bar; b.x = xb_xcc_id(); b.st = st;
    if (threadIdx.x == 0) (void)xb_add(&bar[XB_XCNT(b.x)], 1u);
    return b;
}
__device__ __forceinline__ void xcd_barrier_complete(unsigned* bar, unsigned x, unsigned& nloc, unsigned& nx) {
    const unsigned G = gridDim.x * gridDim.y * gridDim.z;
    unsigned sum, cnt, mine, sp = 0u;
    for (;;) {
        sum = 0u; cnt = 0u; mine = 0u;
#pragma unroll
        for (unsigned j = 0; j < 16; ++j) { const unsigned c = xb_ld(&bar[XB_XCNT(j)]); sum += c; cnt += (c > 0u) ? 1u : 0u; mine = (j == x) ? c : mine; }
        if (sum == G) break;
        __builtin_amdgcn_s_sleep(1);
        if ((++sp & 255u) == 0u) { if (xb_ld(&bar[XB_TMO])) break; if (sp > XB_SPIN_CAP) { atomicAdd(&bar[XB_TMO], 1u); break; } }
    }
    nloc = mine > 0u ? mine : 1u; nx = cnt > 0u ? cnt : 1u;
}

__device__ __forceinline__ void xcd_barrier(const XcdBarrier& b) {
    asm volatile("s_waitcnt vmcnt(0)" ::: "memory");
    __syncthreads();
    if (threadIdx.x == 0) {
        unsigned* bar = b.bar;
        __builtin_amdgcn_s_waitcnt(0);
        unsigned nloc = b.st[0], nx = b.st[1];
        if (nloc == 0u) { xcd_barrier_complete(bar, b.x, nloc, nx); b.st[0] = nloc; b.st[1] = nx; }
        const unsigned old = xb_add(&bar[XB_XSUB(b.x)], 1u);
        const unsigned gen = old / nloc;
        if (old + 1u == (gen + 1u) * nloc) {
            __builtin_amdgcn_fence(__ATOMIC_RELEASE, "agent");
            asm volatile("s_waitcnt vmcnt(0)" ::: "memory");
            const unsigned og = xb_add(&bar[XB_TOP], 1u);
            const unsigned tg = og / nx;
            if (og + 1u == (tg + 1u) * nx) xb_add(&bar[XB_TOPGEN], 1u);
            else XB_SPIN(xb_ld(&bar[XB_TOPGEN]) == tg, bar);
            __builtin_amdgcn_fence(__ATOMIC_ACQUIRE, "agent");
            xb_add(&bar[XB_XGEN(b.x)], 1u);
            asm volatile("s_waitcnt vmcnt(0)" ::: "memory");
        } else {
            XB_SPIN(xb_ld(&bar[XB_XGEN(b.x)]) == gen, bar);
            __builtin_amdgcn_fence(__ATOMIC_ACQUIRE, "agent");
            asm volatile("s_waitcnt vmcnt(0)" ::: "memory");
        }
    }
    __syncthreads();
}

constexpr int LDS_BYTES = 135168;
__global__ void __launch_bounds__(512) mega(Args a) {
    extern __shared__ __attribute__((aligned(16))) unsigned char lds_raw[];
    LAS unsigned char* lds = (LAS unsigned char*)lds_raw;
    cg::grid_group grid = cg::this_grid();
    volatile LAS unsigned* xbst = (volatile LAS unsigned*)(lds + LDS_BYTES - 16);
    if (threadIdx.x == 0) { xbst[0] = 0u; xbst[1] = 0u; }
    __syncthreads();
    const XcdBarrier xb = xcd_barrier_post((unsigned*)(a.ws + WS_BAR), xbst);
    int nsync = 0;
    for (int ph = a.ph_lo; ph < a.ph_hi; ++ph) {
        if (!phase_exists(ph)) continue;
        if (nsync == 1) grid.sync();
        else if (nsync > 1) xcd_barrier(xb);
        ++nsync;
        run_phase(a, ph, lds);
        __syncthreads();
    }
}

extern "C" void kernel_launch(void* const* d_in, const int* in_sizes, int n_in, void* d_out, int out_size,
                              void* d_ws, size_t ws_size, hipStream_t stream) {
    static int grid = 0;
    if (grid == 0) {
        int dev = 0, cus = 0, per_cu = 0;
        (void)hipGetDevice(&dev);
        (void)hipDeviceGetAttribute(&cus, hipDeviceAttributeMultiprocessorCount, dev);
        (void)hipFuncSetAttribute((const void*)mega, hipFuncAttributeMaxDynamicSharedMemorySize, LDS_BYTES);
        (void)hipOccupancyMaxActiveBlocksPerMultiprocessor(&per_cu, (const void*)mega, 512, LDS_BYTES);
        grid = cus > 0 ? cus : 256;
        if (n_in != N_IN || ws_size < WS_END) { fprintf(stderr, "kernel_launch: n_in %d ws %zu (need %zu)\n", n_in, ws_size, (size_t)WS_END); }
    }
    (void)hipMemsetAsync((unsigned char*)d_ws + WS_BAR, 0, 16384, stream);
    Args a{};
    for (int i = 0; i < N_IN; ++i) a.in[i] = (const float*)d_in[i];
    a.out = (float*)d_out; a.ws = (unsigned char*)d_ws; a.ph_lo = 0; a.ph_hi = 50;
    void* args[] = {&a};
    hipError_t e = hipLaunchCooperativeKernel((const void*)mega, dim3(grid), dim3(512), args, LDS_BYTES, stream);
    if (e != hipSuccess) fprintf(stderr, "cooperative launch failed: %s\n", hipGetErrorString(e));
}
```

```cpp
#include <hip/hip_runtime.h>
#include <hip/hip_cooperative_groups.h>
#include <cstdio>
#include <cstdint>
__device__ __forceinline__ int TID() { int t = threadIdx.x; asm volatile("" : "+v"(t)); return t; }
__device__ __forceinline__ int GDIM() { int t = gridDim.x; asm volatile("" : "+s"(t)); return t; }
__device__ __forceinline__ float shx(float v, int o) { const int lane = TID() & 63; return __builtin_bit_cast(float, __builtin_amdgcn_ds_bpermute((lane ^ o) << 2, __builtin_bit_cast(int, v))); }
__device__ __forceinline__ float rdl(float v, int src) { return __builtin_bit_cast(float, __builtin_amdgcn_readlane(__builtin_bit_cast(int, v), src)); }
__device__ __forceinline__ int BID() { int t = blockIdx.x; asm volatile("" : "+s"(t)); return t; }
namespace pg8 {
#define PG8_LAS __attribute__((address_space(3)))
typedef unsigned short bf16_t;
typedef short bf16x8 __attribute__((ext_vector_type(8)));
typedef float f32x4 __attribute__((ext_vector_type(4)));
typedef unsigned u32x4 __attribute__((ext_vector_type(4)));
constexpr int BM = 256, BK = 64, HALF = 128, HTB = HALF * BK * 2  , STAGE_BYTES = 8 * HTB, NXCD = 8, WGM = 8;

__host__ __device__ __forceinline__ int lds_byte(int r, int c) { const int st = (r >> 4) * 2 + (c >> 5), rr = r & 15, cc = c & 31, ob = rr * 64 + cc * 2; return st * 1024 + (ob ^ (((ob >> 9) & 1) << 5)); }
__host__ __device__ __forceinline__ void stage_rc(int b, int& R, int& C) { const int st = b / 1024, sb = b % 1024, swz = sb ^ (((sb >> 9) & 1) << 5); R = (st >> 1) * 16 + swz / 64; C = (st & 1) * 32 + (swz % 64) / 2; }
__host__ __device__ __forceinline__ int perm32(int rho) { const int n = rho >> 4, i = rho & 15; return 8 * (i >> 2) + 4 * n + (i & 3); }

struct Unit { int pm, pn, k0t, nt, sp; };
struct Gemm { const bf16_t* A; const bf16_t* Bt; int M, N, K, Kc; };

struct StaticOrder {
    int nM, nN, nwg, G, c, ntk;
    __host__ __device__ void init(int M, int N, int K, int G_, int c_) { nM = M / BM; nN = N / BM; nwg = nM * nN; G = G_; c = c_; ntk = K / BK; }
    __host__ __device__ bool next(int i, Unit& u) const {
        const long L = (long)i * G + c; if (L >= nwg) return false;
        u.k0t = 0; u.nt = ntk; u.sp = 0;
        int wgid = (int)L; { const int q = nwg / NXCD, r = nwg % NXCD, xcd = wgid % NXCD, off = wgid / NXCD; wgid = (xcd < r ? xcd * (q + 1) : r * (q + 1) + (xcd - r) * q) + off; }
        const int nig = WGM * nN, gid = wgid / nig, fm = gid * WGM, gsz = (nM - fm) < WGM ? (nM - fm) : WGM;
        u.pm = fm + ((wgid % nig) % gsz); u.pn = (wgid % nig) / gsz; return true;
    }
    __device__ __forceinline__ void a_ready(const Unit&) const {}
    __device__ __forceinline__ void done(const Unit&) const {}
};

struct ResidOrder {
    StaticOrder lat; int nctx, ntk, G, c;
    __host__ __device__ void init(int K, int with_ctx, int G_, int c_) { lat.init(16384, 1024, K, G_, c_); nctx = with_ctx ? 128 : 0; ntk = K / BK; G = G_; c = c_; }
    __host__ __device__ bool next(int i, Unit& u) const {
        Unit a; a.pm = 0; a.pn = 0; a.k0t = 0; a.nt = ntk; a.sp = 0;
        const bool is_lat = lat.next(i, a);
        const long L = (long)i * G + c - lat.nwg;
        const int j = (int)L, sp = j & 3, tile = j >> 2;
        const int q4 = (ntk / 4) & ~1, big = (ntk - 4 * q4) / 2;
        const int e0 = 2 * (int)(big > 0), e2 = 2 * (int)(big > 1);
        const int cnt = q4 + e0 * (int)(sp == 0) + e2 * (int)(sp == 2), ck0 = sp * q4 + e0 * (int)(sp >= 1) + e2 * (int)(sp >= 3);
        u.pm = is_lat ? a.pm : 64 + (tile >> 2); u.pn = is_lat ? a.pn : (tile & 3); u.sp = is_lat ? 0 : sp; u.nt = is_lat ? ntk : cnt; u.k0t = is_lat ? 0 : ck0;
        return is_lat || L < nctx;
    }
    __device__ __forceinline__ void a_ready(const Unit&) const {}
    __device__ __forceinline__ void done(const Unit&) const {}
};

__device__ __forceinline__ unsigned cvt_pk_bf16(float lo, float hi) { unsigned r; asm volatile("v_cvt_pk_bf16_f32 %0, %1, %2" : "=v"(r) : "v"(lo), "v"(hi)); return r; }
typedef unsigned u32x2 __attribute__((ext_vector_type(2)));
__device__ __forceinline__ float silu_f(float x) { return x / (1.f + __expf(-x)); }
struct EpiSwiglu {
    static constexpr bool PERM = true, AFTER_DRAIN = false;
    bf16_t* O; int ldc;
    __device__ __forceinline__ void operator()(const f32x4 (&acc)[2][2][4][2], const Unit& u, int wr, int wc, int fr, int fq) const {
        const int row0 = u.pm * BM + wr * 64 + fr, col0 = u.pn * HALF + wc * 32 + 8 * fq;
#pragma unroll
        for (int ai = 0; ai < 2; ++ai)
#pragma unroll
            for (int m = 0; m < 4; ++m) {
                bf16_t* rowp = O + (size_t)(row0 + ai * HALF + m * 16) * ldc + col0;
                const f32x4 g0 = acc[ai][0][m][0], g1 = acc[ai][0][m][1], u0 = acc[ai][1][m][0], u1 = acc[ai][1][m][1];
                u32x4 w;
                w.x = cvt_pk_bf16(silu_f(g0[0]) * u0[0], silu_f(g0[1]) * u0[1]);
                w.y = cvt_pk_bf16(silu_f(g0[2]) * u0[2], silu_f(g0[3]) * u0[3]);
                w.z = cvt_pk_bf16(silu_f(g1[0]) * u1[0], silu_f(g1[1]) * u1[1]);
                w.w = cvt_pk_bf16(silu_f(g1[2]) * u1[2], silu_f(g1[3]) * u1[3]);
                *(u32x4*)rowp = w;
            }
    }
};
constexpr long DPOFF = 116195328;
struct EpiResid {
    static constexpr bool PERM = false, AFTER_DRAIN = false;
    float* H; const float* gate;
    __device__ __forceinline__ void operator()(const f32x4 (&acc)[2][2][4][2], const Unit& u, int wr, int wc, int fr, int fq) const {
        const int mrow = u.pm < 64 ? (u.pm >> 3) : 8;
        const float* gp = gate + (size_t)mrow * 9216; float* DP = H + DPOFF;
        const int row0 = u.pm * BM + wr * 64 + fr, col0 = u.pn * BM + wc * 32 + 4 * fq;
#pragma unroll
        for (int bj = 0; bj < 2; ++bj)
#pragma unroll
            for (int n = 0; n < 2; ++n) {
                const int col = col0 + bj * HALF + n * 16;
                const f32x4 g = *(const f32x4*)(gp + col);
#pragma unroll
                for (int ai = 0; ai < 2; ++ai)
#pragma unroll
                    for (int m = 0; m < 4; ++m) {
                        float* hp = H + (size_t)(row0 + ai * HALF + m * 16) * 1024 + col;
                        const f32x4 d = g * acc[ai][bj][m][n];
                        if (u.sp) *(f32x4*)(DP + ((size_t)(u.sp - 1) * 2048 + (row0 + ai * HALF + m * 16 - 16384)) * 1024 + col) = d;
                        else { f32x4 h = *(const f32x4*)hp; h = h + d; *(f32x4*)hp = h; }
                    }
            }
    }
};
struct EpiProj {
    static constexpr bool PERM = true, AFTER_DRAIN = false;
    bf16_t* P; int ldc; float* G32; int gcol0, gn; bf16_t* VT; int vcol0;
    __device__ __forceinline__ void operator()(const f32x4 (&acc)[2][2][4][2], const Unit& u, int wr, int wc, int fr, int fq) const {
        const int row0 = u.pm * BM + wr * 64 + fr, col0 = u.pn * BM + wc * 32 + 8 * fq;
#pragma unroll
        for (int bj = 0; bj < 2; ++bj) {
            const int col = col0 + bj * HALF;
            const bool gs = (col >= gcol0) && (col < gcol0 + gn);
            const bool vs = (col >= vcol0) && (col < vcol0 + 1024);
#pragma unroll
            for (int ai = 0; ai < 2; ++ai)
#pragma unroll
                for (int m = 0; m < 4; ++m) {
                    const size_t row = (size_t)(row0 + ai * HALF + m * 16);
                    const f32x4 v0 = acc[ai][bj][m][0], v1 = acc[ai][bj][m][1];
                    u32x4 w; w.x = cvt_pk_bf16(v0[0], v0[1]); w.y = cvt_pk_bf16(v0[2], v0[3]); w.z = cvt_pk_bf16(v1[0], v1[1]); w.w = cvt_pk_bf16(v1[2], v1[3]);
                    *(u32x4*)(P + row * ldc + col) = w;
                    if (gs) { float* gp = G32 + row * 32 + (col - gcol0); *(f32x4*)gp = v0; *(f32x4*)(gp + 4) = v1; }
                    if (vs) { bf16_t* vp = VT + (size_t)(col - vcol0) * 18432 + row;
                        vp[0] = (bf16_t)(w.x & 0xffffu); vp[18432] = (bf16_t)(w.x >> 16); vp[2 * 18432] = (bf16_t)(w.y & 0xffffu); vp[3 * 18432] = (bf16_t)(w.y >> 16);
                        vp[4 * 18432] = (bf16_t)(w.z & 0xffffu); vp[5 * 18432] = (bf16_t)(w.z >> 16); vp[6 * 18432] = (bf16_t)(w.w & 0xffffu); vp[7 * 18432] = (bf16_t)(w.w >> 16); }
                }
        }
    }
};

struct EpiProjAttn {
    static constexpr bool PERM = false, AFTER_DRAIN = false;
    bf16_t* P; bf16_t* VT; const float* R; int rope;
    __device__ __forceinline__ void operator()(const f32x4 (&acc)[2][2][4][2], const Unit& u, int wr, int wc, int fr, int fq) const {
        const int sec = u.pn >> 2;
        const int row0 = u.pm * BM + wr * 64 + fr, col0 = u.pn * BM + wc * 32 + 4 * fq;
        if (sec == 1) {
#pragma unroll
            for (int ai = 0; ai < 2; ++ai)
#pragma unroll
                for (int m = 0; m < 4; ++m) {
                    const int row = row0 + ai * HALF + m * 16;
#pragma unroll
                    for (int bj = 0; bj < 2; ++bj)
#pragma unroll
                        for (int n = 0; n < 2; ++n) {
                            const int col = col0 + bj * HALF + n * 16 - 1024;
                            const f32x4 v = acc[ai][bj][m][n];
#pragma unroll
                            for (int e = 0; e < 4; ++e) VT[(size_t)(col + e) * 18432 + row] = (bf16_t)(cvt_pk_bf16(v[e], 0.f) & 0xffffu);
                        }
                }
            return;
        }
        const float sc = sec == 2 ? 0.125f : 1.f;
        const bool do_rope = rope && u.pm < 64;
        const int axis = wc & 1;
#pragma unroll
        for (int ai = 0; ai < 2; ++ai)
#pragma unroll
            for (int m = 0; m < 4; ++m) {
                const int row = row0 + ai * HALF + m * 16;
                f32x4 cs = (f32x4){1.f, 1.f, 1.f, 1.f}, sn = (f32x4){0.f, 0.f, 0.f, 0.f};
                if (do_rope) { const int t = row & 2047, pos = axis ? (t & 63) : (t >> 6); cs = *(const f32x4*)(R + pos * 16 + 4 * fq); sn = *(const f32x4*)(R + 1024 + pos * 16 + 4 * fq); }
#pragma unroll
                for (int bj = 0; bj < 2; ++bj) {
                    const f32x4 x1 = acc[ai][bj][m][0] * sc, x2 = acc[ai][bj][m][1] * sc;
                    const f32x4 y1 = x1 * cs - x2 * sn, y2 = x2 * cs + x1 * sn;
                    bf16_t* pp = P + (size_t)row * 3072 + col0 + bj * HALF;
                    u32x2 o1, o2; o1.x = cvt_pk_bf16(y1[0], y1[1]); o1.y = cvt_pk_bf16(y1[2], y1[3]); o2.x = cvt_pk_bf16(y2[0], y2[1]); o2.y = cvt_pk_bf16(y2[2], y2[3]);
                    *(u32x2*)pp = o1; *(u32x2*)(pp + 16) = o2;
                }
            }
    }
};

template <class Epi, class Sched, bool ALIGN_EPI = false, bool SP2 = false>
__device__ __forceinline__ void gemm_phase(PG8_LAS unsigned char* lds, const Gemm g, const Sched& S, const Epi& E) {
    const int tid = TID(), wid = __builtin_amdgcn_readfirstlane(tid >> 6), lane = tid & 63, wr = wid >> 2, wc = wid & 3, fr = lane & 15, fq = lane >> 4;
    const int K = g.K;
    unsigned voffA[2], voffB[2];
#pragma unroll
    for (int i = 0; i < 2; ++i) { int R, C; stage_rc(tid * 16 + i * 8192, R, C); const int Rb = Epi::PERM ? ((R & ~31) + perm32(R & 31)) : R;
        voffA[i] = (unsigned)(R * K + C) * 2u; voffB[i] = (unsigned)(Rb * K + C) * 2u; }
    const size_t kstep = (size_t)(BK * 2);
    const size_t hstep = (size_t)HALF * K * 2;
    const size_t tstep = 2 * hstep;
    const unsigned ldsw = (unsigned)wid * 1024u;
    const int aoff = lds_byte(wr * 64 + fr, fq * 8), boff = lds_byte(wc * 32 + fr, fq * 8);
#define PG8_SA(b, h) (((b) * 2 + (h)) * HTB)
#define PG8_SB(b, h) ((4 + (b) * 2 + (h)) * HTB)
#define PG8_STAGE(bufoff, gbase, voff) do { _Pragma("unroll") for (int _i = 0; _i < 2; ++_i) \
        __builtin_amdgcn_global_load_lds((const unsigned*)((const char*)(gbase) + (voff)[_i]), (PG8_LAS unsigned*)(lds + (bufoff) + ldsw + _i * 8192), 16, 0, 0); } while (0)
#define PG8_LDA(dst, b, h) do { _Pragma("unroll") for (int m = 0; m < 4; ++m) _Pragma("unroll") for (int k = 0; k < 2; ++k) dst[m][k] = *(const PG8_LAS bf16x8*)(lds + PG8_SA(b, h) + aoff + m * 2048 + k * 1024); } while (0)
#define PG8_LDB(dst, b, h) do { _Pragma("unroll") for (int n = 0; n < 2; ++n) _Pragma("unroll") for (int k = 0; k < 2; ++k) dst[n][k] = *(const PG8_LAS bf16x8*)(lds + PG8_SB(b, h) + boff + n * 2048 + k * 1024); } while (0)
#define PG8_MMA(ai, bj, At, Bt) do { __builtin_amdgcn_s_setprio(1); _Pragma("unroll") for (int m = 0; m < 4; ++m) _Pragma("unroll") for (int n = 0; n < 2; ++n) _Pragma("unroll") for (int k = 0; k < 2; ++k) \
        acc[ai][bj][m][n] = __builtin_amdgcn_mfma_f32_16x16x32_bf16(Bt[n][k], At[m][k], acc[ai][bj][m][n], 0, 0, 0); __builtin_amdgcn_s_setprio(0); } while (0)
#define PG8_WAIT_V(n) asm volatile("s_waitcnt vmcnt(" #n ")" ::: "memory")
#define PG8_WAIT_L(n) asm volatile("s_waitcnt lgkmcnt(" #n ")" ::: "memory")
#define PG8_BAR __builtin_amdgcn_s_barrier()
#define PG8_SCHED __builtin_amdgcn_sched_barrier(0)
    Unit cur, nxt; int ui = 0;
    if (!S.next(0, cur)) return;
    f32x4 acc[2][2][4][2];
#pragma unroll
    for (int a = 0; a < 2; ++a)
#pragma unroll
        for (int b = 0; b < 2; ++b)
#pragma unroll
            for (int m = 0; m < 4; ++m)
#pragma unroll
                for (int n = 0; n < 2; ++n) acc[a][b][m][n] = (f32x4){0.f, 0.f, 0.f, 0.f};
    bf16x8 At[4][2], B0[2][2], B1[2][2];
    const char* cA = (const char*)g.A + (size_t)cur.pm * tstep + (size_t)cur.k0t * kstep; const char* cB = (const char*)g.Bt + (size_t)cur.pn * tstep + (size_t)cur.k0t * kstep;
    S.a_ready(cur);
    if constexpr (SP2) {
        PG8_STAGE(PG8_SB(0, 0), cB, voffB); PG8_STAGE(PG8_SB(0, 1), cB + hstep, voffB); PG8_STAGE(PG8_SA(0, 0), cA, voffA); PG8_STAGE(PG8_SA(0, 1), cA + hstep, voffA);
        if (wr == 1) PG8_BAR;
        PG8_WAIT_V(2); PG8_BAR;
        PG8_STAGE(PG8_SB(1, 0), cB + kstep, voffB); PG8_STAGE(PG8_SA(1, 0), cA + kstep, voffA); PG8_STAGE(PG8_SB(1, 1), cB + hstep + kstep, voffB);
        PG8_WAIT_V(6); PG8_BAR;
    } else {
        PG8_STAGE(PG8_SB(0, 0), cB, voffB); PG8_STAGE(PG8_SA(0, 0), cA, voffA); PG8_STAGE(PG8_SB(0, 1), cB + hstep, voffB); PG8_STAGE(PG8_SA(0, 1), cA + hstep, voffA);
        if (wr == 1) PG8_BAR;
        PG8_WAIT_V(4); PG8_BAR;
        PG8_STAGE(PG8_SB(1, 0), cB + kstep, voffB); PG8_STAGE(PG8_SA(1, 0), cA + kstep, voffA); PG8_STAGE(PG8_SB(1, 1), cB + hstep + kstep, voffB);
        PG8_WAIT_V(6); PG8_BAR;
    }
    for (;;) {
        const bool has_next = S.next(ui + 1, nxt);
        const char* nA = has_next ? (const char*)g.A + (size_t)nxt.pm * tstep + (size_t)nxt.k0t * kstep : cA; const char* nB = has_next ? (const char*)g.Bt + (size_t)nxt.pn * tstep + (size_t)nxt.k0t * kstep : cB;
        const int nt = cur.nt;
        for (int t = 0; t < nt; t += 2) {
            const bool last = (t == nt - 2);
            const char* a1 = cA + (size_t)(t + 1) * kstep;
            const char* a2 = last ? nA : cA + (size_t)(t + 2) * kstep; const char* b2 = last ? nB : cB + (size_t)(t + 2) * kstep;
            const char* a3 = a2 + kstep; const char* b3 = b2 + kstep;
            if (last && has_next) S.a_ready(nxt);
            if constexpr (SP2) {
            PG8_LDB(B0, 0, 0); PG8_LDB(B1, 0, 1); PG8_SCHED; PG8_LDA(At, 0, 0); PG8_STAGE(PG8_SA(1, 1), a1 + hstep, voffA);
            PG8_WAIT_V(8); PG8_WAIT_L(0); PG8_BAR; PG8_MMA(0, 0, At, B0); PG8_MMA(0, 1, At, B1); PG8_BAR; PG8_SCHED;
            PG8_LDA(At, 0, 1); PG8_STAGE(PG8_SB(0, 0), b2, voffB); PG8_STAGE(PG8_SB(0, 1), b2 + hstep, voffB); PG8_STAGE(PG8_SA(0, 0), a2, voffA);
            PG8_WAIT_V(8); PG8_WAIT_L(0); PG8_BAR; PG8_MMA(1, 0, At, B0); PG8_MMA(1, 1, At, B1); PG8_BAR; PG8_SCHED;
            PG8_LDB(B0, 1, 0); PG8_LDB(B1, 1, 1); PG8_SCHED; PG8_LDA(At, 1, 0); PG8_STAGE(PG8_SA(0, 1), a2 + hstep, voffA);
            PG8_WAIT_V(8); PG8_WAIT_L(0); PG8_BAR; PG8_MMA(0, 0, At, B0); PG8_MMA(0, 1, At, B1); PG8_BAR; PG8_SCHED;
            PG8_LDA(At, 1, 1); PG8_STAGE(PG8_SB(1, 0), b3, voffB); PG8_STAGE(PG8_SB(1, 1), b3 + hstep, voffB); PG8_STAGE(PG8_SA(1, 0), a3, voffA);
            PG8_WAIT_V(8); PG8_WAIT_L(0); PG8_BAR; PG8_MMA(1, 0, At, B0); PG8_MMA(1, 1, At, B1); PG8_BAR; PG8_SCHED;
            } else {
            PG8_LDB(B0, 0, 0); PG8_SCHED; PG8_LDA(At, 0, 0); PG8_STAGE(PG8_SA(1, 1), a1 + hstep, voffA);
            PG8_WAIT_L(8); PG8_BAR; PG8_WAIT_L(0); PG8_MMA(0, 0, At, B0); PG8_BAR; PG8_SCHED;
            PG8_LDB(B1, 0, 1); PG8_STAGE(PG8_SB(0, 0), b2, voffB);
            PG8_BAR; PG8_WAIT_L(0); PG8_MMA(0, 1, At, B1); PG8_BAR;
            PG8_LDA(At, 0, 1); PG8_STAGE(PG8_SA(0, 0), a2, voffA);
            PG8_BAR; PG8_WAIT_L(0); PG8_MMA(1, 0, At, B0); PG8_BAR; PG8_SCHED;
            PG8_STAGE(PG8_SB(0, 1), b2 + hstep, voffB);
            PG8_WAIT_V(6); PG8_BAR; PG8_MMA(1, 1, At, B1); PG8_BAR;
            PG8_LDB(B0, 1, 0); PG8_SCHED; PG8_LDA(At, 1, 0); PG8_STAGE(PG8_SA(0, 1), a2 + hstep, voffA);
            PG8_WAIT_L(8); PG8_BAR; PG8_WAIT_L(0); PG8_MMA(0, 0, At, B0); PG8_BAR; PG8_SCHED;
            PG8_LDB(B1, 1, 1); PG8_STAGE(PG8_SB(1, 0), b3, voffB);
            PG8_BAR; PG8_WAIT_L(0); PG8_MMA(0, 1, At, B1); PG8_BAR;
            PG8_LDA(At, 1, 1); PG8_STAGE(PG8_SA(1, 0), a3, voffA);
            PG8_BAR; PG8_WAIT_L(0); PG8_MMA(1, 0, At, B0); PG8_BAR; PG8_SCHED;
            PG8_STAGE(PG8_SB(1, 1), b3 + hstep, voffB);
            PG8_WAIT_V(6); PG8_BAR; PG8_MMA(1, 1, At, B1); PG8_BAR;
            }
        }
        if constexpr (ALIGN_EPI) { if (wr == 0) PG8_BAR; }
        if constexpr (!Epi::AFTER_DRAIN) { E(acc, cur, wr, wc, fr, fq); S.done(cur); }
        if (!has_next) break;
#pragma unroll
        for (int a = 0; a < 2; ++a)
#pragma unroll
            for (int b = 0; b < 2; ++b)
#pragma unroll
                for (int m = 0; m < 4; ++m)
#pragma unroll
                    for (int n = 0; n < 2; ++n) acc[a][b][m][n] = (f32x4){0.f, 0.f, 0.f, 0.f};
        cur = nxt; cA = nA; cB = nB; ++ui;
        if constexpr (ALIGN_EPI) { if (wr == 1) PG8_BAR; }
    }
    PG8_WAIT_V(0);
    if constexpr (!ALIGN_EPI) { if (wr == 0) PG8_BAR; }
    PG8_BAR;
    if constexpr (Epi::AFTER_DRAIN) { E.fused(acc, cur, wr, wc, fr, fq, lds, wid, lane); S.done(cur); }
#undef PG8_SA
#undef PG8_SB
#undef PG8_STAGE
#undef PG8_LDA
#undef PG8_LDB
#undef PG8_MMA
#undef PG8_WAIT_V
#undef PG8_WAIT_L
#undef PG8_BAR
#undef PG8_SCHED
}
}
namespace cg = cooperative_groups;
typedef unsigned short bf16_t;
typedef float f32x4 __attribute__((ext_vector_type(4)));
typedef unsigned u32x4 __attribute__((ext_vector_type(4)));
typedef unsigned u32x2 __attribute__((ext_vector_type(2)));
#define LAS __attribute__((address_space(3)))
#define GAS __attribute__((address_space(1)))

constexpr int D = 1024, NB = 8, SEQ = 2048, CTXL = 256, DFF = 2816;
constexpr int MLAT = NB * SEQ, MCTX = NB * CTXL, MTOT = MLAT + MCTX;
constexpr int MODLD = 9 * D;
enum { I_X = 0, I_C, I_CTX, I_CCTX, I_ADAW, I_ADAB, I_NORMG, I_W13, I_W2, I_FINALG, I_NAW, I_NARPB, I_NAWO, I_MLW, I_MLGB, I_MLCONV, I_MLNG, I_MLWO,
       I_DAW, I_DALAM, I_DANG, I_DAWO, I_GLAW, I_GLAGU, I_GLABG, I_GLANG, I_GLAWO, N_IN };
constexpr int NPAD_IN[4] = {3072, 4352, 3072, 3328};
constexpr int N_IN_REAL[4] = {3072, 4112, 3072, 3104};
constexpr size_t al256(size_t x) { return (x + 255) & ~(size_t)255; }
constexpr size_t WS_MOD = 0;
constexpr size_t WS_ROPE = al256(WS_MOD + (size_t)4 * 9 * MODLD * 4);
constexpr size_t WS_W13T = al256(WS_ROPE + 2 * 64 * 16 * 4);
constexpr size_t W13T_SZ = (size_t)2 * DFF * D * 2;
constexpr size_t WS_W2T = WS_W13T + 8 * W13T_SZ;
constexpr size_t W2T_SZ = (size_t)D * DFF * 2;
constexpr size_t WS_WIN0 = WS_W2T + 8 * W2T_SZ;
constexpr size_t WS_WIN1 = WS_WIN0 + (size_t)3072 * D * 2;
constexpr size_t WS_WIN2 = WS_WIN1 + (size_t)4352 * D * 2;
constexpr size_t WS_WIN3 = WS_WIN2 + (size_t)3072 * D * 2;
constexpr size_t WS_WO = WS_WIN3 + (size_t)3328 * D * 2;
constexpr size_t WS_H = WS_WO + (size_t)4 * D * D * 2;
constexpr size_t WS_U = WS_H + (size_t)MTOT * D * 4;
constexpr size_t WS_P = WS_U + (size_t)MTOT * D * 2;
constexpr size_t WS_G32 = WS_P + (size_t)MTOT * 4352 * 2;
constexpr size_t WS_QC = WS_G32 + (size_t)MTOT * 32 * 4;
constexpr size_t WS_KC = WS_QC + (size_t)MTOT * D * 2;
constexpr size_t WS_HS = WS_KC + (size_t)MTOT * D * 2;
constexpr size_t WS_VT = WS_HS + (size_t)2 * MTOT * D * 2;
constexpr size_t WS_KBT = WS_VT + (size_t)D * MTOT * 2;
constexpr size_t WS_SC = WS_KBT + (size_t)2 * D * MTOT * 2;
constexpr size_t SC_SA = 0, SC_SMX = (size_t)8 * MTOT * 4, SC_SB = (size_t)16 * MTOT * 4, SC_CE = (size_t)24 * MTOT * 4, SC_DEC = SC_CE + 65536;
constexpr size_t WS_DP = WS_KBT;
constexpr size_t WS_END = WS_SC + SC_DEC + (size_t)2 * 288 * 512 * 4;
constexpr size_t WS_BAR = WS_END;
static_assert(WS_BAR + 16384 <= (size_t)738197504, "workspace");

struct Args { const float* in[N_IN]; float* out; unsigned char* ws; int ph_lo, ph_hi; };

__device__ __forceinline__ unsigned f2bf(float f) { unsigned u = __builtin_bit_cast(unsigned, f); return (u + 0x7fffu + ((u >> 16) & 1u)) >> 16; }
__device__ __forceinline__ unsigned pk2(float lo, float hi) { return f2bf(lo) | (f2bf(hi) << 16); }
__device__ __forceinline__ float bf2f(unsigned short b) { return __builtin_bit_cast(float, (unsigned)b << 16); }
__device__ __forceinline__ float bflo(unsigned w) { return __builtin_bit_cast(float, w << 16); }
__device__ __forceinline__ float bfhi(unsigned w) { return __builtin_bit_cast(float, w & 0xffff0000u); }
__device__ __forceinline__ float wave_sum(float v) {
#pragma unroll
    for (int o = 1; o < 64; o <<= 1) v += shx(v, o);
    return v;
}
__device__ __forceinline__ float wave_max(float v) {
#pragma unroll
    for (int o = 1; o < 64; o <<= 1) v = fmaxf(v, shx(v, o));
    return v;
}
__device__ __forceinline__ float silu(float x) { return x / (1.f + __expf(-x)); }
__device__ __forceinline__ float sigmoidf_(float x) { return 1.f / (1.f + __expf(-x)); }
__device__ __forceinline__ float log_sigmoid(float x) { return fminf(x, 0.f) - log1pf(__expf(-fabsf(x))); }

struct WDesc { const float* src; bf16_t* dst; int K, N, Npad, perm, tiles; };
__device__ __forceinline__ WDesc get_wdesc(const Args& a, unsigned char* ws, int mi) {
    WDesc w;
    if (mi < 8) { w.src = ((const float*)(const GAS float*)a.in[I_W13]) + (size_t)mi * D * 2 * DFF; w.dst = (bf16_t*)(ws + WS_W13T + mi * W13T_SZ); w.K = D; w.N = 2 * DFF; w.Npad = 2 * DFF; w.perm = 1; }
    else if (mi < 16) { const int j = mi - 8; w.src = ((const float*)(const GAS float*)a.in[I_W2]) + (size_t)j * DFF * D; w.dst = (bf16_t*)(ws + WS_W2T + j * W2T_SZ); w.K = DFF; w.N = D; w.Npad = D; w.perm = 0; }
    else if (mi < 20) { const int j = mi - 16;
        w.src = ((const float*)(const GAS float*)a.in[j == 0 ? I_NAW : j == 1 ? I_MLW : j == 2 ? I_DAW : I_GLAW]);
        w.dst = (bf16_t*)(ws + (j == 0 ? WS_WIN0 : j == 1 ? WS_WIN1 : j == 2 ? WS_WIN2 : WS_WIN3));
        w.K = D; w.N = j == 0 ? 3072 : j == 1 ? 4112 : j == 2 ? 3072 : 3104; w.Npad = j == 0 ? 3072 : j == 1 ? 4352 : j == 2 ? 3072 : 3328; w.perm = 0; }
    else { const int j = mi - 20; w.src = ((const float*)(const GAS float*)a.in[j == 0 ? I_NAWO : j == 1 ? I_MLWO : j == 2 ? I_DAWO : I_GLAWO]); w.dst = (bf16_t*)(ws + WS_WO + (size_t)j * D * D * 2); w.K = D; w.N = D; w.Npad = D; w.perm = 0; }
    w.tiles = (w.K / 64) * (w.Npad / 64);
    return w;
}
constexpr int TILES_W13 = 16 * 88, TILES_W2 = 44 * 16, TILES_WO = 256;
constexpr int TILES_TOTAL = 8 * TILES_W13 + 8 * TILES_W2 + 16 * (48 + 68 + 48 + 52) + 4 * TILES_WO;

__device__ void p0_prologue(const Args& a, LAS unsigned char* lds) {
    const int tid = TID(), lane = tid & 63, wid = tid >> 6;
    GAS unsigned char* wsg = (GAS unsigned char*)a.ws; asm volatile("" : "+s"(wsg)); unsigned char* ws = (unsigned char*)wsg;
    {
        LAS float* S = (LAS float*)lds;
        LAS float* red = (LAS float*)(lds + 9 * 1024 * 4);
        for (int i = tid; i < 9 * 1024; i += 512) { const float v = i < 8 * 1024 ? ((const float*)(const GAS float*)a.in[I_C])[i] : ((const float*)(const GAS float*)a.in[I_CCTX])[i - 8 * 1024]; S[i] = silu(v); }
        __syncthreads();
        float* MOD = (float*)(ws + WS_MOD);
        for (int item = BID(); item < 4 * 144; item += GDIM()) {
            const int l = item / 144, cgp = item % 144;
            const int cq = tid & 15, kg = tid >> 4;
            const float* W = ((const float*)(const GAS float*)a.in[I_ADAW]) + (size_t)l * D * MODLD + cgp * 64 + cq * 4;
            f32x4 acc[9];
#pragma unroll
            for (int r = 0; r < 9; ++r) acc[r] = (f32x4){0.f, 0.f, 0.f, 0.f};
#pragma unroll 4
            for (int kk = 0; kk < 32; ++kk) {
                const int k = kg * 32 + kk;
                const f32x4 w4 = *(const f32x4*)(W + (size_t)k * MODLD);
#pragma unroll
                for (int r = 0; r < 9; ++r) acc[r] = acc[r] + w4 * S[r * 1024 + k];
            }
#pragma unroll
            for (int r = 0; r < 9; ++r)
#pragma unroll
                for (int e = 0; e < 4; ++e) { float v = acc[r][e]; v += shx(v, 16); v += shx(v, 32); acc[r][e] = v; }
            if (lane < 16) {
#pragma unroll
                for (int r = 0; r < 9; ++r)
#pragma unroll
                    for (int e = 0; e < 4; ++e) red[(wid * 9 + r) * 64 + cq * 4 + e] = acc[r][e];
            }
            __syncthreads();
            for (int o = tid; o < 9 * 64; o += 512) {
                const int r = o >> 6, cc = o & 63; float v = 0.f;
#pragma unroll
                for (int w = 0; w < 8; ++w) v += red[(w * 9 + r) * 64 + cc];
                const int col = cgp * 64 + cc;
                const int slot = col >> 10;
                MOD[((size_t)l * 9 + r) * MODLD + col] = (v + ((const float*)(const GAS float*)a.in[I_ADAB])[(size_t)l * MODLD + col]) * ((slot == 2 || slot == 8) ? 0.5f : 1.f);
            }
            __syncthreads();
        }
    }
    {
        LAS float* tile = (LAS float*)lds;
        const int lr = tid >> 4, lc = (tid & 15) * 4;
        f32x4 r0 = (f32x4){0.f, 0.f, 0.f, 0.f}, r1 = r0;
        WDesc w; int k0 = 0, n0 = 0;
#define P0_DECODE(ITEM, W, K0, N0) do { int mi, t = (ITEM); \
            if (t < 8 * TILES_W13) { mi = t / TILES_W13; t -= mi * TILES_W13; } \
            else if (t < 8 * TILES_W13 + 8 * TILES_W2) { t -= 8 * TILES_W13; mi = t / TILES_W2; t -= mi * TILES_W2; mi += 8; } \
            else { t -= 8 * TILES_W13 + 8 * TILES_W2; \
                if (t < 16 * 48) { mi = 16; } else if (t < 16 * (48 + 68)) { mi = 17; t -= 16 * 48; } else if (t < 16 * (48 + 68 + 48)) { mi = 18; t -= 16 * (48 + 68); } \
                else if (t < 16 * (48 + 68 + 48 + 52)) { mi = 19; t -= 16 * (48 + 68 + 48); } else { t -= 16 * (48 + 68 + 48 + 52); mi = 20 + t / TILES_WO; t = t % TILES_WO; } } \
            W = get_wdesc(a, ws, mi); const int ntn_ = W.Npad / 64; K0 = (t / ntn_) * 64; N0 = (t % ntn_) * 64; } while (0)
#define P0_LOAD(W, K0, N0) do { const int n_ = (N0) + lc; const bool in_ = n_ < W.N; const float* sp_ = W.src + (size_t)((K0) + lr) * W.N + n_; \
            r0 = in_ ? *(const f32x4*)sp_ : (f32x4){0.f, 0.f, 0.f, 0.f}; r1 = in_ ? *(const f32x4*)(sp_ + (size_t)32 * W.N) : (f32x4){0.f, 0.f, 0.f, 0.f}; } while (0)
        int item = BID();
        if (item < TILES_TOTAL) { P0_DECODE(item, w, k0, n0); P0_LOAD(w, k0, n0); }
        for (; item < TILES_TOTAL; item += GDIM()) {
#pragma unroll
            for (int e = 0; e < 4; ++e) { tile[lr * 65 + lc + e] = r0[e]; tile[(lr + 32) * 65 + lc + e] = r1[e]; }
            __syncthreads();
            const WDesc wc_ = w; const int ck0 = k0, cn0 = n0;
            if (item + GDIM() < TILES_TOTAL) { P0_DECODE(item + GDIM(), w, k0, n0); P0_LOAD(w, k0, n0); }
            {
                const int kp = tid & 31;
#pragma unroll
                for (int i = 0; i < 4; ++i) {
                    const int nn = (tid >> 5) + 16 * i, n = cn0 + nn;
                    int drow = n;
                    if (wc_.perm) { const int half = n >= DFF ? 1 : 0, jj = n - half * DFF; drow = (jj >> 7) * 256 + half * 128 + (jj & 127); }
                    *(unsigned*)(wc_.dst + (size_t)drow * wc_.K + ck0 + 2 * kp) = pk2(tile[(2 * kp) * 65 + nn], tile[(2 * kp + 1) * 65 + nn]);
                }
            }
            __syncthreads();
        }
    }
    {
        f32x4* H4 = (f32x4*)(ws + WS_H);
        const f32x4* x4 = (const f32x4*)((const float*)(const GAS float*)a.in[I_X]); const f32x4* c4 = (const f32x4*)((const float*)(const GAS float*)a.in[I_CTX]);
        const int n1 = MLAT * D / 4, n2 = MTOT * D / 4;
        for (int i = BID() * 512 + tid; i < n2; i += GDIM() * 512) H4[i] = i < n1 ? x4[i] : c4[i - n1];
    }
    if (BID() == 0) {
        float* R = (float*)(ws + WS_ROPE);
        for (int i = tid; i < 64 * 16; i += 512) { const int pos = i >> 4, fi = i & 15; const float f = powf(10000.f, -(float)fi / 16.f); const float ang = (float)pos * f; R[i] = cosf(ang); R[1024 + i] = sinf(ang); }
    }
}

__device__ void norm_phase(float* H, const float* g, const float* modl  , int slot_shift, bf16_t* U, int nrows, const float* DP) {
    const int lane = TID() & 63, gw = BID() * 8 + (TID() >> 6), ngw = GDIM() * 8;
    f32x4 gv[4];
#pragma unroll
    for (int j = 0; j < 4; ++j) gv[j] = *(const f32x4*)(g + j * 256 + lane * 4);
    for (int rowb = gw; rowb < nrows; rowb += 3 * ngw) {
        f32x4 v[3][4];
#pragma unroll
        for (int q = 0; q < 3; ++q) {
            const int row = rowb + q * ngw;
            if (row < nrows) {
#pragma unroll
                for (int j = 0; j < 4; ++j) v[q][j] = *(const f32x4*)(H + (size_t)row * D + j * 256 + lane * 4);
                if (DP != nullptr && row >= MLAT) {
#pragma unroll
                    for (int j = 0; j < 4; ++j) {
                        const float* dp = DP + (size_t)(row - MLAT) * D + j * 256 + lane * 4;
                        v[q][j] = v[q][j] + *(const f32x4*)dp + *(const f32x4*)(dp + (size_t)MCTX * D) + *(const f32x4*)(dp + (size_t)2 * MCTX * D);
                    }
                }
            }
        }
#pragma unroll
        for (int q = 0; q < 3; ++q) {
            const int row = rowb + q * ngw;
            if (row < nrows) {
                const int mrow = row < MLAT ? (row >> 11) : 8;
                const float* sh = modl + (size_t)mrow * MODLD + slot_shift * D; const float* sc = sh + D;
                float s = 0.f;
#pragma unroll
                for (int j = 0; j < 4; ++j) s += (v[q][j][0] * v[q][j][0] + v[q][j][1] * v[q][j][1]) + (v[q][j][2] * v[q][j][2] + v[q][j][3] * v[q][j][3]);
                const float rstd = rsqrtf(wave_sum(s) * (1.f / D) + 1e-6f);
#pragma unroll
                for (int j = 0; j < 4; ++j) {
                    if (DP != nullptr && row >= MLAT) *(f32x4*)(H + (size_t)row * D + j * 256 + lane * 4) = v[q][j];
                    const f32x4 s4 = *(const f32x4*)(sh + j * 256 + lane * 4), c4 = *(const f32x4*)(sc + j * 256 + lane * 4);
                    const f32x4 y = (v[q][j] * rstd) * gv[j] * (c4 + 1.f) + s4;
                    u32x2 o; o.x = pk2(y[0], y[1]); o.y = pk2(y[2], y[3]);
                    *(u32x2*)(U + (size_t)row * D + j * 256 + lane * 4) = o;
                }
            }
        }
    }
}
__device__ void final_norm_phase(const float* H, const float* g, float* out) {
    const int lane = TID() & 63, gw = BID() * 8 + (TID() >> 6), ngw = GDIM() * 8;
    f32x4 gv[4];
#pragma unroll
    for (int j = 0; j < 4; ++j) gv[j] = *(const f32x4*)(g + j * 256 + lane * 4);
    for (int row = gw; row < MLAT; row += ngw) {
        f32x4 v[4]; float s = 0.f;
#pragma unroll
        for (int j = 0; j < 4; ++j) { v[j] = *(const f32x4*)(H + (size_t)row * D + j * 256 + lane * 4); s += (v[j][0] * v[j][0] + v[j][1] * v[j][1]) + (v[j][2] * v[j][2] + v[j][3] * v[j][3]); }
        const float rstd = rsqrtf(wave_sum(s) * (1.f / D) + 1e-6f);
#pragma unroll
        for (int j = 0; j < 4; ++j) *(f32x4*)(out + (size_t)row * D + j * 256 + lane * 4) = (v[j] * rstd) * gv[j];
    }
}

__device__ __forceinline__ void unpack8(const u32x4 w, float* f) { f[0] = bflo(w.x); f[1] = bfhi(w.x); f[2] = bflo(w.y); f[3] = bfhi(w.y); f[4] = bflo(w.z); f[5] = bfhi(w.z); f[6] = bflo(w.w); f[7] = bfhi(w.w); }
__device__ void na_naive_phase(const bf16_t* P, const float* rpb, bf16_t* U, LAS unsigned char* lds) {
    constexpr int LD = 3072;
    const int lane = TID() & 63, gw = BID() * 8 + (TID() >> 6), ngw = GDIM() * 8;
    for (int item = gw; item < MTOT * 16; item += ngw) {
        const int row = item >> 4, h = item & 15;
        const bool lat = row < MLAT;
        const int b = lat ? (row >> 11) : ((row - MLAT) >> 8);
        const int t = row & 2047, r = t >> 6, c = t & 63;
        const int r0 = min(max(r - 4, 0), 24), win0 = min(max(c - 8, 0), 48);
        const int nk = lat ? 384 : 256;
        LAS float* q = (LAS float*)lds + (TID() >> 6) * 64;
        q[lane] = bf2f(P[(size_t)row * LD + 2048 + h * 64 + lane]);
        __builtin_amdgcn_wave_barrier();
        float s[6];
#pragma unroll
        for (int jj = 0; jj < 6; ++jj) s[jj] = -1e30f;
#pragma unroll 1
        for (int jj = 0; jj < 6; ++jj) {
            const int kk = lane + 64 * jj;
            float val = -1e30f;
            if (kk < nk) {
                int krow; float bias = 0.f;
                if (lat && kk < 128) { const int kr = r0 + (kk >> 4), kc = win0 + (kk & 15); krow = b * 2048 + kr * 64 + kc; bias = rpb[(h * 15 + (kr - r + 7)) * 31 + (kc - c + 15)]; }
                else krow = MLAT + b * 256 + (lat ? kk - 128 : kk);
                const u32x4* kp = (const u32x4*)(P + (size_t)krow * LD + h * 64);
                float d = 0.f;
#pragma unroll
                for (int i = 0; i < 8; ++i) { float kf[8]; unpack8(kp[i], kf); const f32x4 qa = *(const LAS f32x4*)(q + 8 * i), qb = *(const LAS f32x4*)(q + 8 * i + 4);
                    d += kf[0] * qa[0] + kf[1] * qa[1] + kf[2] * qa[2] + kf[3] * qa[3] + kf[4] * qb[0] + kf[5] * qb[1] + kf[6] * qb[2] + kf[7] * qb[3]; }
                val = d * 0.125f + bias;
            }
#pragma unroll
            for (int k2 = 0; k2 < 6; ++k2) s[k2] = (jj == k2) ? val : s[k2];
        }
        float mx = s[0];
#pragma unroll
        for (int jj = 1; jj < 6; ++jj) mx = fmaxf(mx, s[jj]);
        mx = wave_max(mx);
        float sum = 0.f;
#pragma unroll
        for (int jj = 0; jj < 6; ++jj) { s[jj] = (lane + 64 * jj < nk) ? __expf(s[jj] - mx) : 0.f; sum += s[jj]; }
        sum = wave_sum(sum);
        float o = 0.f;
#pragma unroll
        for (int jj = 0; jj < 6; ++jj) {
            if (jj * 64 < nk) {
#pragma unroll 4
                for (int src = 0; src < 64; ++src) {
                    const int kk = jj * 64 + src;
                    const float p = rdl(s[jj], src);
                    int krow;
                    if (lat && kk < 128) krow = b * 2048 + (r0 + (kk >> 4)) * 64 + win0 + (kk & 15); else krow = MLAT + b * 256 + (lat ? kk - 128 : kk);
                    o += p * bf2f(P[(size_t)krow * LD + 1024 + h * 64 + lane]);
                }
            }
        }
        U[(size_t)row * D + h * 64 + lane] = (bf16_t)f2bf(o / sum);
        __builtin_amdgcn_wave_barrier();
    }
}

__device__ void da_rope_phase(bf16_t* P, const float* R) {
    constexpr int LD = 3072;
    const int gt = BID() * 512 + TID(), ngt = GDIM() * 512;
    for (long it = gt; it < (long)MLAT * 1024; it += ngt) {
        const int row = (int)(it >> 10), w = (int)(it & 1023), sec = w >> 9, grp = (w >> 5) & 15, axis = (w >> 4) & 1, i = w & 15;
        const int t = row & 2047, pos = axis ? (t & 63) : (t >> 6);
        const float cs = R[pos * 16 + i], sn = R[1024 + pos * 16 + i];
        bf16_t* p = P + (size_t)row * LD + sec * 2048 + grp * 64 + axis * 32 + i;
        const float x1 = bf2f(p[0]), x2 = bf2f(p[16]);
        p[0] = (bf16_t)f2bf(x1 * cs - x2 * sn); p[16] = (bf16_t)f2bf(x2 * cs + x1 * sn);
    }
}
__device__ void da_naive_phase(const bf16_t* P, const float* lamp, const float* ng, bf16_t* U, LAS unsigned char* lds) {
    constexpr int LD = 3072;
    const int lane = TID() & 63, wid = TID() >> 6, gw = BID() * 8 + wid, ngw = GDIM() * 8;
    LAS float* qs = (LAS float*)lds + wid * 128;
    const float lam_init = 0.8f - 0.6f * expf(-0.3f * 2.f);
    const float l01 = wave_sum(lamp[lane] * lamp[64 + lane]), l23 = wave_sum(lamp[128 + lane] * lamp[192 + lane]);
    const float lam = expf(l01) - expf(l23) + lam_init;
    for (int item = gw; item < MTOT * 8; item += ngw) {
        const int row = item >> 3, h = item & 7;
        const bool lat = row < MLAT;
        const int b = lat ? (row >> 11) : ((row - MLAT) >> 8);
        const int nkl = lat ? 36 : 4;
        { const bf16_t* qp = P + (size_t)row * LD + 2048 + h * 128; qs[lane] = bf2f(qp[lane]) * 0.125f; qs[64 + lane] = bf2f(qp[64 + lane]) * 0.125f; }
        __builtin_amdgcn_wave_barrier();
        float m0 = -1e30f, m1 = -1e30f, l0 = 0.f, l1 = 0.f;
#pragma unroll 1
        for (int jj = 0; jj < nkl; ++jj) {
            const int kk = lane + 64 * jj;
            const int krow = lat ? (kk < 2048 ? b * 2048 + kk : MLAT + b * 256 + kk - 2048) : MLAT + b * 256 + kk;
            const u32x4* kp = (const u32x4*)(P + (size_t)krow * LD + h * 128);
            float d0 = 0.f, d1 = 0.f;
#pragma unroll
            for (int i = 0; i < 8; ++i) { float kf[8]; unpack8(kp[i], kf); const f32x4 qa = *(const LAS f32x4*)(qs + 8 * i), qb = *(const LAS f32x4*)(qs + 8 * i + 4);
                d0 += kf[0] * qa[0] + kf[1] * qa[1] + kf[2] * qa[2] + kf[3] * qa[3] + kf[4] * qb[0] + kf[5] * qb[1] + kf[6] * qb[2] + kf[7] * qb[3]; }
#pragma unroll
            for (int i = 0; i < 8; ++i) { float kf[8]; unpack8(kp[8 + i], kf); const f32x4 qa = *(const LAS f32x4*)(qs + 64 + 8 * i), qb = *(const LAS f32x4*)(qs + 64 + 8 * i + 4);
                d1 += kf[0] * qa[0] + kf[1] * qa[1] + kf[2] * qa[2] + kf[3] * qa[3] + kf[4] * qb[0] + kf[5] * qb[1] + kf[6] * qb[2] + kf[7] * qb[3]; }
            const float n0 = fmaxf(m0, d0), n1 = fmaxf(m1, d1);
            l0 = l0 * __expf(m0 - n0) + __expf(d0 - n0); l1 = l1 * __expf(m1 - n1) + __expf(d1 - n1); m0 = n0; m1 = n1;
        }
        { const float g0 = wave_max(m0), g1 = wave_max(m1); l0 = wave_sum(l0 * __expf(m0 - g0)); l1 = wave_sum(l1 * __expf(m1 - g1)); m0 = g0; m1 = g1; }
        const float i0 = 1.f / l0, i1 = lam / l1;
        float o0 = 0.f, o1 = 0.f;
#pragma unroll 1
        for (int jj = 0; jj < nkl; ++jj) {
            const int kk0 = lane + 64 * jj;
            const int krow0 = lat ? (kk0 < 2048 ? b * 2048 + kk0 : MLAT + b * 256 + kk0 - 2048) : MLAT + b * 256 + kk0;
            const u32x4* kp = (const u32x4*)(P + (size_t)krow0 * LD + h * 128);
            float d0 = 0.f, d1 = 0.f;
#pragma unroll
            for (int i = 0; i < 8; ++i) { float kf[8]; unpack8(kp[i], kf); const f32x4 qa = *(const LAS f32x4*)(qs + 8 * i), qb = *(const LAS f32x4*)(qs + 8 * i + 4);
                d0 += kf[0] * qa[0] + kf[1] * qa[1] + kf[2] * qa[2] + kf[3] * qa[3] + kf[4] * qb[0] + kf[5] * qb[1] + kf[6] * qb[2] + kf[7] * qb[3]; }
#pragma unroll
            for (int i = 0; i < 8; ++i) { float kf[8]; unpack8(kp[8 + i], kf); const f32x4 qa = *(const LAS f32x4*)(qs + 64 + 8 * i), qb = *(const LAS f32x4*)(qs + 64 + 8 * i + 4);
                d1 += kf[0] * qa[0] + kf[1] * qa[1] + kf[2] * qa[2] + kf[3] * qa[3] + kf[4] * qb[0] + kf[5] * qb[1] + kf[6] * qb[2] + kf[7] * qb[3]; }
            const float wv = __expf(d0 - m0) * i0 - __expf(d1 - m1) * i1;
#pragma unroll 4
            for (int src = 0; src < 64; ++src) {
                const int kk = jj * 64 + src;
                const int krow = lat ? (kk < 2048 ? b * 2048 + kk : MLAT + b * 256 + kk - 2048) : MLAT + b * 256 + kk;
                const float p = rdl(wv, src);
                const bf16_t* vp = P + (size_t)krow * LD + 1024 + h * 128;
                o0 += p * bf2f(vp[lane]); o1 += p * bf2f(vp[64 + lane]);
            }
        }
        const float rstd = rsqrtf(wave_sum(o0 * o0 + o1 * o1) * (1.f / 128.f) + 1e-6f) * (1.f - lam_init);
        U[(size_t)row * D + h * 128 + lane] = (bf16_t)f2bf(o0 * rstd * ng[h * 128 + lane]);
        U[(size_t)row * D + h * 128 + 64 + lane] = (bf16_t)f2bf(o1 * rstd * ng[h * 128 + 64 + lane]);
        __builtin_amdgcn_wave_barrier();
    }
}


typedef short bf16x8 __attribute__((ext_vector_type(8)));
__device__ __forceinline__ unsigned pk2hw(float lo, float hi) { unsigned r; asm volatile("v_cvt_pk_bf16_f32 %0, %1, %2" : "=v"(r) : "v"(lo), "v"(hi)); return r; }
__device__ __forceinline__ bf16x8 pack8(const f32x4 a, const f32x4 b) { u32x4 w; w.x = pk2hw(a[0], a[1]); w.y = pk2hw(a[2], a[3]); w.z = pk2hw(b[0], b[1]); w.w = pk2hw(b[2], b[3]); return __builtin_bit_cast(bf16x8, w); }
__device__ void da_flash_phase(const bf16_t* P, const bf16_t* VT, const float* lamp, const float* ng, bf16_t* U, LAS unsigned char* lds) {
    constexpr int LD = 3072, KS = 272, VS = 144, KBUF = 64 * KS, VBUF = 128 * VS, BUF = KBUF + VBUF;
    const int tid = TID(), lane = tid & 63, wid = tid >> 6, m16 = lane & 15, quad = lane >> 4;
    const float lam_init = 0.8f - 0.6f * expf(-0.3f * 2.f);
    const float l01 = wave_sum(lamp[lane] * lamp[64 + lane]), l23 = wave_sum(lamp[128 + lane] * lamp[192 + lane]);
    const float lam = expf(l01) - expf(l23) + lam_init;
    const int kkey = tid >> 3, kch = tid & 7, vdv = tid >> 2, vch = tid & 3;
    const int krho = ((kkey >> 5) * 2 + ((kkey >> 2) & 1)) * 16 + ((kkey >> 3) & 3) * 4 + (kkey & 3);
    for (int item = BID(); item < 1024 + 128; item += GDIM()) {
        const bool lat = item < 1024;
        int b, h, qb;
        if (lat) { b = item >> 7; h = (item >> 4) & 7; qb = item & 15; } else { const int i2 = item - 1024; b = i2 >> 4; h = (i2 >> 1) & 7; qb = i2 & 1; }
        const int qrow = (lat ? b * 2048 : MLAT + b * 256) + qb * 128 + wid * 16 + m16;
        const int nblk = lat ? 36 : 4;
        bf16x8 qf[2][2];
        { const bf16_t* qp = P + (size_t)qrow * LD + 2048 + h * 128 + quad * 8;
#pragma unroll
          for (int j = 0; j < 2; ++j)
#pragma unroll
            for (int ks = 0; ks < 2; ++ks) qf[j][ks] = *(const GAS bf16x8*)(qp + j * 64 + ks * 32); }
        f32x4 O[2][8];
#pragma unroll
        for (int j = 0; j < 2; ++j)
#pragma unroll
            for (int dt = 0; dt < 8; ++dt) O[j][dt] = (f32x4){0.f, 0.f, 0.f, 0.f};
        float mrun[2] = {-1e30f, -1e30f}, lrun[2] = {0.f, 0.f};
        u32x4 rk0, rk1, rv0, rv1;
        {
            const int kr0 = lat ? b * 2048 : MLAT + b * 256;
            const bf16_t* kp = P + (size_t)(kr0 + kkey) * LD + h * 128 + kch * 8;
            rk0 = *(const GAS u32x4*)kp; rk1 = *(const GAS u32x4*)(kp + 64);
            const bf16_t* vp = VT + (size_t)(h * 128 + vdv) * MTOT + kr0 + vch * 8;
            rv0 = *(const GAS u32x4*)vp; rv1 = *(const GAS u32x4*)(vp + 32);
            LAS unsigned char* Kb = lds; LAS unsigned char* Vb = lds + KBUF;
            *(LAS u32x4*)(Kb + krho * KS + kch * 16) = rk0; *(LAS u32x4*)(Kb + krho * KS + (kch + 8) * 16) = rk1;
            *(LAS u32x4*)(Vb + vdv * VS + vch * 16) = rv0; *(LAS u32x4*)(Vb + vdv * VS + (vch + 4) * 16) = rv1;
        }
        __syncthreads();
        asm volatile("" :: "v"(qf[0][0]), "v"(qf[0][1]), "v"(qf[1][0]), "v"(qf[1][1]));
#pragma unroll 1
        for (int kb = 0; kb < nblk; ++kb) {
            const bool more = kb + 1 < nblk;
            if (more) {
                const int k1 = kb + 1;
                const int kr0 = lat ? (k1 < 32 ? b * 2048 + k1 * 64 : MLAT + b * 256 + (k1 - 32) * 64) : MLAT + b * 256 + k1 * 64;
                const bf16_t* kp = P + (size_t)(kr0 + kkey) * LD + h * 128 + kch * 8;
                rk0 = *(const GAS u32x4*)kp; rk1 = *(const GAS u32x4*)(kp + 64);
                const bf16_t* vp = VT + (size_t)(h * 128 + vdv) * MTOT + kr0 + vch * 8;
                rv0 = *(const GAS u32x4*)vp; rv1 = *(const GAS u32x4*)(vp + 32);
            }
            LAS const unsigned char* Kb = lds + (kb & 1) * BUF; LAS const unsigned char* Vb = Kb + KBUF;
            f32x4 st[2][2][2];
#pragma unroll
            for (int sb = 0; sb < 2; ++sb) {
                bf16x8 Ak[2][2][2];
#pragma unroll
                for (int j = 0; j < 2; ++j)
#pragma unroll
                    for (int T = 0; T < 2; ++T)
#pragma unroll
                        for (int ks = 0; ks < 2; ++ks) Ak[j][T][ks] = *(LAS const bf16x8*)(Kb + ((sb * 2 + T) * 16 + m16) * KS + (j * 64 + ks * 32 + quad * 8) * 2);
                asm volatile("" ::: "memory");
#pragma unroll
                for (int j = 0; j < 2; ++j)
#pragma unroll
                    for (int T = 0; T < 2; ++T) {
                        f32x4 acc = (f32x4){0.f, 0.f, 0.f, 0.f};
                        acc = __builtin_amdgcn_mfma_f32_16x16x32_bf16(Ak[j][T][0], qf[j][0], acc, 0, 0, 0);
                        acc = __builtin_amdgcn_mfma_f32_16x16x32_bf16(Ak[j][T][1], qf[j][1], acc, 0, 0, 0);
                        st[sb][j][T] = acc;
                    }
            }
            float alpha[2]; bool chg = false;
#pragma unroll
            for (int j = 0; j < 2; ++j) {
                float mx = fmaxf(fmaxf(st[0][j][0][0], st[0][j][0][1]), fmaxf(st[0][j][0][2], st[0][j][0][3]));
#pragma unroll
                for (int sb = 0; sb < 2; ++sb)
#pragma unroll
                    for (int T = 0; T < 2; ++T) if (sb + T) mx = fmaxf(mx, fmaxf(fmaxf(st[sb][j][T][0], st[sb][j][T][1]), fmaxf(st[sb][j][T][2], st[sb][j][T][3])));
                mx = fmaxf(mx, shx(mx, 16)); mx = fmaxf(mx, shx(mx, 32));
                mx *= 1.4426950408889634f;
                const bool up = mx > mrun[j] + 8.f;
                const float mnew = up ? mx : mrun[j];
                alpha[j] = up ? __builtin_amdgcn_exp2f(mrun[j] - mnew) : 1.f; chg = chg || up;
                mrun[j] = mnew;
                float ps = 0.f;
#pragma unroll
                for (int sb = 0; sb < 2; ++sb)
#pragma unroll
                    for (int T = 0; T < 2; ++T)
#pragma unroll
                        for (int e = 0; e < 4; ++e) { const float pv = __builtin_amdgcn_exp2f(__builtin_fmaf(st[sb][j][T][e], 1.4426950408889634f, -mnew)); st[sb][j][T][e] = pv; ps += pv; }
                lrun[j] = lrun[j] * alpha[j] + ps;
            }
            if (__builtin_amdgcn_ballot_w64(chg) != 0ull) {
#pragma unroll
                for (int j = 0; j < 2; ++j)
#pragma unroll
                    for (int dt = 0; dt < 8; ++dt) O[j][dt] = O[j][dt] * alpha[j];
            }
#pragma unroll
            for (int sb = 0; sb < 2; ++sb) {
                const bf16x8 p0 = pack8(st[sb][0][0], st[sb][0][1]), p1 = pack8(st[sb][1][0], st[sb][1][1]);
                bf16x8 Av[8];
#pragma unroll
                for (int dt = 0; dt < 8; ++dt) Av[dt] = *(LAS const bf16x8*)(Vb + (dt * 16 + m16) * VS + (sb * 32 + quad * 8) * 2);
                asm volatile("" ::: "memory");
#pragma unroll
                for (int dt = 0; dt < 8; ++dt) {
                    O[0][dt] = __builtin_amdgcn_mfma_f32_16x16x32_bf16(Av[dt], p0, O[0][dt], 0, 0, 0);
                    O[1][dt] = __builtin_amdgcn_mfma_f32_16x16x32_bf16(Av[dt], p1, O[1][dt], 0, 0, 0);
                }
            }
            if (more) {
                LAS unsigned char* Kn = lds + ((kb + 1) & 1) * BUF; LAS unsigned char* Vn = Kn + KBUF;
                *(LAS u32x4*)(Kn + krho * KS + kch * 16) = rk0; *(LAS u32x4*)(Kn + krho * KS + (kch + 8) * 16) = rk1;
                *(LAS u32x4*)(Vn + vdv * VS + vch * 16) = rv0; *(LAS u32x4*)(Vn + vdv * VS + (vch + 4) * 16) = rv1;
            }
            __syncthreads();
        }
        float l0 = lrun[0], l1 = lrun[1];
        l0 += shx(l0, 16); l0 += shx(l0, 32); l1 += shx(l1, 16); l1 += shx(l1, 32);
        const float i0 = 1.f / l0, i1 = lam / l1;
        float ss = 0.f;
#pragma unroll
        for (int dt = 0; dt < 8; ++dt) { O[0][dt] = O[0][dt] * i0 - O[1][dt] * i1;
#pragma unroll
            for (int e = 0; e < 4; ++e) ss += O[0][dt][e] * O[0][dt][e]; }
        ss += shx(ss, 16); ss += shx(ss, 32);
        const float rstd = rsqrtf(ss * (1.f / 128.f) + 1e-6f) * (1.f - lam_init);
#pragma unroll
        for (int dt = 0; dt < 8; ++dt) {
            const int c = h * 128 + dt * 16 + quad * 4;
            const f32x4 g4 = *(const f32x4*)(ng + c);
            const f32x4 y = O[0][dt] * rstd * g4;
            u32x2 o; o.x = pk2(y[0], y[1]); o.y = pk2(y[2], y[3]);
            *(u32x2*)(U + (size_t)qrow * D + c) = o;
        }
    }
}


__device__ void na_mfma_phase(const bf16_t* P, const bf16_t* VT, const float* rpb, bf16_t* U) {
    constexpr int LD = 3072;
    const int lane = TID() & 63, gw = BID() * 8 + (TID() >> 6), ngw = GDIM() * 8, m16 = lane & 15, quad = lane >> 4;
    const int krow_in = (m16 >> 2) * 8 + (m16 & 3);
    for (int item = gw; item < 16384 + 2048; item += ngw) {
        const bool lat = item < 16384;
        int b, h, r = 0, j = 0, qrow;
        if (lat) { b = item >> 11; h = (item >> 7) & 15; r = (item >> 2) & 31; j = item & 3; qrow = b * 2048 + r * 64 + j * 16 + m16; }
        else { const int i2 = item - 16384; b = i2 >> 8; h = (i2 >> 4) & 15; qrow = MLAT + b * 256 + (i2 & 15) * 16 + m16; }
        const int r0 = min(max(r - 4, 0), 24), kc0 = min(max(16 * j - 8, 0), 32);
        const int c = j * 16 + m16, win0 = min(max(c - 8, 0), 48);
        bf16x8 qf[2];
        { const bf16_t* qp = P + (size_t)qrow * LD + 2048 + h * 64 + quad * 8; qf[0] = *(const GAS bf16x8*)qp; qf[1] = *(const GAS bf16x8*)(qp + 32); }
        f32x4 st[16][2];
        float mx = -1e30f;
#pragma unroll
        for (int sp = 0; sp < 16; ++sp) {
            if (sp < 8 && !lat) { st[sp][0] = (f32x4){-1e30f, -1e30f, -1e30f, -1e30f}; st[sp][1] = st[sp][0]; continue; }
            const int tok0 = sp < 8 ? b * 2048 + (r0 + sp) * 64 + kc0 : MLAT + b * 256 + (sp - 8) * 32;
#pragma unroll
            for (int T = 0; T < 2; ++T) {
                const bf16_t* kp = P + (size_t)(tok0 + krow_in + 4 * T) * LD + h * 64 + quad * 8;
                f32x4 acc = (f32x4){0.f, 0.f, 0.f, 0.f};
                acc = __builtin_amdgcn_mfma_f32_16x16x32_bf16(*(const GAS bf16x8*)kp, qf[0], acc, 0, 0, 0);
                acc = __builtin_amdgcn_mfma_f32_16x16x32_bf16(*(const GAS bf16x8*)(kp + 32), qf[1], acc, 0, 0, 0);
                if (sp < 8) {
                    const int ro = (r0 + sp - r + 7) * 31;
#pragma unroll
                    for (int e = 0; e < 4; ++e) {
                        const int kc = kc0 + quad * 8 + T * 4 + e;
                        const bool inw = (kc >= win0) && (kc < win0 + 16);
                        const float bias = ((const GAS float*)rpb)[h * 465 + (inw ? ro + (kc - c + 15) : 0)];
                        acc[e] = inw ? acc[e] + bias : -1e30f;
                    }
                }
                st[sp][T] = acc;
#pragma unroll
                for (int e = 0; e < 4; ++e) mx = fmaxf(mx, acc[e]);
            }
        }
        mx = fmaxf(mx, shx(mx, 16)); mx = fmaxf(mx, shx(mx, 32));
        float sum = 0.f;
        f32x4 O[4];
#pragma unroll
        for (int dt = 0; dt < 4; ++dt) O[dt] = (f32x4){0.f, 0.f, 0.f, 0.f};
#pragma unroll
        for (int sp = 0; sp < 16; ++sp) {
            if (sp < 8 && !lat) continue;
#pragma unroll
            for (int T = 0; T < 2; ++T)
#pragma unroll
                for (int e = 0; e < 4; ++e) { const float pv = __expf(st[sp][T][e] - mx); st[sp][T][e] = pv; sum += pv; }
            const bf16x8 pf = pack8(st[sp][0], st[sp][1]);
            const int tok0 = sp < 8 ? b * 2048 + (r0 + sp) * 64 + kc0 : MLAT + b * 256 + (sp - 8) * 32;
#pragma unroll
            for (int dt = 0; dt < 4; ++dt) {
                const bf16x8 Av = *(const GAS bf16x8*)(VT + (size_t)(h * 64 + dt * 16 + m16) * MTOT + tok0 + quad * 8);
                O[dt] = __builtin_amdgcn_mfma_f32_16x16x32_bf16(Av, pf, O[dt], 0, 0, 0);
            }
        }
        sum += shx(sum, 16); sum += shx(sum, 32);
        const float inv = 1.f / sum;
#pragma unroll
        for (int dt = 0; dt < 4; ++dt) {
            const f32x4 y = O[dt] * inv;
            u32x2 o; o.x = pk2(y[0], y[1]); o.y = pk2(y[2], y[3]);
            *(u32x2*)(U + (size_t)qrow * D + h * 64 + dt * 16 + quad * 4) = o;
        }
    }
}

constexpr int ML_LD = 4352, ML_NKVG = 2064;
__device__ void ml_prep_phase(const bf16_t* P, const float* convw, bf16_t* QC, bf16_t* KC) {
    const int gt = BID() * 512 + TID(), ngt = GDIM() * 512;
    for (long it = gt; it < (long)MTOT * 2048; it += ngt) {
        const int row = (int)(it >> 11), w = (int)(it & 2047), isq = w >> 10, ch = w & 1023;
        const bool lat = row < MLAT;
        const int pos = lat ? (row & 2047) : ((row - MLAT) & 255), len = lat ? 2048 : 256;
        const int col = isq ? (ML_NKVG + ch) : ch;
        const float w0 = convw[0 * 2048 + isq * 1024 + ch], w1 = convw[1 * 2048 + isq * 1024 + ch], w2 = convw[2 * 2048 + isq * 1024 + ch];
        const bf16_t* p = P + (size_t)row * ML_LD + col;
        float v = w1 * bf2f(p[0]);
        if (pos > 0) v += w0 * bf2f(p[-ML_LD]);
        if (pos < len - 1) v += w2 * bf2f(p[ML_LD]);
        v = silu(v);
        if (isq) QC[(size_t)row * D + ch] = (bf16_t)f2bf(v); else KC[(size_t)row * D + ch] = (bf16_t)f2bf(v * 0.0625f);
    }
}
__device__ void ml_scan_naive_phase(const bf16_t* P, const float* G32, const float* gate_b, const bf16_t* QC, const bf16_t* KC, float* HS, LAS unsigned char* lds) {
    const int tid = TID(), dvl = tid & 63, g = tid >> 6;
    LAS float* red = (LAS float*)lds;
    LAS float* redd = red + 2 * 8 * 64;
    for (int item = BID(); item < 256; item += GDIM()) {
        const int dir = item >> 7, b = (item >> 4) & 7, h = (item >> 2) & 3, sl = item & 3;
        const float bi = gate_b[dir * 8 + h], bfg = gate_b[dir * 8 + 4 + h];
        float C[32], n[32];
#pragma unroll
        for (int j = 0; j < 32; ++j) { C[j] = 0.f; n[j] = 0.f; }
        float m = 0.f;
        for (int step = 0; step < CTXL + SEQ; ++step) {
            int row;
            if (step < CTXL) row = MLAT + b * CTXL + (dir ? CTXL - 1 - step : step);
            else { const int s2 = step - CTXL; row = b * SEQ + (dir ? SEQ - 1 - s2 : s2); }
            const float ig = G32[(size_t)row * 32 + dir * 8 + h] + bi, fg = G32[(size_t)row * 32 + dir * 8 + 4 + h] + bfg;
            const float lf = log_sigmoid(fg);
            const float mn = fmaxf(lf + m, ig), fw = __expf(lf + m - mn), iw = __expf(ig - mn);
            m = mn;
            const float v = bf2f(P[(size_t)row * ML_LD + 1024 + h * 256 + sl * 64 + dvl]);
            const u32x4* qp = (const u32x4*)(QC + (size_t)row * D + h * 256 + g * 32);
            const u32x4* kp = (const u32x4*)(KC + (size_t)row * D + h * 256 + g * 32);
            float part = 0.f, dpart = 0.f;
#pragma unroll
            for (int i = 0; i < 4; ++i) {
                float qf[8], kf[8]; unpack8(qp[i], qf); unpack8(kp[i], kf);
#pragma unroll
                for (int e = 0; e < 8; ++e) {
                    const int j = 8 * i + e;
                    C[j] = fw * C[j] + (iw * kf[e]) * v; n[j] = fw * n[j] + iw * kf[e];
                    part += qf[e] * C[j]; dpart += qf[e] * n[j];
                }
            }
            const int pb = step & 1;
            red[(pb * 8 + g) * 64 + dvl] = part;
            if (dvl == 0) redd[pb * 8 + g] = dpart;
            __syncthreads();
            if (tid < 64) {
                float num = 0.f, den = 0.f;
#pragma unroll
                for (int w = 0; w < 8; ++w) { num += red[(pb * 8 + w) * 64 + tid]; den += redd[pb * 8 + w]; }
                HS[((size_t)dir * MTOT + row) * D + h * 256 + sl * 64 + tid] = num / fmaxf(fabsf(den), __expf(-m));
            }
        }
        __syncthreads();
    }
}
__device__ void ml_readout_phase(const bf16_t* P, const bf16_t* HS, const float* ng, bf16_t* U) {
    const int lane = TID() & 63, gw = BID() * 8 + (TID() >> 6), ngw = GDIM() * 8;
    for (int row = gw; row < MTOT; row += ngw) {
        const int c0 = lane * 16;
        float v[16]; float ss = 0.f;
#pragma unroll
        for (int i = 0; i < 2; ++i) {
            float f0[8], f1[8]; unpack8(*(const u32x4*)(HS + (size_t)row * D + c0 + 8 * i), f0); unpack8(*(const u32x4*)(HS + ((size_t)MTOT + row) * D + c0 + 8 * i), f1);
#pragma unroll
            for (int e = 0; e < 8; ++e) { v[8 * i + e] = f0[e] + f1[e]; ss += v[8 * i + e] * v[8 * i + e]; }
        }
        ss += shx(ss, 1); ss += shx(ss, 2); ss += shx(ss, 4); ss += shx(ss, 8);
        const float rstd = rsqrtf(ss * (1.f / 256.f) + 1e-6f);
        const bf16_t* op = P + (size_t)row * ML_LD + ML_NKVG + D + c0;
        unsigned o[8];
#pragma unroll
        for (int i = 0; i < 8; ++i) {
            const float y0 = sigmoidf_(bf2f(op[2 * i])) * v[2 * i] * rstd * ng[c0 + 2 * i], y1 = sigmoidf_(bf2f(op[2 * i + 1])) * v[2 * i + 1] * rstd * ng[c0 + 2 * i + 1];
            o[i] = pk2(y0, y1);
        }
        u32x4* up = (u32x4*)(U + (size_t)row * D + c0);
        up[0] = (u32x4){o[0], o[1], o[2], o[3]}; up[1] = (u32x4){o[4], o[5], o[6], o[7]};
    }
}

constexpr int GL_LD = 3328, GL_NKVG = 1568;
__device__ void gla_prep_phase(const float* G32, const float* wgu, const float* bg, float* LA) {
    const int gt = BID() * 512 + TID(), ngt = GDIM() * 512;
    for (long it = gt; it < (long)2 * MTOT * 512; it += ngt) {
        const int c = (int)(it & 511), row = (int)((it >> 9) % MTOT), dir = (int)(it / ((long)MTOT * 512));
        const float* low = G32 + (size_t)row * 32 + dir * 16;
        float acc = bg[dir * 512 + c];
#pragma unroll
        for (int r = 0; r < 16; ++r) acc += low[r] * wgu[(dir * 16 + r) * 512 + c];
        LA[((size_t)dir * MTOT + row) * 512 + c] = log_sigmoid(acc) * (1.f / 16.f);
    }
}
__device__ void gla_scan_naive_phase(const bf16_t* P, const float* LA, float* HS, LAS unsigned char* lds) {
    const int tid = TID(), dvl = tid & 63, g = tid >> 6;
    LAS float* red = (LAS float*)lds;
    for (int item = BID(); item < 256; item += GDIM()) {
        const int dir = item >> 7, b = (item >> 4) & 7, h = (item >> 2) & 3, sl = item & 3;
        float S[16];
#pragma unroll
        for (int j = 0; j < 16; ++j) S[j] = 0.f;
        for (int step = 0; step < CTXL + SEQ; ++step) {
            int row;
            if (step < CTXL) row = MLAT + b * CTXL + (dir ? CTXL - 1 - step : step);
            else { const int s2 = step - CTXL; row = b * SEQ + (dir ? SEQ - 1 - s2 : s2); }
            const float v = bf2f(P[(size_t)row * GL_LD + 512 + h * 256 + sl * 64 + dvl]);
            const u32x4* kp = (const u32x4*)(P + (size_t)row * GL_LD + h * 128 + g * 16);
            const u32x4* qp = (const u32x4*)(P + (size_t)row * GL_LD + GL_NKVG + h * 128 + g * 16);
            const f32x4* lp = (const f32x4*)(LA + ((size_t)dir * MTOT + row) * 512 + h * 128 + g * 16);
            float part = 0.f;
#pragma unroll
            for (int i = 0; i < 2; ++i) {
                float qf[8], kf[8]; unpack8(qp[i], qf); unpack8(kp[i], kf);
                const f32x4 la0 = lp[2 * i], la1 = lp[2 * i + 1];
#pragma unroll
                for (int e = 0; e < 8; ++e) {
                    const int j = 8 * i + e; const float al = __expf(e < 4 ? la0[e] : la1[e - 4]);
                    S[j] = al * S[j] + kf[e] * v; part += qf[e] * S[j];
                }
            }
            const int pb = step & 1;
            red[(pb * 8 + g) * 64 + dvl] = part;
            __syncthreads();
            if (tid < 64 && step >= CTXL) {
                float num = 0.f;
#pragma unroll
                for (int w = 0; w < 8; ++w) num += red[(pb * 8 + w) * 64 + tid];
                HS[((size_t)dir * MTOT + row) * D + h * 256 + sl * 64 + tid] = num * 0.08838834764831845f;
            }
        }
        __syncthreads();
    }
}
__device__ void gla_readout_phase(const bf16_t* P, const bf16_t* HS, const float* ng, bf16_t* U) {
    const int lane = TID() & 63, gw = BID() * 8 + (TID() >> 6), ngw = GDIM() * 8;
    for (int row = gw; row < MLAT; row += ngw) {
        const int c0 = lane * 16;
        float v[16]; float ss = 0.f;
#pragma unroll
        for (int i = 0; i < 2; ++i) {
            float f0[8], f1[8]; unpack8(*(const u32x4*)(HS + (size_t)row * D + c0 + 8 * i), f0); unpack8(*(const u32x4*)(HS + ((size_t)MTOT + row) * D + c0 + 8 * i), f1);
#pragma unroll
            for (int e = 0; e < 8; ++e) { v[8 * i + e] = f0[e] + f1[e]; ss += v[8 * i + e] * v[8 * i + e]; }
        }
        ss += shx(ss, 1); ss += shx(ss, 2); ss += shx(ss, 4); ss += shx(ss, 8);
        const float rstd = rsqrtf(ss * (1.f / 256.f) + 1e-6f);
        const bf16_t* rp = P + (size_t)row * GL_LD + GL_NKVG + 512 + c0;
        unsigned o[8];
#pragma unroll
        for (int i = 0; i < 8; ++i) {
            const float y0 = silu(bf2f(rp[2 * i])) * v[2 * i] * rstd * ng[c0 + 2 * i], y1 = silu(bf2f(rp[2 * i + 1])) * v[2 * i + 1] * rstd * ng[c0 + 2 * i + 1];
            o[i] = pk2(y0, y1);
        }
        u32x4* up = (u32x4*)(U + (size_t)row * D + c0);
        up[0] = (u32x4){o[0], o[1], o[2], o[3]}; up[1] = (u32x4){o[4], o[5], o[6], o[7]};
    }
}


__device__ __forceinline__ int chunk_row0(int cidx) { return cidx < 256 ? (cidx >> 5) * 2048 + (cidx & 31) * 64 : MLAT + ((cidx - 256) >> 2) * 256 + ((cidx - 256) & 3) * 64; }
__device__ void ml_prep2_phase(const bf16_t* P, const float* G32, const float* gate_b, const float* convw, bf16_t* QC, bf16_t* KC, bf16_t* KBT, unsigned char* sc, LAS unsigned char* lds) {
    constexpr int KTS = 258;
    const int tid = TID();
    LAS bf16_t* ktile = (LAS bf16_t*)lds;
    LAS float* lfL = (LAS float*)(lds + 64 * KTS * 2);
    LAS float* igL = lfL + 128; LAS float* aL = igL + 128; LAS float* aeL = aL + 128;
    float* SA = (float*)(sc + SC_SA); float* SMX = (float*)(sc + SC_SMX); float* SB = (float*)(sc + SC_SB); float* CE = (float*)(sc + SC_CE);
    for (int item = BID(); item < 288 * 4; item += GDIM()) {
        const int cidx = item >> 2, h = item & 3, row0 = chunk_row0(cidx);
        const int p0 = cidx < 256 ? (cidx & 31) * 64 : ((cidx - 256) & 3) * 64, len = cidx < 256 ? 2048 : 256;
        if (tid < 128) { const int dir = tid >> 6, tau = tid & 63; const float* gp = G32 + (size_t)(row0 + tau) * 32 + dir * 8 + h;
            igL[dir * 64 + tau] = gp[0] + gate_b[dir * 8 + h]; lfL[dir * 64 + tau] = log_sigmoid(gp[4] + gate_b[dir * 8 + 4 + h]); }
        for (int idx = tid; idx < 2 * 64 * 256; idx += 512) {
            const int isq = idx >> 14, tau = (idx >> 8) & 63, ch = idx & 255, c = h * 256 + ch, row = row0 + tau, pos = p0 + tau;
            const float w0 = convw[0 * 2048 + isq * 1024 + c], w1 = convw[1 * 2048 + isq * 1024 + c], w2 = convw[2 * 2048 + isq * 1024 + c];
            const bf16_t* pp = P + (size_t)row * ML_LD + (isq ? ML_NKVG + c : c);
            float v = w1 * bf2f(pp[0]);
            if (pos > 0) v += w0 * bf2f(pp[-ML_LD]);
            if (pos < len - 1) v += w2 * bf2f(pp[ML_LD]);
            v = silu(v);
            if (isq) QC[(size_t)row * D + c] = (bf16_t)f2bf(v);
            else { const bf16_t kb = (bf16_t)f2bf(v * 0.0625f); KC[(size_t)row * D + c] = kb; ktile[tau * KTS + ch] = kb; }
        }
        __syncthreads();
        if (tid < 2) {
            const int dir = tid; float run = 0.f, mx = -1e30f;
            for (int pp = 0; pp < 64; ++pp) {
                const int tau = dir ? 63 - pp : pp;
                run += lfL[dir * 64 + tau]; const float av = igL[dir * 64 + tau] - run; mx = fmaxf(mx, av);
                const size_t o = ((size_t)(dir * 4 + h)) * MTOT + row0 + tau;
                SB[o] = run; SA[o] = av; SMX[o] = mx; aL[dir * 64 + tau] = av;
            }
            CE[((dir * 4 + h) * 288 + cidx) * 2] = mx; CE[((dir * 4 + h) * 288 + cidx) * 2 + 1] = run; aeL[dir] = mx;
        }
        __syncthreads();
        for (int idx = tid; idx < 2 * 256 * 8; idx += 512) {
            const int dir = idx >> 11, dk = (idx >> 3) & 255, sc8 = idx & 7; const float ae = aeL[dir];
            unsigned o[4];
#pragma unroll
            for (int i = 0; i < 4; ++i) { const int s0 = sc8 * 8 + 2 * i;
                o[i] = pk2(bf2f(ktile[s0 * KTS + dk]) * __expf(aL[dir * 64 + s0] - ae), bf2f(ktile[(s0 + 1) * KTS + dk]) * __expf(aL[dir * 64 + s0 + 1] - ae)); }
            *(u32x4*)(KBT + ((size_t)dir * D + h * 256 + dk) * MTOT + row0 + sc8 * 8) = (u32x4){o[0], o[1], o[2], o[3]};
        }
        __syncthreads();
    }
}
__device__ void gla_prep2_phase(const bf16_t* P, const float* G32, const float* wgu, const float* bg, bf16_t* QA, bf16_t* KA, bf16_t* KBT, unsigned char* sc, LAS unsigned char* lds) {
    const int tid = TID();
    LAS float* laL = (LAS float*)lds;
    LAS float* beL = laL + 2 * 64 * 128;
    float* DEC = (float*)(sc + SC_DEC);
    for (int item = BID(); item < 288 * 4; item += GDIM()) {
        const int cidx = item >> 2, h = item & 3, row0 = chunk_row0(cidx);
        {
            const int dk = tid & 127, dir = (tid >> 7) & 1, tg = tid >> 8;
            float w[16];
#pragma unroll
            for (int r = 0; r < 16; ++r) w[r] = wgu[(dir * 16 + r) * 512 + h * 128 + dk];
            const float bgv = bg[dir * 512 + h * 128 + dk];
            for (int tau = tg * 32; tau < tg * 32 + 32; ++tau) {
                const float* low = G32 + (size_t)(row0 + tau) * 32 + dir * 16;
                float acc = bgv;
#pragma unroll
                for (int r = 0; r < 16; ++r) acc += low[r] * w[r];
                laL[(dir * 64 + tau) * 128 + dk] = log_sigmoid(acc) * (1.f / 16.f);
            }
        }
        __syncthreads();
        if (tid < 256) {
            const int dir = tid >> 7, dk = tid & 127; float run = 0.f;
            for (int pp = 0; pp < 64; ++pp) { const int tau = dir ? 63 - pp : pp; run += laL[(dir * 64 + tau) * 128 + dk]; laL[(dir * 64 + tau) * 128 + dk] = run; }
            beL[dir * 128 + dk] = run; DEC[((size_t)dir * 288 + cidx) * 512 + h * 128 + dk] = __expf(run);
        }
        __syncthreads();
        for (int idx = tid; idx < 2 * 64 * 128; idx += 512) {
            const int dir = idx >> 13, tau = (idx >> 7) & 63, dk = idx & 127; const float bc = laL[(dir * 64 + tau) * 128 + dk];
            const bf16_t* pp = P + (size_t)(row0 + tau) * GL_LD + h * 128 + dk;
            const size_t o = ((size_t)dir * MTOT + row0 + tau) * 512 + h * 128 + dk;
            QA[o] = (bf16_t)f2bf(bf2f(pp[GL_NKVG]) * __expf(bc) * 0.08838834764831845f); KA[o] = (bf16_t)f2bf(bf2f(pp[0]) * __expf(-bc));
        }
        for (int idx = tid; idx < 2 * 128 * 8; idx += 512) {
            const int dir = idx >> 10, dk = (idx >> 3) & 127, sc8 = idx & 7; const float be = beL[dir * 128 + dk];
            unsigned o[4];
#pragma unroll
            for (int i = 0; i < 4; ++i) { const int s0 = sc8 * 8 + 2 * i; const bf16_t* pp = P + (size_t)(row0 + s0) * GL_LD + h * 128 + dk;
                o[i] = pk2(bf2f(pp[0]) * __expf(be - laL[(dir * 64 + s0) * 128 + dk]), bf2f(pp[GL_LD]) * __expf(be - laL[(dir * 64 + s0 + 1) * 128 + dk])); }
            *(u32x4*)(KBT + ((size_t)dir * 512 + h * 128 + dk) * MTOT + row0 + sc8 * 8) = (u32x4){o[0], o[1], o[2], o[3]};
        }
        __syncthreads();
    }
}

__device__ __forceinline__ float lane_up(float v, int lane, int off) { return __builtin_bit_cast(float, __builtin_amdgcn_ds_bpermute(((lane - off) & 63) << 2, __builtin_bit_cast(int, v))); }
__device__ void ml_prep3_phase(const bf16_t* P, const float* G32, const float* gate_b, const float* convw, bf16_t* QC, bf16_t* KC, bf16_t* KBT, unsigned char* sc, LAS unsigned char* lds) {
    const int tid = TID(), lane = tid & 63, wid = tid >> 6;
    LAS float* aL = (LAS float*)lds;
    LAS float* aeL = aL + 128;
    float* SA = (float*)(sc + SC_SA); float* SMX = (float*)(sc + SC_SMX); float* SB = (float*)(sc + SC_SB); float* CE = (float*)(sc + SC_CE);
    for (int item = BID(); item < 288 * 4; item += GDIM()) {
        const int cidx = item >> 2, h = item & 3, row0 = chunk_row0(cidx);
        const int p0 = cidx < 256 ? (cidx & 31) * 64 : ((cidx - 256) & 3) * 64, len = cidx < 256 ? 2048 : 256;
        if (wid < 2) {
            const int dir = wid, tau = dir ? 63 - lane : lane;
            const float* gp = G32 + (size_t)(row0 + tau) * 32 + dir * 8 + h;
            const float ig = gp[0] + gate_b[dir * 8 + h];
            float run = log_sigmoid(gp[4] + gate_b[dir * 8 + 4 + h]);
#pragma unroll
            for (int off = 1; off < 64; off <<= 1) { const float v = lane_up(run, lane, off); if (lane >= off) run += v; }
            const float av = ig - run; float mx = av;
#pragma unroll
            for (int off = 1; off < 64; off <<= 1) { const float v = lane_up(mx, lane, off); if (lane >= off) mx = fmaxf(mx, v); }
            const size_t o = ((size_t)(dir * 4 + h)) * MTOT + row0 + tau;
            SB[o] = run; SA[o] = av; SMX[o] = mx; aL[dir * 64 + tau] = av;
            if (lane == 63) { CE[((dir * 4 + h) * 288 + cidx) * 2] = mx; CE[((dir * 4 + h) * 288 + cidx) * 2 + 1] = run; aeL[dir] = mx; }
        }
        __syncthreads();
        const int c = h * 256 + (tid & 63) * 4, tau0 = (tid >> 6) * 8;
        float kr[8][4];
#pragma unroll
        for (int isq = 0; isq < 2; ++isq) {
            const f32x4 w0 = *(const f32x4*)(convw + 0 * 2048 + isq * 1024 + c), w1 = *(const f32x4*)(convw + 1 * 2048 + isq * 1024 + c), w2 = *(const f32x4*)(convw + 2 * 2048 + isq * 1024 + c);
            const bf16_t* pp = P + (size_t)(row0 + tau0) * ML_LD + (isq ? ML_NKVG + c : c);
            f32x4 x[10];
#pragma unroll
            for (int i = 0; i < 10; ++i) {
                const int pos = p0 + tau0 + i - 1;
                u32x2 v = (u32x2){0u, 0u};
                if (pos >= 0 && pos < len) v = *(const u32x2*)(pp + (long)(i - 1) * ML_LD);
                x[i] = (f32x4){bflo(v.x), bfhi(v.x), bflo(v.y), bfhi(v.y)};
            }
#pragma unroll
            for (int i = 0; i < 8; ++i) {
                f32x4 y = w0 * x[i] + w1 * x[i + 1] + w2 * x[i + 2];
#pragma unroll
                for (int e = 0; e < 4; ++e) y[e] = silu(y[e]);
                if (isq) { u32x2 o; o.x = pk2(y[0], y[1]); o.y = pk2(y[2], y[3]); *(u32x2*)(QC + (size_t)(row0 + tau0 + i) * D + c) = o; }
                else { y = y * 0.0625f; u32x2 o; o.x = pk2(y[0], y[1]); o.y = pk2(y[2], y[3]); *(u32x2*)(KC + (size_t)(row0 + tau0 + i) * D + c) = o;
                    kr[i][0] = bflo(o.x); kr[i][1] = bfhi(o.x); kr[i][2] = bflo(o.y); kr[i][3] = bfhi(o.y); }
            }
        }
#pragma unroll
        for (int dir = 0; dir < 2; ++dir) {
            const float ae = aeL[dir]; float wv[8];
#pragma unroll
            for (int i = 0; i < 8; ++i) wv[i] = __expf(aL[dir * 64 + tau0 + i] - ae);
#pragma unroll
            for (int e = 0; e < 4; ++e) {
                u32x4 o; o.x = pk2(kr[0][e] * wv[0], kr[1][e] * wv[1]); o.y = pk2(kr[2][e] * wv[2], kr[3][e] * wv[3]); o.z = pk2(kr[4][e] * wv[4], kr[5][e] * wv[5]); o.w = pk2(kr[6][e] * wv[6], kr[7][e] * wv[7]);
                *(u32x4*)(KBT + ((size_t)dir * D + c + e) * MTOT + row0 + tau0) = o;
            }
        }
        __syncthreads();
    }
}
__device__ void gla_prep3_phase(const bf16_t* P, const float* G32, const float* wgu, const float* bg, bf16_t* QA, bf16_t* KA, bf16_t* KBT, unsigned char* sc, LAS unsigned char* lds) {
    const int tid = TID(), dk = tid & 127, dir = (tid >> 7) & 1, tg = tid >> 8;
    LAS float* lowL = (LAS float*)lds;
    LAS float* totL = lowL + 2048;
    float* DEC = (float*)(sc + SC_DEC);
    for (int item = BID(); item < 288 * 4; item += GDIM()) {
        const int cidx = item >> 2, h = item & 3, row0 = chunk_row0(cidx);
        *(LAS f32x4*)(lowL + tid * 4) = *(const f32x4*)(G32 + (size_t)row0 * 32 + tid * 4);
        float w[16];
#pragma unroll
        for (int r = 0; r < 16; ++r) w[r] = wgu[(dir * 16 + r) * 512 + h * 128 + dk];
        const float bgv = bg[dir * 512 + h * 128 + dk];
        __syncthreads();
        float la[32];
#pragma unroll
        for (int j = 0; j < 32; ++j) {
            const LAS f32x4* lp = (const LAS f32x4*)(lowL + (tg * 32 + j) * 32 + dir * 16);
            const f32x4 l0 = lp[0], l1 = lp[1], l2 = lp[2], l3 = lp[3];
            float acc = bgv;
#pragma unroll
            for (int e = 0; e < 4; ++e) acc += l0[e] * w[e] + l1[e] * w[4 + e] + l2[e] * w[8 + e] + l3[e] * w[12 + e];
            la[j] = log_sigmoid(acc) * (1.f / 16.f);
        }
        float run = 0.f;
        if (dir == 0) {
#pragma unroll
            for (int j = 0; j < 32; ++j) { run += la[j]; la[j] = run; }
        } else {
#pragma unroll
            for (int j = 31; j >= 0; --j) { run += la[j]; la[j] = run; }
        }
        totL[(dir * 2 + tg) * 128 + dk] = run;
        __syncthreads();
        const float t0 = totL[(dir * 2 + 0) * 128 + dk], t1 = totL[(dir * 2 + 1) * 128 + dk], be = t0 + t1;
        const float offs = dir == 0 ? (tg ? t0 : 0.f) : (tg ? 0.f : t1);
        if (tg == 0) DEC[((size_t)dir * 288 + cidx) * 512 + h * 128 + dk] = __expf(be);
        unsigned kb[16];
#pragma unroll
        for (int j2 = 0; j2 < 16; ++j2) {
            float kv[2];
#pragma unroll
            for (int u = 0; u < 2; ++u) {
                const int j = 2 * j2 + u, row = row0 + tg * 32 + j; const float bc = la[j] + offs;
                const bf16_t* pp = P + (size_t)row * GL_LD + h * 128 + dk;
                const float kf = bf2f(pp[0]), qf = bf2f(pp[GL_NKVG]);
                const size_t o = ((size_t)dir * MTOT + row) * 512 + h * 128 + dk;
                QA[o] = (bf16_t)f2bf(qf * __expf(bc) * 0.08838834764831845f); KA[o] = (bf16_t)f2bf(kf * __expf(-bc));
                kv[u] = kf * __expf(be - bc);
            }
            kb[j2] = pk2(kv[0], kv[1]);
        }
        bf16_t* kp = KBT + ((size_t)dir * 512 + h * 128 + dk) * MTOT + row0 + tg * 32;
#pragma unroll
        for (int i = 0; i < 4; ++i) *(u32x4*)(kp + 8 * i) = (u32x4){kb[4 * i], kb[4 * i + 1], kb[4 * i + 2], kb[4 * i + 3]};
        __syncthreads();
    }
}
template <int DK, bool ML>
__device__ void chunk_scan_phase(const bf16_t* QAg, const bf16_t* KAg, size_t qa_dir_stride, const bf16_t* KBT, const bf16_t* VT, const unsigned char* sc, bf16_t* HS, LAS unsigned char* lds) {
    constexpr int RS = 4 * DK;
    constexpr int QS = DK * 2 + 16, VS = 144;
    constexpr int NG = DK / 64;
    constexpr int OFF_QA = 0, OFF_KA = 64 * QS, OFF_KBT = 2 * 64 * QS, OFF_VT = OFF_KBT + DK * VS, OFF_PT = OFF_VT + 64 * VS, OFF_TAB = OFF_PT + 8192;
    static_assert(OFF_TAB + 8192 <= 135168, "LDS");
    const int tid = TID(), lane = tid & 63, wid = tid >> 6, m16 = lane & 15, quad = lane >> 4, dt = wid & 3, kh = wid >> 2;
    LAS float* aL = (LAS float*)(lds + OFF_TAB);
    LAS float* mxL = aL + 64; LAS float* bL = aL + 128;
    LAS float* rsL = aL + 256;
    LAS float* qnL = aL + 384;
    LAS float* nL = aL + 896;
    LAS float* decL = aL;
    LAS f32x4* XL = (LAS f32x4*)(lds + OFF_KA);
    const float* SA = (const float*)(sc + SC_SA); const float* SMX = (const float*)(sc + SC_SMX); const float* SB = (const float*)(sc + SC_SB); const float* CE = (const float*)(sc + SC_CE);
    const float* DEC = (const float*)(sc + SC_DEC);
    for (int item = BID(); item < 256; item += GDIM()) {
        const int dir = item >> 7, b = (item >> 4) & 7, h = (item >> 2) & 3, sl = item & 3;
        const bf16_t* QAd = QAg + dir * qa_dir_stride; const bf16_t* KAd = KAg + dir * qa_dir_stride;
        const bf16_t* KBTd = KBT + ((size_t)dir * 4 * DK + h * DK) * MTOT;
        const bf16_t* VTd = VT + (size_t)(h * 256 + sl * 64) * MTOT;
        f32x4 Cst[NG][2];
#pragma unroll
        for (int g = 0; g < NG; ++g) { Cst[g][0] = (f32x4){0.f, 0.f, 0.f, 0.f}; Cst[g][1] = (f32x4){0.f, 0.f, 0.f, 0.f}; }
        float mrun = 0.f;
        if (ML && tid < 256) nL[tid] = 0.f;
        constexpr int NQ = DK / 64;
        u32x4 pq[NQ], pk[NQ], pb[NQ], pv;
#define SCAN_ROW0(CI, R0) const int ci_ = (CI); const int cx_ = ci_ < 4 ? 256 + b * 4 + (dir ? 3 - ci_ : ci_) : b * 32 + (dir ? 35 - ci_ : ci_ - 4); const int R0 = chunk_row0(cx_);
#define SCAN_ISSUE_QK(CI) do { SCAN_ROW0(CI, r0_) \
            _Pragma("unroll") for (int i = 0; i < NQ; ++i) { const int c = tid + i * 512, r = c / (DK / 8), cc = c % (DK / 8); \
                pq[i] = *(const GAS u32x4*)(QAd + (size_t)(r0_ + r) * RS + h * DK + cc * 8); pk[i] = *(const GAS u32x4*)(KAd + (size_t)(r0_ + r) * RS + h * DK + cc * 8); } } while (0)
#define SCAN_ISSUE_BV(CI) do { SCAN_ROW0(CI, r0_) \
            _Pragma("unroll") for (int i = 0; i < NQ; ++i) { const int c = tid + i * 512, r = c >> 3, cc = c & 7; pb[i] = *(const GAS u32x4*)(KBTd + (size_t)r * MTOT + r0_ + cc * 8); } \
            { const int r = tid >> 3, cc = tid & 7; pv = *(const GAS u32x4*)(VTd + (size_t)r * MTOT + r0_ + cc * 8); } } while (0)
        SCAN_ISSUE_QK(0);
#pragma unroll 1
        for (int ci = 0; ci < 36; ++ci) {
            int cidx;
            if (ci < 4) cidx = 256 + b * 4 + (dir ? 3 - ci : ci); else cidx = b * 32 + (dir ? 35 - ci : ci - 4);
            const int row0 = chunk_row0(cidx);
#pragma unroll
            for (int i = 0; i < NQ; ++i) {
                const int c = tid + i * 512, r = c / (DK / 8), cc = c % (DK / 8);
                const int rho = ((r >> 5) * 2 + ((r >> 2) & 1)) * 16 + ((r >> 3) & 3) * 4 + (r & 3);
                *(LAS u32x4*)(lds + OFF_QA + r * QS + cc * 16) = pq[i]; *(LAS u32x4*)(lds + OFF_KA + rho * QS + cc * 16) = pk[i];
            }
            SCAN_ISSUE_BV(ci);
            float ae = 0.f, be = 0.f;
            if (ML) {
                if (tid < 64) aL[tid] = ((const GAS float*)SA)[(size_t)(dir * 4 + h) * MTOT + row0 + tid];
                else if (tid < 128) aL[tid] = ((const GAS float*)SMX)[(size_t)(dir * 4 + h) * MTOT + row0 + tid - 64];
                else if (tid < 192) aL[tid] = ((const GAS float*)SB)[(size_t)(dir * 4 + h) * MTOT + row0 + tid - 128];
                ae = ((const GAS float*)CE)[((dir * 4 + h) * 288 + cidx) * 2]; be = ((const GAS float*)CE)[((dir * 4 + h) * 288 + cidx) * 2 + 1];
            } else {
                if (tid < DK) decL[tid] = ((const GAS float*)DEC)[((size_t)dir * 288 + cidx) * 512 + h * DK + tid];
            }
            __syncthreads();
            f32x4 st[2] = {(f32x4){0.f, 0.f, 0.f, 0.f}, (f32x4){0.f, 0.f, 0.f, 0.f}};
#pragma unroll
            for (int ks = 0; ks < DK / 32; ++ks) {
                const bf16x8 Bq = *(LAS const bf16x8*)(lds + OFF_QA + (dt * 16 + m16) * QS + (ks * 32 + quad * 8) * 2);
#pragma unroll
                for (int T = 0; T < 2; ++T) {
                    const bf16x8 Ak = *(LAS const bf16x8*)(lds + OFF_KA + ((kh * 2 + T) * 16 + m16) * QS + (ks * 32 + quad * 8) * 2);
                    st[T] = __builtin_amdgcn_mfma_f32_16x16x32_bf16(Ak, Bq, st[T], 0, 0, 0);
                }
            }
            const int tloc = dt * 16 + m16;
            float Mt = 0.f;
            if (ML) Mt = fmaxf(mrun, mxL[tloc]);
            float rsum = 0.f;
#pragma unroll
            for (int T = 0; T < 2; ++T)
#pragma unroll
                for (int e = 0; e < 4; ++e) {
                    const int sloc = kh * 32 + quad * 8 + T * 4 + e;
                    const bool valid = dir ? (sloc >= tloc) : (sloc <= tloc);
                    float wgt = valid ? 1.f : 0.f;
                    if (ML) wgt = valid ? __expf(aL[sloc] - Mt) : 0.f;
                    const float pv = st[T][e] * wgt; st[T][e] = pv; rsum += pv;
                }
            *(LAS bf16x8*)(lds + OFF_PT + ((kh * 4 + dt) * 64 + lane) * 16) = pack8(st[0], st[1]);
            if (ML) {
                rsum += shx(rsum, 16); rsum += shx(rsum, 32);
                if (quad == 0) rsL[kh * 64 + tloc] = rsum;
                float qn = 0.f;
#pragma unroll
                for (int i = 0; i < 4; ++i) { float qf8[8]; unpack8(*(LAS const u32x4*)(lds + OFF_QA + lane * QS + (wid * 32 + i * 8) * 2), qf8);
#pragma unroll
                    for (int e = 0; e < 8; ++e) qn += qf8[e] * nL[wid * 32 + i * 8 + e]; }
                qnL[wid * 64 + lane] = qn;
            }
#pragma unroll
            for (int i = 0; i < NQ; ++i) {
                const int c = tid + i * 512, r = c >> 3, cc = c & 7;
                const int rho = (r & ~31) + ((r >> 2) & 1) * 16 + ((r >> 3) & 3) * 4 + (r & 3);
                *(LAS u32x4*)(lds + OFF_KBT + rho * VS + cc * 16) = pb[i];
            }
            { const int r = tid >> 3, cc = tid & 7; *(LAS u32x4*)(lds + OFF_VT + r * VS + cc * 16) = pv; }
            __syncthreads();
            if (ci + 1 < 36) SCAN_ISSUE_QK(ci + 1);
            f32x4 numT[4];
#pragma unroll
            for (int tt = 0; tt < 4; ++tt) numT[tt] = (f32x4){0.f, 0.f, 0.f, 0.f};
#pragma unroll
            for (int g = 0; g < NG; ++g) {
                const bf16x8 Ac = pack8(Cst[g][0], Cst[g][1]);
#pragma unroll
                for (int tt = 0; tt < 4; ++tt) {
                    const bf16x8 Bq = *(LAS const bf16x8*)(lds + OFF_QA + (tt * 16 + m16) * QS + (kh * (DK / 2) + g * 32 + quad * 8) * 2);
                    numT[tt] = __builtin_amdgcn_mfma_f32_16x16x32_bf16(Ac, Bq, numT[tt], 0, 0, 0);
                }
            }
            if (ML) {
#pragma unroll
                for (int tt = 0; tt < 4; ++tt) { const float wi = __expf(mrun - fmaxf(mrun, mxL[tt * 16 + m16])); numT[tt] = numT[tt] * wi; }
            }
            {
                const bf16x8 Av = *(LAS const bf16x8*)(lds + OFF_VT + (dt * 16 + m16) * VS + (kh * 32 + quad * 8) * 2);
#pragma unroll
                for (int tt = 0; tt < 4; ++tt) {
                    const bf16x8 Bp = *(LAS const bf16x8*)(lds + OFF_PT + ((kh * 4 + tt) * 64 + lane) * 16);
                    numT[tt] = __builtin_amdgcn_mfma_f32_16x16x32_bf16(Av, Bp, numT[tt], 0, 0, 0);
                }
            }
            {
                float cs = 1.f;
                if (ML) {
                    const float mm = fmaxf(mrun, ae), ratio = __expf(mrun - ae); cs = __expf(ae - mm);
#pragma unroll
                    for (int g = 0; g < NG; ++g) { Cst[g][0] = Cst[g][0] * ratio; Cst[g][1] = Cst[g][1] * ratio; }
                } else {
#pragma unroll
                    for (int g = 0; g < NG; ++g)
#pragma unroll
                        for (int T = 0; T < 2; ++T) { const f32x4 d4 = *(LAS const f32x4*)(decL + kh * (DK / 2) + g * 32 + quad * 8 + T * 4); Cst[g][T] = Cst[g][T] * d4; }
                }
#pragma unroll
                for (int k2 = 0; k2 < 2; ++k2) {
                    const bf16x8 Bv = *(LAS const bf16x8*)(lds + OFF_VT + (dt * 16 + m16) * VS + (k2 * 32 + quad * 8) * 2);
#pragma unroll
                    for (int g = 0; g < NG; ++g)
#pragma unroll
                        for (int T = 0; T < 2; ++T) {
                            const bf16x8 Ak = *(LAS const bf16x8*)(lds + OFF_KBT + (kh * (DK / 2) + g * 32 + T * 16 + m16) * VS + (k2 * 32 + quad * 8) * 2);
                            Cst[g][T] = __builtin_amdgcn_mfma_f32_16x16x32_bf16(Ak, Bv, Cst[g][T], 0, 0, 0);
                        }
                }
                if (ML) {
#pragma unroll
                    for (int g = 0; g < NG; ++g) { Cst[g][0] = Cst[g][0] * cs; Cst[g][1] = Cst[g][1] * cs; }
                }
            }
            XL[(dt * 4 + (1 - kh) * 2 + 0) * 64 + lane] = numT[(1 - kh) * 2 + 0];
            XL[(dt * 4 + (1 - kh) * 2 + 1) * 64 + lane] = numT[(1 - kh) * 2 + 1];
            if (ML && tid < 256) {
                const float mm = fmaxf(mrun, ae), wold = __expf(mrun - mm), cs = __expf(ae - mm);
                const int rho = (tid & ~31) + ((tid >> 2) & 1) * 16 + ((tid >> 3) & 3) * 4 + (tid & 3);
                float sm = 0.f;
#pragma unroll
                for (int i = 0; i < 8; ++i) { float kf8[8]; unpack8(*(LAS const u32x4*)(lds + OFF_KBT + rho * VS + i * 16), kf8);
#pragma unroll
                    for (int e = 0; e < 8; ++e) sm += kf8[e]; }
                nL[tid] = wold * nL[tid] + cs * sm;
            }
            __syncthreads();
            const bool want_out = ML || ci >= 4;
            if (want_out) {
#pragma unroll
                for (int q2 = 0; q2 < 2; ++q2) {
                    const int tt = kh * 2 + q2, t = tt * 16 + m16;
                    f32x4 v = (kh ? numT[2 + q2] : numT[q2]) + XL[(dt * 4 + tt) * 64 + lane];
                    if (ML) {
                        const float Mtt = fmaxf(mrun, mxL[t]), wi = __expf(mrun - Mtt);
                        float qn = 0.f;
#pragma unroll
                        for (int pp = 0; pp < 8; ++pp) qn += qnL[pp * 64 + t];
                        const float den = wi * qn + rsL[t] + rsL[64 + t];
                        v = v * (1.f / fmaxf(fabsf(den), __expf(-(bL[t] + Mtt))));
                    }
                    u32x2 o; o.x = pk2(v[0], v[1]); o.y = pk2(v[2], v[3]);
                    *(GAS u32x2*)(HS + ((size_t)dir * MTOT + row0 + t) * D + h * 256 + sl * 64 + dt * 16 + quad * 4) = o;
                }
            }
            if (ML) { const float mm = fmaxf(mrun, ae); mrun = be + mm; }
            __syncthreads();
        }
    }
}

__device__ __forceinline__ bool phase_exists(int ph) {
    if (ph == 0 || ph == 49) return true;
    const int l = (ph - 1) / 12, k = (ph - 1) % 12;
    if (k == 6 || k == 7) return (l & 1) != 0;
    return true;
}
template <class Epi>
__device__ __forceinline__ void run_gemm(LAS unsigned char* lds, const bf16_t* A, const bf16_t* Bt, int M, int N, int K, const Epi& E) {
    pg8::Gemm g; g.A = A; g.Bt = Bt; g.M = M; g.N = N; g.K = K; g.Kc = K;
    pg8::StaticOrder S; S.init(M, N, K, (int)GDIM(), (int)BID());
    pg8::gemm_phase<Epi, pg8::StaticOrder, true, true>(lds, g, S, E);
}
static_assert((WS_DP - WS_H) / 4 == (size_t)pg8::DPOFF && (WS_DP - WS_H) % 4 == 0, "DPOFF");
__device__ __forceinline__ void run_resid_gemm(LAS unsigned char* lds, const bf16_t* A, const bf16_t* Bt, int Mr, int K, float* H, const float* gate) {
    pg8::EpiResid E; E.H = H; E.gate = gate;
    pg8::Gemm g; g.A = A; g.Bt = Bt; g.M = Mr; g.N = D; g.K = K; g.Kc = K;
    pg8::ResidOrder S; S.init(K, Mr == MTOT ? 1 : 0, (int)GDIM(), (int)BID());
    pg8::gemm_phase<pg8::EpiResid, pg8::ResidOrder, true, true>(lds, g, S, E);
}
#define INP(i) ((const float*)(const GAS float*)a.in[i])
__device__ void run_phase(const Args& a, int ph, LAS unsigned char* lds) {
    GAS unsigned char* wsg = (GAS unsigned char*)a.ws; asm volatile("" : "+s"(wsg)); unsigned char* ws = (unsigned char*)wsg;
    float* H = (float*)(ws + WS_H); bf16_t* U = (bf16_t*)(ws + WS_U); bf16_t* P = (bf16_t*)(ws + WS_P); float* G32 = (float*)(ws + WS_G32);
    bf16_t* QC = (bf16_t*)(ws + WS_QC); bf16_t* KC = (bf16_t*)(ws + WS_KC); bf16_t* HS = (bf16_t*)(ws + WS_HS); bf16_t* KBT = (bf16_t*)(ws + WS_KBT); const bf16_t* VTb = (const bf16_t*)(ws + WS_VT); unsigned char* scb = ws + WS_SC;
    if (ph == 0) { p0_prologue(a, lds); return; }
    if (ph == 49) { final_norm_phase(H, INP(I_FINALG), (float*)(GAS float*)a.out); return; }
    const int l = (ph - 1) / 12, k = (ph - 1) % 12;
    const float* modl = (const float*)(ws + WS_MOD) + (size_t)l * 9 * MODLD;
    const float* ng = INP(I_NORMG) + (size_t)l * 3 * D;
    switch (k) {
    case 0: norm_phase(H, ng, modl, 0, U, MTOT, l > 0 ? (const float*)(ws + WS_DP) : nullptr); break;
    case 1: case 10: { const int f = k == 10 ? 1 : 0; pg8::EpiSwiglu E; E.O = P; E.ldc = DFF; run_gemm(lds, U, (const bf16_t*)(ws + WS_W13T + (size_t)(l * 2 + f) * W13T_SZ), (l == 3 && f == 1) ? MLAT : MTOT, 2 * DFF, D, E); } break;
    case 2: case 8: case 11: {
        const int Mr = (l == 3 && k >= 8) ? MLAT : MTOT;
        const bf16_t* A = k == 8 ? U : P; const int K = k == 8 ? D : DFF;
        const bf16_t* Bt = (const bf16_t*)(ws + (k == 8 ? WS_WO + (size_t)l * D * D * 2 : WS_W2T + (size_t)(l * 2 + (k == 11 ? 1 : 0)) * W2T_SZ));
        run_resid_gemm(lds, A, Bt, Mr, K, H, modl + (k == 2 ? 2 : k == 8 ? 5 : 8) * D);
    } break;
    case 3: norm_phase(H, ng + D, modl, 3, U, MTOT, (const float*)(ws + WS_DP)); break;
    case 4: {
        const size_t woff = l == 0 ? WS_WIN0 : l == 1 ? WS_WIN1 : l == 2 ? WS_WIN2 : WS_WIN3;
        if (l == 2 || l == 0) { pg8::EpiProjAttn E; E.P = P; E.VT = (bf16_t*)(ws + WS_VT); E.R = (const float*)(ws + WS_ROPE); E.rope = l == 2 ? 1 : 0; run_gemm(lds, U, (const bf16_t*)(ws + woff), MTOT, 3072, D, E); }
        else { pg8::EpiProj E; E.P = P; E.G32 = G32; E.ldc = NPAD_IN[l]; E.gcol0 = l == 1 ? 2048 : (l == 3 ? 1536 : 1 << 30); E.gn = l == 1 ? 16 : 32; E.VT = (bf16_t*)(ws + WS_VT); E.vcol0 = l == 1 ? 1024 : (l == 3 ? 512 : 1 << 30);
            run_gemm(lds, U, (const bf16_t*)(ws + woff), MTOT, NPAD_IN[l], D, E); }
    } break;
    case 5:
        if (l == 0) na_mfma_phase(P, VTb, INP(I_NARPB), U);
        else if (l == 1) ml_prep3_phase(P, G32, INP(I_MLGB), INP(I_MLCONV), QC, KC, KBT, scb, lds);
        else if (l == 2) da_flash_phase(P, (const bf16_t*)(ws + WS_VT), INP(I_DALAM), INP(I_DANG), U, lds);
        else gla_prep3_phase(P, G32, INP(I_GLAGU), INP(I_GLABG), QC, KC, KBT, scb, lds);
        break;
    case 6:
        if (l == 1) chunk_scan_phase<256, true>(QC, KC, 0, KBT, VTb, scb, HS, lds);
        else if (l == 3) chunk_scan_phase<128, false>(QC, KC, (size_t)MTOT * 512, KBT, VTb, scb, HS, lds);
        break;
    case 7:
        if (l == 1) ml_readout_phase(P, HS, INP(I_MLNG), U);
        else if (l == 3) gla_readout_phase(P, HS, INP(I_GLANG), U);
        break;
    case 9: norm_phase(H, ng + 2 * D, modl, 6, U, l == 3 ? MLAT : MTOT, (const float*)(ws + WS_DP)); break;
    }
}


#define XB_TMO      128
#define XB_XCNT(j)  (256  + 64 * (j))
#define XB_XSUB(j)  (1280 + 64 * (j))
#define XB_XGEN(j)  (2304 + 64 * (j))
#define XB_TOP      3328
#define XB_TOPGEN   3392
#define XCD_BAR_WORDS 3456
#define XB_SPIN_CAP (1u << 18)

__device__ __forceinline__ unsigned xb_ld(unsigned* p)              { return __hip_atomic_load(p, __ATOMIC_RELAXED, __HIP_MEMORY_SCOPE_AGENT); }
__device__ __forceinline__ unsigned xb_add(unsigned* p, unsigned v) { return __hip_atomic_fetch_add(p, v, __ATOMIC_RELAXED, __HIP_MEMORY_SCOPE_AGENT); }
__device__ __forceinline__ unsigned xb_xcc_id() { return (unsigned)__builtin_amdgcn_s_getreg((3 << 11) | 20) & 0xFu; }
#define XB_SPIN(cond, bar) do { unsigned _sp = 0; while (cond) { __builtin_amdgcn_s_sleep(1); \
    if ((++_sp & 255u) == 0u) { if (xb_ld(&(bar)[XB_TMO])) break; if (_sp > XB_SPIN_CAP) { atomicAdd(&(bar)[XB_TMO], 1u); break; } } } } while (0)

struct XcdBarrier {
    unsigned* bar; unsigned x;
    volatile LAS unsigned* st;
};

__device__ __forceinline__ XcdBarrier xcd_barrier_post(unsigned* bar, volatile LAS unsigned* st) {
    XcdBarrier b; b.bar = bar; b.x = xb_xcc_id(); b.st = st;
    if (threadIdx.x == 0) (void)xb_add(&bar[XB_XCNT(b.x)], 1u);
    return b;
}
__device__ __forceinline__ void xcd_barrier_complete(unsigned* bar, unsigned x, unsigned& nloc, unsigned& nx) {
    const unsigned G = gridDim.x * gridDim.y * gridDim.z;
    unsigned sum, cnt, mine, sp = 0u;
    for (;;) {
        sum = 0u; cnt = 0u; mine = 0u;
#pragma unroll
        for (unsigned j = 0; j < 16; ++j) { const unsigned c = xb_ld(&bar[XB_XCNT(j)]); sum += c; cnt += (c > 0u) ? 1u : 0u; mine = (j == x) ? c : mine; }
        if (sum == G) break;
        __builtin_amdgcn_s_sleep(1);
        if ((++sp & 255u) == 0u) { if (xb_ld(&bar[XB_TMO])) break; if (sp > XB_SPIN_CAP) { atomicAdd(&bar[XB_TMO], 1u); break; } }
    }
    nloc = mine > 0u ? mine : 1u; nx = cnt > 0u ? cnt : 1u;
}

__device__ __forceinline__ void xcd_barrier(const XcdBarrier& b) {
    asm volatile("s_waitcnt vmcnt(0)" ::: "memory");
    __syncthreads();
    if (threadIdx.x == 0) {
        unsigned* bar = b.bar;
        __builtin_amdgcn_s_waitcnt(0);
        unsigned nloc = b.st[0], nx = b.st[1];
        if (nloc == 0u) { xcd_barrier_complete(bar, b.x, nloc, nx); b.st[0] = nloc; b.st[1] = nx; }
        const unsigned old = xb_add(&bar[XB_XSUB(b.x)], 1u);
        const unsigned gen = old / nloc;
        if (old + 1u == (gen + 1u) * nloc) {
            __builtin_amdgcn_fence(__ATOMIC_RELEASE, "agent");
            asm volatile("s_waitcnt vmcnt(0)" ::: "memory");
            const unsigned og = xb_add(&bar[XB_TOP], 1u);
            const unsigned tg = og / nx;
            if (og + 1u == (tg + 1u) * nx) xb_add(&bar[XB_TOPGEN], 1u);
            else XB_SPIN(xb_ld(&bar[XB_TOPGEN]) == tg, bar);
            __builtin_amdgcn_fence(__ATOMIC_ACQUIRE, "agent");
            xb_add(&bar[XB_XGEN(b.x)], 1u);
            asm volatile("s_waitcnt vmcnt(0)" ::: "memory");
        } else {
            XB_SPIN(xb_ld(&bar[XB_XGEN(b.x)]) == gen, bar);
            __builtin_amdgcn_fence(__ATOMIC_ACQUIRE, "agent");
            asm volatile("s_waitcnt vmcnt(0)" ::: "memory");
        }
    }
    __syncthreads();
}

constexpr int LDS_BYTES = 135168;
__global__ void __launch_bounds__(512) mega(Args a) {
    extern __shared__ __attribute__((aligned(16))) unsigned char lds_raw[];
    LAS unsigned char* lds = (LAS unsigned char*)lds_raw;
    cg::grid_group grid = cg::this_grid();
    volatile LAS unsigned* xbst = (volatile LAS unsigned*)(lds + LDS_BYTES - 16);
    if (threadIdx.x == 0) { xbst[0] = 0u; xbst[1] = 0u; }
    __syncthreads();
    const XcdBarrier xb = xcd_barrier_post((unsigned*)(a.ws + WS_BAR), xbst);
    int nsync = 0;
    for (int ph = a.ph_lo; ph < a.ph_hi; ++ph) {
        if (!phase_exists(ph)) continue;
        if (nsync == 1) grid.sync();
        else if (nsync > 1) xcd_barrier(xb);
        ++nsync;
        run_phase(a, ph, lds);
        __syncthreads();
    }
}

extern "C" void kernel_launch(void* const* d_in, const int* in_sizes, int n_in, void* d_out, int out_size,
                              void* d_ws, size_t ws_size, hipStream_t stream) {
    static int grid = 0;
    if (grid == 0) {
        int dev = 0, cus = 0, per_cu = 0;
        (void)hipGetDevice(&dev);
        (void)hipDeviceGetAttribute(&cus, hipDeviceAttributeMultiprocessorCount, dev);
        (void)hipFuncSetAttribute((const void*)mega, hipFuncAttributeMaxDynamicSharedMemorySize, LDS_BYTES);
        (void)hipOccupancyMaxActiveBlocksPerMultiprocessor(&per_cu, (const void*)mega, 512, LDS_BYTES);
        grid = cus > 0 ? cus : 256;
        if (n_in != N_IN || ws_size < WS_END) { fprintf(stderr, "kernel_launch: n_in %d ws %zu (need %zu)\n", n_in, ws_size, (size_t)WS_END); }
    }
    (void)hipMemsetAsync((unsigned char*)d_ws + WS_BAR, 0, 16384, stream);
    Args a{};
    for (int i = 0; i < N_IN; ++i) a.in[i] = (const float*)d_in[i];
    a.out = (float*)d_out; a.ws = (unsigned char*)d_ws; a.ph_lo = 0; a.ph_hi = 50;
    void* args[] = {&a};
    hipError_t e = hipLaunchCooperativeKernel((const void*)mega, dim3(grid), dim3(512), args, LDS_BYTES, stream);
    if (e != hipSuccess) fprintf(stderr, "cooperative launch failed: %s\n", hipGetErrorString(e));
}
```
